# Optimizing an MI355X kernel written in HIP

```python
import jax, jax.numpy as jnp
from jax import lax
import numpy as np

D_MODEL = 1024
BATCH = 4
SEQ = 8192
DEPTH = 1

GRID_W = 64
NA_HEADS = 8
NA_HEAD_DIM = 64
NA_ROWS = 8
NA_COLS = 16
SWA_Q_HEADS = 8
SWA_KV_HEADS = 2
SWA_HEAD_DIM = 64
SWA_WINDOW = 128
SWA_BLOCK = 128
ROPE_THETA = 10000.0
N_EXPERTS = 32
TOP_K = 4
D_FF_EXPERT = 1024
SWIGLU_LIMIT = 7.0
SWIGLU_ALPHA = 1.702
EXPERT_BLOCK = 256
RMS_EPS = 1e-5

NA_WIDTH = NA_HEADS * NA_HEAD_DIM
SWA_Q_WIDTH = SWA_Q_HEADS * SWA_HEAD_DIM
SWA_KV_WIDTH = SWA_KV_HEADS * SWA_HEAD_DIM
IN_SIZES = (NA_WIDTH, NA_WIDTH, NA_WIDTH, SWA_Q_WIDTH, SWA_KV_WIDTH, SWA_KV_WIDTH, D_MODEL, D_MODEL)
D_IN = sum(IN_SIZES)
IN_SPLITS = tuple(int(v) for v in np.cumsum(IN_SIZES)[:-1])

kernel_name = 'hybrid_natten_swa_moe_encoder'


def rmsnorm(x, g):
    xf = x.astype(jnp.float32)
    y = xf * lax.rsqrt(jnp.mean(xf * xf, axis=-1, keepdims=True) + RMS_EPS)
    return (y * g.astype(jnp.float32)).astype(x.dtype)


def rope(x, pos):
    half = x.shape[-1] // 2
    inv_freq = ROPE_THETA ** (-jnp.arange(half, dtype=jnp.float32) / half)
    ang = pos.astype(jnp.float32)[:, None] * inv_freq[None, :]
    cos = jnp.cos(ang)[None, :, None, :]
    sin = jnp.sin(ang)[None, :, None, :]
    xf = x.astype(jnp.float32)
    x1, x2 = xf[..., :half], xf[..., half:]
    return jnp.concatenate([x1 * cos - x2 * sin, x2 * cos + x1 * sin], axis=-1).astype(x.dtype)


def neighborhood_attention(q, k, v, rpb):
    b, s, h, dh = q.shape
    rows = s // GRID_W
    kr = min(NA_ROWS, rows)
    scale = dh ** -0.5
    qg = q.reshape(b, rows, GRID_W, h, dh)
    kg = k.reshape(b, rows, GRID_W, h, dh)
    vg = v.reshape(b, rows, GRID_W, h, dh)
    col = np.arange(GRID_W)
    cstart = np.clip(col - NA_COLS // 2, 0, GRID_W - NA_COLS)
    cidx = cstart[:, None] + np.arange(NA_COLS)[None, :]
    rpb_c = rpb[:, :, cidx - col[:, None] + NA_COLS - 1]

    def one_row(r):
        rs = jnp.clip(r - kr // 2, 0, rows - kr)
        kw = lax.dynamic_slice_in_dim(kg, rs, kr, axis=1)[:, :, cidx]
        vw = lax.dynamic_slice_in_dim(vg, rs, kr, axis=1)[:, :, cidx]
        qr = lax.dynamic_index_in_dim(qg, r, axis=1, keepdims=False)
        sc = jnp.einsum('bchd,bicjhd->bhcij', qr, kw).astype(jnp.float32) * scale
        dr = rs + jnp.arange(kr) - r + NA_ROWS - 1
        bias = jnp.take(rpb_c, dr, axis=1).transpose(0, 2, 1, 3)
        sc = sc + bias[None].astype(jnp.float32)
        p = jax.nn.softmax(sc.reshape(b, h, GRID_W, kr * NA_COLS), axis=-1)
        p = p.reshape(b, h, GRID_W, kr, NA_COLS).astype(v.dtype)
        return jnp.einsum('bhcij,bicjhd->bchd', p, vw)

    out = lax.map(one_row, jnp.arange(rows))
    return out.transpose(1, 0, 2, 3, 4).reshape(b, s, h * dh)


def sliding_window_gqa(q, k, v, sinks):
    b, s, hq, dh = q.shape
    hkv = k.shape[2]
    grp = hq // hkv
    nb = s // SWA_BLOCK
    scale = dh ** -0.5
    pad = ((0, 0), (SWA_BLOCK, SWA_BLOCK), (0, 0), (0, 0))
    kp = jnp.pad(k, pad).reshape(b, nb + 2, SWA_BLOCK, hkv, dh)
    vp = jnp.pad(v, pad).reshape(b, nb + 2, SWA_BLOCK, hkv, dh)
    kband = jnp.concatenate([kp[:, :-2], kp[:, 1:-1], kp[:, 2:]], axis=2)
    vband = jnp.concatenate([vp[:, :-2], vp[:, 1:-1], vp[:, 2:]], axis=2)
    qb = q.reshape(b, nb, SWA_BLOCK, hkv, grp, dh)
    sc = jnp.einsum('bnqkgd,bnjkd->bkgnqj', qb, kband).astype(jnp.float32) * scale
    qpos = jnp.arange(SWA_BLOCK)[:, None]
    koff = jnp.arange(3 * SWA_BLOCK)[None, :] - SWA_BLOCK
    rel_ok = jnp.abs(koff - qpos) <= SWA_WINDOW
    kabs = jnp.arange(nb)[:, None] * SWA_BLOCK + koff
    in_seq = (kabs >= 0) & (kabs < s)
    mask = rel_ok[None, :, :] & in_seq[:, None, :]
    sc = jnp.where(mask[None, None, None], sc, -jnp.inf)
    sink = sinks.astype(jnp.float32).reshape(1, hkv, grp, 1, 1, 1)
    m = jnp.maximum(jnp.max(sc, axis=-1, keepdims=True), sink)
    e = jnp.exp(sc - m)
    p = (e / (jnp.sum(e, axis=-1, keepdims=True) + jnp.exp(sink - m))).astype(v.dtype)
    o = jnp.einsum('bkgnqj,bnjkd->bnqkgd', p, vband)
    return o.reshape(b, s, hq * dh)


def moe_clamped_swiglu(h, w_router, b_router, w1, b1, w2, b2):
    b, s, d = h.shape
    t = b * s
    xt = h.reshape(t, d)
    logits = (xt @ w_router + b_router).astype(jnp.float32)
    top_v, top_i = lax.top_k(logits, TOP_K)
    gates = jax.nn.softmax(top_v, axis=-1)
    n_assign = t * TOP_K
    e_id = top_i.reshape(n_assign).astype(jnp.int32)
    tok = jnp.arange(n_assign, dtype=jnp.int32) // TOP_K
    wts = gates.reshape(n_assign)
    order = jnp.argsort(e_id, stable=True)
    e_sorted = e_id[order]
    counts = jnp.bincount(e_id, length=N_EXPERTS)
    start = jnp.cumsum(counts) - counts
    padded = (counts + EXPERT_BLOCK - 1) // EXPERT_BLOCK * EXPERT_BLOCK
    pend = jnp.cumsum(padded)
    pstart = pend - padded
    dest = pstart[e_sorted] + jnp.arange(n_assign, dtype=jnp.int32) - start[e_sorted]
    n_rows = n_assign + N_EXPERTS * EXPERT_BLOCK
    n_blk = n_rows // EXPERT_BLOCK
    row_tok = jnp.full((n_rows,), t, jnp.int32).at[dest].set(tok[order])
    row_w = jnp.zeros((n_rows,), jnp.float32).at[dest].set(wts[order])
    blk_exp = jnp.minimum(jnp.searchsorted(pend, jnp.arange(n_blk) * EXPERT_BLOCK, side='right'), N_EXPERTS - 1)
    x_ext = jnp.concatenate([xt, jnp.zeros((1, d), xt.dtype)], axis=0)

    def expert_block(args):
        rows, ex = args
        xb = x_ext[rows]
        gu = xb @ w1[ex] + b1[ex]
        gate = jnp.minimum(gu[:, :D_FF_EXPERT], SWIGLU_LIMIT)
        up = jnp.clip(gu[:, D_FF_EXPERT:], -SWIGLU_LIMIT, SWIGLU_LIMIT)
        glu = gate * jax.nn.sigmoid(gate * SWIGLU_ALPHA)
        return ((up + 1.0) * glu) @ w2[ex] + b2[ex]

    yb = lax.map(expert_block, (row_tok.reshape(n_blk, EXPERT_BLOCK), blk_exp))
    contrib = yb.reshape(n_rows, d).astype(jnp.float32) * row_w[:, None]
    y = jax.ops.segment_sum(contrib, row_tok, num_segments=t + 1)[:t]
    return y.reshape(b, s, d).astype(h.dtype)


def setup_inputs(seed: int = 0) -> dict:
    key = jax.random.key(seed)
    ks = jax.random.split(key, 18)
    f32 = jnp.float32

    def nrm(k, shape, scale):
        return jax.random.normal(k, shape, f32) * scale

    return {
        'x': nrm(ks[0], (BATCH, SEQ, D_MODEL), 1.0),
        'norm1_g': 1.0 + nrm(ks[1], (DEPTH, D_MODEL), 0.02),
        'w_in': nrm(ks[2], (DEPTH, D_MODEL, D_IN), D_MODEL ** -0.5),
        'b_in': nrm(ks[3], (DEPTH, D_IN), 0.02),
        'na_rpb': nrm(ks[4], (DEPTH, NA_HEADS, 2 * NA_ROWS - 1, 2 * NA_COLS - 1), 0.5),
        'swa_sinks': nrm(ks[5], (DEPTH, SWA_Q_HEADS), 1.0),
        'w_up_a': nrm(ks[6], (DEPTH, NA_WIDTH, D_MODEL), NA_WIDTH ** -0.5),
        'w_up_b': nrm(ks[7], (DEPTH, SWA_Q_WIDTH, D_MODEL), SWA_Q_WIDTH ** -0.5),
        'w_out': nrm(ks[8], (DEPTH, D_MODEL, D_MODEL), D_MODEL ** -0.5),
        'norm2_g': 1.0 + nrm(ks[9], (DEPTH, D_MODEL), 0.02),
        'w_router': nrm(ks[10], (DEPTH, D_MODEL, N_EXPERTS), D_MODEL ** -0.5),
        'b_router': nrm(ks[11], (DEPTH, N_EXPERTS), 0.01),
        'w1': nrm(ks[12], (DEPTH, N_EXPERTS, D_MODEL, 2 * D_FF_EXPERT), D_MODEL ** -0.5),
        'b1': nrm(ks[13], (DEPTH, N_EXPERTS, 2 * D_FF_EXPERT), 0.02),
        'w2': nrm(ks[14], (DEPTH, N_EXPERTS, D_FF_EXPERT, D_MODEL), D_FF_EXPERT ** -0.5),
        'b2': nrm(ks[15], (DEPTH, N_EXPERTS, D_MODEL), 0.02),
        'final_g': 1.0 + nrm(ks[16], (D_MODEL,), 0.02),
    }


def reference(x, norm1_g, w_in, b_in, na_rpb, swa_sinks, w_up_a, w_up_b, w_out,
              norm2_g, w_router, b_router, w1, b1, w2, b2, final_g):
    b, s, _ = x.shape
    pos = jnp.arange(s, dtype=jnp.int32)
    for l in range(DEPTH):
        h = rmsnorm(x, norm1_g[l])
        proj = h @ w_in[l] + b_in[l]
        qa, ka, va, qb, kb, vb, ga, gb = jnp.split(proj, IN_SPLITS, axis=-1)
        oa = neighborhood_attention(
            qa.reshape(b, s, NA_HEADS, NA_HEAD_DIM),
            ka.reshape(b, s, NA_HEADS, NA_HEAD_DIM),
            va.reshape(b, s, NA_HEADS, NA_HEAD_DIM),
            na_rpb[l])
        ob = sliding_window_gqa(
            rope(qb.reshape(b, s, SWA_Q_HEADS, SWA_HEAD_DIM), pos),
            rope(kb.reshape(b, s, SWA_KV_HEADS, SWA_HEAD_DIM), pos),
            vb.reshape(b, s, SWA_KV_HEADS, SWA_HEAD_DIM),
            swa_sinks[l])
        merged = jax.nn.sigmoid(ga) * (oa @ w_up_a[l]) + jax.nn.sigmoid(gb) * (ob @ w_up_b[l])
        x = x + merged @ w_out[l]
        h2 = rmsnorm(x, norm2_g[l])
        x = x + moe_clamped_swiglu(h2, w_router[l], b_router[l], w1[l], b1[l], w2[l], b2[l])
    return rmsnorm(x, final_g)
```

```cpp
#include <hip/hip_runtime.h>
#include <cstdio>
#include <cstdint>

#ifndef PROBE_ATTN
#define PROBE_ATTN 0
#endif
#ifndef ATTN_NAIVE
#define ATTN_NAIVE 0
#endif
#ifndef MK_SPLIT
#define MK_SPLIT 0
#endif

#define LAS __attribute__((address_space(3)))
#define GAS __attribute__((address_space(1)))
typedef unsigned short bf16_t;
typedef short bf16x8 __attribute__((ext_vector_type(8)));
typedef float f32x4 __attribute__((ext_vector_type(4)));
typedef float f32x2 __attribute__((ext_vector_type(2)));
typedef unsigned u32x4 __attribute__((ext_vector_type(4)));
typedef unsigned u32x2 __attribute__((ext_vector_type(2)));
typedef __bf16 bf16x2_t __attribute__((ext_vector_type(2)));

constexpr int NB = 4, SEQ = 8192, T = NB * SEQ, D = 1024, DIN = 4352;
constexpr int NEXP = 32, FF = 1024, LISTCAP = 32768;
constexpr float RMS_EPS = 1e-5f;
constexpr float LOG2E = 1.4426950408889634f;
constexpr float QSCALE = 0.125f * LOG2E;
constexpr int C_QA = 0, C_KA = 512, C_VA = 1024, C_QB = 1536, C_KB = 2048, C_VB = 2176, C_GA = 2304, C_GB = 3328;

constexpr size_t MiB = 1u << 20;
constexpr size_t WS_CTL = 0, CTL_ZERO_BYTES = 1 * MiB;
constexpr size_t WS_ROPE = 1 * MiB;
constexpr size_t WS_BT = 3 * MiB;
constexpr size_t WS_WIN = 4 * MiB;
constexpr size_t WS_WA = 13 * MiB, WS_WB = 14 * MiB, WS_WOUT = 15 * MiB;
constexpr size_t WS_W2 = 17 * MiB;
constexpr size_t WS_GWL = 744 * MiB;
constexpr size_t WS_LIST = 83 * MiB;
constexpr size_t WS_AO = 88 * MiB;
constexpr size_t WS_PROJ = 152 * MiB;
constexpr size_t WS_QA = WS_PROJ, WS_KA = WS_PROJ + 32 * MiB, WS_VA = WS_PROJ + 64 * MiB, WS_QB = WS_PROJ + 96 * MiB;
constexpr size_t WS_KB = WS_PROJ + 128 * MiB, WS_VB = WS_PROJ + 136 * MiB;
constexpr size_t WS_SG = WS_PROJ + 144 * MiB;
constexpr size_t WS_HACT = WS_PROJ;
constexpr size_t WS_W1 = 424 * MiB;
constexpr size_t WS_H1 = 552 * MiB;
constexpr size_t WS_H2N = WS_H1;
constexpr size_t WS_OA = 616 * MiB, WS_OB = 648 * MiB;
constexpr size_t WS_MERGED = 680 * MiB;
constexpr size_t WS_YTK = 424 * MiB;
constexpr size_t WS_H1Q = 680 * MiB;
constexpr size_t WS_WING8 = 50 * MiB;
constexpr size_t WS_INV = 748 * MiB;
constexpr size_t WS_END = 749 * MiB;
constexpr int CW_CNT = 64;
constexpr int CW_BAR = 4096;

constexpr int RING_BYTES = 131072;
constexpr int ATT_BYTES = 147456;
constexpr int MISC_OFF = ATT_BYTES;
constexpr int SEL_OFF = MISC_OFF + 1024;
constexpr int SELG_OFF = SEL_OFF + 2048;
constexpr int TS_OFF = SELG_OFF + 2048;
constexpr int T2E_OFF = TS_OFF + 1536;
constexpr int LDS_BYTES = 155648;
constexpr int NWAVES = 8, NTHREADS = 512;

#define RLX_AGENT __ATOMIC_RELAXED, __HIP_MEMORY_SCOPE_AGENT

__device__ __forceinline__ unsigned f2bf(float f) { unsigned u = __builtin_bit_cast(unsigned, f); return (u + 0x7fffu + ((u >> 16) & 1u)) >> 16; }
__device__ __forceinline__ unsigned pk2(float lo, float hi) { f32x2 v = {lo, hi}; bf16x2_t b = __builtin_convertvector(v, bf16x2_t); return __builtin_bit_cast(unsigned, b); }
constexpr float F8_ACT = 4.0f, F8_W = 128.0f, F8_INV = 1.0f / 512.0f, F8_Y = 32.0f, F8_YINV = 1.0f / 32.0f;
__device__ __forceinline__ unsigned pk4_fp8(float a, float b, float c, float d) { int w = 0; w = __builtin_amdgcn_cvt_pk_fp8_f32(a, b, w, false); w = __builtin_amdgcn_cvt_pk_fp8_f32(c, d, w, true); return (unsigned)w; }
__device__ __forceinline__ float bflo(unsigned w) { return __uint_as_float(w << 16); }
__device__ __forceinline__ float bfhi(unsigned w) { return __uint_as_float(w & 0xffff0000u); }
__device__ __forceinline__ float sigmoidf_(float x) { return __builtin_amdgcn_rcpf(1.0f + __builtin_amdgcn_exp2f(-x * LOG2E)); }
__device__ __forceinline__ const char* uniform_ptr(const char* p) {
    const unsigned long long v = (unsigned long long)p;
    const unsigned lo = __builtin_amdgcn_readfirstlane((unsigned)v), hi = __builtin_amdgcn_readfirstlane((unsigned)(v >> 32));
    return (const char*)(((unsigned long long)hi << 32) | lo);
}
__device__ __forceinline__ float wave_sum(float v) {
#pragma unroll
    for (int o = 1; o < 64; o <<= 1) v += __shfl_xor(v, o);
    return v;
}

namespace pg8 {
constexpr int BM = 256, BK = 64, HALF = 128, HTB = HALF * BK * 2, STAGE_BYTES = 8 * HTB, NXCD = 8, WGM = 8;
__host__ __device__ __forceinline__ int lds_byte(int r, int c) { const int st = (r >> 4) * 2 + (c >> 5), rr = r & 15, cc = c & 31, ob = rr * 64 + cc * 2; return st * 1024 + (ob ^ (((ob >> 9) & 1) << 5)); }
__host__ __device__ __forceinline__ void stage_rc(int b, int& R, int& C) { const int st = b / 1024, sb = b % 1024, swz = sb ^ (((sb >> 9) & 1) << 5); R = (st >> 1) * 16 + swz / 64; C = (st & 1) * 32 + (swz % 64) / 2; }
__host__ __device__ __forceinline__ int perm32(int rho) { const int n = rho >> 4, i = rho & 15; return 8 * (i >> 2) + 4 * n + (i & 3); }

struct Unit { int pm, pn, e, mt, part; };

struct StaticOrder {
    int nM, nN, nwg, G, c, tail_lo;
    __device__ void init(int M, int N, int G_, int c_) { nM = M / BM; nN = N / BM; nwg = nM * nN; G = G_; c = c_; tail_lo = -1; }
    __device__ bool next(int i, Unit& u) const {
        long L = (long)i * G + c;
        if (tail_lo >= 0 && i >= 3) { if (c < tail_lo || i >= 5) return false; L = 3L * G + 2 * (c - tail_lo) + (i - 3); }
        if (L >= nwg) return false;
        int wgid = (int)L; { const int q = nwg / NXCD, r = nwg % NXCD, xcd = wgid % NXCD, off = wgid / NXCD; wgid = (xcd < r ? xcd * (q + 1) : r * (q + 1) + (xcd - r) * q) + off; }
        const int nig = WGM * nN, gid = wgid / nig, fm = gid * WGM, gsz = (nM - fm) < WGM ? (nM - fm) : WGM;
        u.pm = fm + ((wgid % nig) % gsz); u.pn = (wgid % nig) / gsz; u.e = 0; u.mt = 0; u.part = 0; return true;
    }
};

typedef int v8i32_t __attribute__((ext_vector_type(8)));
typedef int v4i32_t __attribute__((ext_vector_type(4)));
__device__ __forceinline__ v8i32_t cat8(const bf16x8& a, const bf16x8& b) { const v4i32_t x = __builtin_bit_cast(v4i32_t, a), y = __builtin_bit_cast(v4i32_t, b); return __builtin_shufflevector(x, y, 0, 1, 2, 3, 4, 5, 6, 7); }
template <bool PERM, bool ALIGN_EPI, bool FP8, class Sched, class Epi>
__device__ __forceinline__ void gemm_phase(LAS unsigned char* lds, const int KB, const Sched& S, const Epi& E) {
    const int tid = threadIdx.x, wid = __builtin_amdgcn_readfirstlane(tid >> 6), lane = tid & 63, wr = wid >> 2, wc = wid & 3, fr = lane & 15, fq = lane >> 4;
    const int nt = KB / 128;
    int R[2], C2[2]; unsigned voffB[2];
#pragma unroll
    for (int i = 0; i < 2; ++i) { int r_, c_; stage_rc(tid * 16 + i * 8192, r_, c_); R[i] = r_; C2[i] = c_ * 2; const int Rb = PERM ? ((r_ & ~31) + perm32(r_ & 31)) : r_; voffB[i] = (unsigned)(Rb * KB + c_ * 2); }
    const size_t kstep = (size_t)(BK * 2);
    const size_t hstepB = (size_t)HALF * KB;
    const unsigned ldsw = (unsigned)wid * 1024u;
    const int aoff = lds_byte(wr * 64 + fr, fq * 8), boff = lds_byte(wc * 32 + fr, fq * 8);
#define PG8_SA(b, h) (((b) * 2 + (h)) * HTB)
#define PG8_SB(b, h) ((4 + (b) * 2 + (h)) * HTB)
#define PG8_STAGE_B(bufoff, gbase) do { _Pragma("unroll") for (int _i = 0; _i < 2; ++_i) \
        __builtin_amdgcn_global_load_lds((const unsigned*)((const char*)(gbase) + voffB[_i]), (LAS unsigned*)(lds + (bufoff) + ldsw + _i * 8192), 16, 0, 0); } while (0)
#define PG8_STAGE_A(bufoff, gbase, o0, o1) do { \
        __builtin_amdgcn_global_load_lds((const unsigned*)((const char*)(gbase) + (o0)), (LAS unsigned*)(lds + (bufoff) + ldsw), 16, 0, 0); \
        __builtin_amdgcn_global_load_lds((const unsigned*)((const char*)(gbase) + (o1)), (LAS unsigned*)(lds + (bufoff) + ldsw + 8192), 16, 0, 0); } while (0)
#define PG8_LDA(dst, b, h) do { _Pragma("unroll") for (int m = 0; m < 4; ++m) { const LAS unsigned char* p_ = lds + PG8_SA(b, h) + aoff + m * 2048; \
        dst[m] = __builtin_shufflevector(*(const LAS v4i32_t*)p_, *(const LAS v4i32_t*)(p_ + 1024), 0, 1, 2, 3, 4, 5, 6, 7); } } while (0)
#define PG8_LDB(dst, b, h) do { _Pragma("unroll") for (int n = 0; n < 2; ++n) { const LAS unsigned char* p_ = lds + PG8_SB(b, h) + boff + n * 2048; \
        dst[n] = __builtin_shufflevector(*(const LAS v4i32_t*)p_, *(const LAS v4i32_t*)(p_ + 1024), 0, 1, 2, 3, 4, 5, 6, 7); } } while (0)
#define PG8_LO(v) __builtin_bit_cast(bf16x8, __builtin_shufflevector(v, v, 0, 1, 2, 3))
#define PG8_HI(v) __builtin_bit_cast(bf16x8, __builtin_shufflevector(v, v, 4, 5, 6, 7))
#define PG8_MMA(ai, bj, At, Bt) do { __builtin_amdgcn_s_setprio(1); _Pragma("unroll") for (int m = 0; m < 4; ++m) _Pragma("unroll") for (int n = 0; n < 2; ++n) { \
        if constexpr (FP8) asm volatile("v_mfma_scale_f32_16x16x128_f8f6f4 %0, %1, %2, %0, %3, %3 op_sel_hi:[0,0,0]" : "+v"(acc[ai][bj][m][n]) : "v"(Bt[n]), "v"(At[m]), "v"(one_scale)); \
        else { acc[ai][bj][m][n] = __builtin_amdgcn_mfma_f32_16x16x32_bf16(PG8_LO(Bt[n]), PG8_LO(At[m]), acc[ai][bj][m][n], 0, 0, 0); \
               acc[ai][bj][m][n] = __builtin_amdgcn_mfma_f32_16x16x32_bf16(PG8_HI(Bt[n]), PG8_HI(At[m]), acc[ai][bj][m][n], 0, 0, 0); } } \
        __builtin_amdgcn_s_setprio(0); } while (0)
#define PG8_WAIT_V(n) asm volatile("s_waitcnt vmcnt(" #n ")" ::: "memory")
#define PG8_WAIT_L(n) asm volatile("s_waitcnt lgkmcnt(" #n ")" ::: "memory")
#define PG8_BAR __builtin_amdgcn_s_barrier()
#define PG8_SCHED __builtin_amdgcn_sched_barrier(0)
    Unit cur, nxt; int ui = 0;
    if (!S.next(0, cur)) return;
    f32x4 acc[2][2][4][2];
#pragma unroll
    for (int a = 0; a < 2; ++a)
#pragma unroll
        for (int b = 0; b < 2; ++b)
#pragma unroll
            for (int m = 0; m < 4; ++m)
#pragma unroll
                for (int n = 0; n < 2; ++n) acc[a][b][m][n] = (f32x4){0.f, 0.f, 0.f, 0.f};
    v8i32_t At[4], B0[2], B1[2];
    const int one_scale = 0x7f7f7f7f;
    const char* cA = S.a_base(cur); const char* cB = S.b_base(cur);
    LAS unsigned char* const eslot0 = lds + STAGE_BYTES;
    if (wid == 0) E.prefetch(cur, eslot0, lane);
    if constexpr (Sched::GATHER) { if (wid == 0) S.rows_prefetch(cur, eslot0 + 2048, lane); asm volatile("s_waitcnt vmcnt(0)" ::: "memory"); __syncthreads(); }
    unsigned oA00 = S.a_off(cur, R[0], eslot0 + 2048) + C2[0], oA01 = S.a_off(cur, R[1], eslot0 + 2048) + C2[1], oA10 = S.a_off(cur, HALF + R[0], eslot0 + 2048) + C2[0], oA11 = S.a_off(cur, HALF + R[1], eslot0 + 2048) + C2[1];
    PG8_STAGE_B(PG8_SB(0, 0), cB); PG8_STAGE_B(PG8_SB(0, 1), cB + hstepB); PG8_STAGE_A(PG8_SA(0, 0), cA, oA00, oA01); PG8_STAGE_A(PG8_SA(0, 1), cA, oA10, oA11);
    if (wr == 1) PG8_BAR;
    PG8_WAIT_V(2); PG8_BAR;
    PG8_STAGE_B(PG8_SB(1, 0), cB + kstep); PG8_STAGE_A(PG8_SA(1, 0), cA + kstep, oA00, oA01); PG8_STAGE_B(PG8_SB(1, 1), cB + hstepB + kstep);
    PG8_WAIT_V(6); PG8_BAR;
    for (;;) {
        const bool has_next = S.next(ui + 1, nxt);
        const char* nA = has_next ? S.a_base(nxt) : cA; const char* nB = has_next ? S.b_base(nxt) : cB;
        LAS unsigned char* const nrows = eslot0 + ((ui + 1) & 1) * 4096 + 2048;
        if constexpr (Sched::GATHER) { if (has_next && wid == 0) S.rows_prefetch(nxt, nrows, lane); }
        for (int t = 0; t < nt; t += 2) {
            const bool last = (t == nt - 2);
            const char* a1 = cA + (size_t)(t + 1) * kstep;
            const char* a2 = last ? nA : cA + (size_t)(t + 2) * kstep; const char* b2 = last ? nB : cB + (size_t)(t + 2) * kstep;
            const char* a3 = a2 + kstep; const char* b3 = b2 + kstep;
            unsigned p00 = oA00, p01 = oA01;
            if (last && has_next) { p00 = S.a_off(nxt, R[0], nrows) + C2[0]; p01 = S.a_off(nxt, R[1], nrows) + C2[1]; }
            PG8_LDB(B0, 0, 0); PG8_LDB(B1, 0, 1); PG8_SCHED; PG8_LDA(At, 0, 0); PG8_STAGE_A(PG8_SA(1, 1), a1, oA10, oA11);
            PG8_WAIT_V(8); PG8_WAIT_L(0); PG8_BAR; PG8_MMA(0, 0, At, B0); PG8_MMA(0, 1, At, B1); PG8_BAR; PG8_SCHED;
            unsigned p10 = oA10, p11 = oA11;
            if (last && has_next) { p10 = S.a_off(nxt, HALF + R[0], nrows) + C2[0]; p11 = S.a_off(nxt, HALF + R[1], nrows) + C2[1]; }
            PG8_LDA(At, 0, 1); PG8_STAGE_B(PG8_SB(0, 0), b2); PG8_STAGE_B(PG8_SB(0, 1), b2 + hstepB); PG8_STAGE_A(PG8_SA(0, 0), a2, p00, p01);
            PG8_WAIT_V(8); PG8_WAIT_L(0); PG8_BAR; PG8_MMA(1, 0, At, B0); PG8_MMA(1, 1, At, B1); PG8_BAR; PG8_SCHED;
            PG8_LDB(B0, 1, 0); PG8_LDB(B1, 1, 1); PG8_SCHED; PG8_LDA(At, 1, 0); PG8_STAGE_A(PG8_SA(0, 1), a2, p10, p11);
            PG8_WAIT_V(8); PG8_WAIT_L(0); PG8_BAR; PG8_MMA(0, 0, At, B0); PG8_MMA(0, 1, At, B1); PG8_BAR; PG8_SCHED;
            PG8_LDA(At, 1, 1); PG8_STAGE_B(PG8_SB(1, 0), b3); PG8_STAGE_B(PG8_SB(1, 1), b3 + hstepB); PG8_STAGE_A(PG8_SA(1, 0), a3, p00, p01);
            PG8_WAIT_V(8); PG8_WAIT_L(0); PG8_BAR; PG8_MMA(1, 0, At, B0); PG8_MMA(1, 1, At, B1); PG8_BAR; PG8_SCHED;
            if (last) { oA00 = p00; oA01 = p01; oA10 = p10; oA11 = p11; }
        }
        if constexpr (ALIGN_EPI) { if (wr == 0) PG8_BAR; }
        if constexpr (FP8) asm volatile("s_nop 15\n\ts_nop 7" ::: "memory");
        const bool zero = E(acc, cur, wr, wc, fr, fq, eslot0 + (ui & 1) * 4096);
        if (!has_next) break;
        if (zero) {
#pragma unroll
            for (int a = 0; a < 2; ++a)
#pragma unroll
                for (int b = 0; b < 2; ++b)
#pragma unroll
                    for (int m = 0; m < 4; ++m)
#pragma unroll
                        for (int n = 0; n < 2; ++n) acc[a][b][m][n] = (f32x4){0.f, 0.f, 0.f, 0.f};
        }
        cur = nxt; cA = nA; cB = nB; ++ui;
        if (wid == 0) E.prefetch(cur, eslot0 + (ui & 1) * 4096, lane);
        if constexpr (ALIGN_EPI) { if (wr == 1) PG8_BAR; }
    }
    PG8_WAIT_V(0);
    if constexpr (!ALIGN_EPI) { if (wr == 0) PG8_BAR; }
    PG8_BAR;
#undef PG8_SA
#undef PG8_SB
#undef PG8_STAGE_A
#undef PG8_STAGE_B
#undef PG8_LDA
#undef PG8_LDB
#undef PG8_MMA
#undef PG8_LO
#undef PG8_HI
#undef PG8_WAIT_V
#undef PG8_WAIT_L
#undef PG8_BAR
#undef PG8_SCHED
}
}
using pg8::Unit;

#define XB_TMO      128
#define XB_XCNT(j)  (256  + 64 * (j))
#define XB_XSUB(j)  (1280 + 64 * (j))
#define XB_XGEN(j)  (2304 + 64 * (j))
#define XB_TOP      3328
#define XB_TOPGEN   3392
#define XCD_BAR_WORDS 3456
#define XB_SPIN_CAP (1u << 18)
__device__ __forceinline__ unsigned xb_ld(unsigned* p)              { return __hip_atomic_load(p, __ATOMIC_RELAXED, __HIP_MEMORY_SCOPE_AGENT); }
__device__ __forceinline__ unsigned xb_add(unsigned* p, unsigned v) { return __hip_atomic_fetch_add(p, v, __ATOMIC_RELAXED, __HIP_MEMORY_SCOPE_AGENT); }
__device__ __forceinline__ unsigned xb_xcc_id() { return (unsigned)__builtin_amdgcn_s_getreg((3 << 11) | 20) & 0xFu; }
#define XB_SPIN(cond, bar) do { unsigned _sp = 0; while (cond) { __builtin_amdgcn_s_sleep(1); \
    if ((++_sp & 255u) == 0u) { if (xb_ld(&(bar)[XB_TMO])) break; if (_sp > XB_SPIN_CAP) { atomicAdd(&(bar)[XB_TMO], 1u); break; } } } } while (0)
struct XcdBarrier { unsigned* bar; unsigned x; volatile LAS unsigned* st; };
__device__ __forceinline__ XcdBarrier xcd_barrier_post(unsigned* bar, volatile LAS unsigned* st) {
    XcdBarrier b; b.bar = bar; b.x = xb_xcc_id(); b.st = st;
    if (threadIdx.x == 0) (void)xb_add(&bar[XB_XCNT(b.x)], 1u);
    return b;
}
__device__ __forceinline__ void xcd_barrier_complete(unsigned* bar, unsigned x, unsigned& nloc, unsigned& nx) {
    const unsigned G = gridDim.x * gridDim.y * gridDim.z;
    unsigned sum, cnt, mine, sp = 0u;
    for (;;) {
        sum = 0u; cnt = 0u; mine = 0u;
#pragma unroll
        for (unsigned j = 0; j < 16; ++j) { const unsigned c = xb_ld(&bar[XB_XCNT(j)]); sum += c; cnt += (c > 0u) ? 1u : 0u; mine = (j == x) ? c : mine; }
        if (sum == G) break;
        __builtin_amdgcn_s_sleep(1);
        if ((++sp & 255u) == 0u) { if (xb_ld(&bar[XB_TMO])) break; if (sp > XB_SPIN_CAP) { atomicAdd(&bar[XB_TMO], 1u); break; } }
    }
    nloc = mine > 0u ? mine : 1u; nx = cnt > 0u ? cnt : 1u;
}
__device__ __forceinline__ void xcd_barrier(const XcdBarrier& b) {
    asm volatile("s_waitcnt vmcnt(0)" ::: "memory");
    __syncthreads();
    if (threadIdx.x == 0) {
        unsigned* bar = b.bar;
        __builtin_amdgcn_s_waitcnt(0);
        unsigned nloc = b.st[0], nx = b.st[1];
        if (nloc == 0u) { xcd_barrier_complete(bar, b.x, nloc, nx); b.st[0] = nloc; b.st[1] = nx; }
        const unsigned old = xb_add(&bar[XB_XSUB(b.x)], 1u);
        const unsigned gen = old / nloc;
        if (old + 1u == (gen + 1u) * nloc) {
            __builtin_amdgcn_fence(__ATOMIC_RELEASE, "agent");
            asm volatile("s_waitcnt vmcnt(0)" ::: "memory");
            const unsigned og = xb_add(&bar[XB_TOP], 1u);
            const unsigned tg = og / nx;
            if (og + 1u == (tg + 1u) * nx) xb_add(&bar[XB_TOPGEN], 1u);
            else XB_SPIN(xb_ld(&bar[XB_TOPGEN]) == tg, bar);
            __builtin_amdgcn_fence(__ATOMIC_ACQUIRE, "agent");
            xb_add(&bar[XB_XGEN(b.x)], 1u);
            asm volatile("s_waitcnt vmcnt(0)" ::: "memory");
        } else {
            XB_SPIN(xb_ld(&bar[XB_XGEN(b.x)]) == gen, bar);
            __builtin_amdgcn_fence(__ATOMIC_ACQUIRE, "agent");
            asm volatile("s_waitcnt vmcnt(0)" ::: "memory");
        }
    }
    __syncthreads();
}

struct Args { const float* in[17]; float* out; unsigned char* ws; int ph_lo, ph_hi, li, pad; };
struct Frame {
    LAS unsigned char* lds;
    int tid, lane, wave, G, vcu;
    unsigned char* ws;
};

struct MapId { __device__ __forceinline__ int operator()(int n) const { return n; } };
struct MapWin { __device__ __forceinline__ int operator()(int n) const {
    const int tile = n >> 8, bj = (n >> 7) & 1;
    if (tile == 6 || tile == 7 || (tile == 8 && bj == 0)) {
        const int hb = n & ~127, p = n & 127, wc = p >> 5, fq = (p >> 3) & 3, nn = (p >> 2) & 1, e = p & 3;
        return hb + 64 * (wc >> 1) + 32 * nn + 16 * (wc & 1) + 4 * fq + e;
    }
    return n; } };
struct MapGate { __device__ __forceinline__ int operator()(int n) const { return C_GA + 1024 * ((n >> 7) & 1) + 128 * (n >> 8) + (n & 127); } };
struct MapY16 { __device__ __forceinline__ int operator()(int n) const { const int p = n & 255, bj = p >> 7, wc = (p >> 5) & 3, fq = (p >> 3) & 3, j = p & 7; return (n & ~255) + 64 * wc + 16 * fq + 8 * bj + j; } };
struct MapW1 { __device__ __forceinline__ int operator()(int n) const { const int pn = n >> 8, r = n & 255; return 1024 * (r >> 7) + 128 * pn + (r & 127); } };

template <class Map>
__device__ __forceinline__ void p0_transpose_item(const float* W, int K, int N, bf16_t* WT, LAS float* scr, int item, int lane, const Map& map, const float* kscale, int ncols = 0) {
    const int nblk = (ncols ? ncols : N) / 64, kb = item / nblk, nb = item % nblk, k0 = 64 * kb, n0 = 64 * nb;
    const int srcc = map(n0 + 4 * (lane & 15));
    f32x4 v[16];
#pragma unroll
    for (int i = 0; i < 16; ++i) v[i] = *(const f32x4*)(W + (size_t)(k0 + 4 * i + (lane >> 4)) * N + srcc);
    if (kscale) {
#pragma unroll
        for (int i = 0; i < 16; ++i) v[i] = v[i] * kscale[k0 + 4 * i + (lane >> 4)];
    }
#pragma unroll
    for (int i = 0; i < 16; ++i) *(LAS f32x4*)(scr + (4 * i + (lane >> 4)) * 68 + 4 * (lane & 15)) = v[i];
    asm volatile("s_waitcnt lgkmcnt(0)" ::: "memory");
    const int kc = lane & 7, ngl = lane >> 3;
#pragma unroll
    for (int pp = 0; pp < 2; ++pp) {
        const int ng = 8 * pp + ngl; f32x4 r[8];
#pragma unroll
        for (int j = 0; j < 8; ++j) r[j] = *(const LAS f32x4*)(scr + (8 * kc + j) * 68 + 4 * ng);
#pragma unroll
        for (int e = 0; e < 4; ++e) { u32x4 o; o.x = pk2(r[0][e], r[1][e]); o.y = pk2(r[2][e], r[3][e]); o.z = pk2(r[4][e], r[5][e]); o.w = pk2(r[6][e], r[7][e]);
            *(u32x4*)(WT + (size_t)(n0 + 4 * ng + e) * K + k0 + 8 * kc) = o; }
    }
    asm volatile("s_waitcnt lgkmcnt(0)" ::: "memory");
}

template <class Map>
__device__ __forceinline__ void p0_transpose_item_fp8(const float* W, int K, int N, unsigned char* WT, LAS float* scr, int item, int lane, const Map& map, const float* kscale, float scale, int pitch = 0) {
    if (pitch == 0) pitch = N;
    const int nblk = N / 32, kb = item / nblk, nb = item % nblk, k0 = 128 * kb, n0 = 32 * nb;
    const int srcc = map(n0 + 4 * (lane & 7));
    f32x4 v[16];
#pragma unroll
    for (int i = 0; i < 16; ++i) v[i] = *(const f32x4*)(W + (size_t)(k0 + 8 * i + (lane >> 3)) * pitch + srcc);
#pragma unroll
    for (int i = 0; i < 16; ++i) v[i] = v[i] * (kscale ? kscale[k0 + 8 * i + (lane >> 3)] * scale : scale);
#pragma unroll
    for (int i = 0; i < 16; ++i) *(LAS f32x4*)(scr + (8 * i + (lane >> 3)) * 36 + 4 * (lane & 7)) = v[i];
    asm volatile("s_waitcnt lgkmcnt(0)" ::: "memory");
    const int kc = lane & 15, ngl = lane >> 4;
#pragma unroll
    for (int pp = 0; pp < 2; ++pp) {
        const int ng = 4 * pp + ngl; f32x4 r[8];
#pragma unroll
        for (int j = 0; j < 8; ++j) r[j] = *(const LAS f32x4*)(scr + (8 * kc + j) * 36 + 4 * ng);
#pragma unroll
        for (int e = 0; e < 4; ++e) { u32x2 o; o.x = pk4_fp8(r[0][e], r[1][e], r[2][e], r[3][e]); o.y = pk4_fp8(r[4][e], r[5][e], r[6][e], r[7][e]);
            *(u32x2*)(WT + (size_t)(n0 + 4 * ng + e) * K + k0 + 8 * kc) = o; }
    }
    asm volatile("s_waitcnt lgkmcnt(0)" ::: "memory");
}

struct F8Item { const float* W; unsigned char* WT; int K, N, k0, n0, srcc; f32x4 ks0, ks1; };
template <class Map> __device__ __forceinline__ void f8_item_load(F8Item& I, const float* W, int K, int N, unsigned char* WT, int item, int lane, const Map& map, const float* kscale, f32x4 (&v)[16]) {
    const int nblk = N / 32, kb = item / nblk, nb = item % nblk;
    I.W = W; I.WT = WT; I.K = K; I.N = N; I.k0 = 128 * kb; I.n0 = 32 * nb; I.srcc = map(I.n0 + 4 * (lane & 7));
    if (kscale) { const float* kp = kscale + I.k0 + 8 * (lane & 15); I.ks0 = *(const f32x4*)kp; I.ks1 = *(const f32x4*)(kp + 4); }
    else { I.ks0 = (f32x4){1.f, 1.f, 1.f, 1.f}; I.ks1 = I.ks0; }
#pragma unroll
    for (int i = 0; i < 16; ++i) v[i] = *(const f32x4*)(W + (size_t)(I.k0 + 8 * i + (lane >> 3)) * N + I.srcc);
}
__device__ __forceinline__ void f8_item_finish(const F8Item& I, LAS float* scr, int lane, f32x4 (&v)[16], float scale) {
#pragma unroll
    for (int i = 0; i < 16; ++i) *(LAS f32x4*)(scr + (8 * i + (lane >> 3)) * 36 + 4 * (lane & 7)) = v[i];
    asm volatile("s_waitcnt lgkmcnt(0)" ::: "memory");
    const int kc = lane & 15, ngl = lane >> 4;
    const f32x4 s0 = I.ks0 * scale, s1 = I.ks1 * scale;
#pragma unroll
    for (int pp = 0; pp < 2; ++pp) {
        const int ng = 4 * pp + ngl; f32x4 r[8];
#pragma unroll
        for (int j = 0; j < 8; ++j) r[j] = *(const LAS f32x4*)(scr + (8 * kc + j) * 36 + 4 * ng) * (j < 4 ? s0[j] : s1[j - 4]);
#pragma unroll
        for (int e = 0; e < 4; ++e) { u32x2 o; o.x = pk4_fp8(r[0][e], r[1][e], r[2][e], r[3][e]); o.y = pk4_fp8(r[4][e], r[5][e], r[6][e], r[7][e]);
            *(u32x2*)(I.WT + (size_t)(I.n0 + 4 * ng + e) * I.K + I.k0 + 8 * kc) = o; }
    }
    asm volatile("s_waitcnt lgkmcnt(0)" ::: "memory");
}

__device__ __forceinline__ void p0_prologue(Frame& F, const Args& a) {
    LAS float* scr = (LAS float*)(F.lds + F.wave * 18432);
    const int gw = F.vcu * NWAVES + F.wave, NGW = F.G * NWAVES;
    const float* w_in = a.in[2]; const float* w_up_a = a.in[6]; const float* w_up_b = a.in[7]; const float* w_out = a.in[8];
    const float* w1 = a.in[12]; const float* w2 = a.in[14]; const float* g2 = a.in[9];
    bf16_t* Win_t = (bf16_t*)(F.ws + WS_WIN); bf16_t* Wa_t = (bf16_t*)(F.ws + WS_WA); bf16_t* Wb_t = (bf16_t*)(F.ws + WS_WB); bf16_t* Wout_t = (bf16_t*)(F.ws + WS_WOUT);
    unsigned char* W1_t = (unsigned char*)(F.ws + WS_W1); unsigned char* W2_t = (unsigned char*)(F.ws + WS_W2);
    constexpr int I_IN = (D / 64) * (C_GA / 64), I_G8 = (D / 128) * (2048 / 32), I_UP = (512 / 64) * (D / 64), I_OUT = (D / 64) * (D / 64), I_W1 = (D / 128) * (2 * FF / 32), I_W2 = (FF / 128) * (D / 32);
        constexpr int NSMALL = I_IN + I_G8 + 2 * I_UP + I_OUT, NEXPERT = NEXP * (I_W1 + I_W2);
    for (int it = gw; it < NSMALL; it += NGW) {
        int r = it;
        if (r < I_IN) { p0_transpose_item(w_in, D, DIN, Win_t, scr, r, F.lane, MapWin(), nullptr, C_GA); continue; } r -= I_IN;
        if (r < I_G8) { p0_transpose_item_fp8(w_in, D, 2048, (unsigned char*)(F.ws + WS_WING8), scr, r, F.lane, MapGate(), nullptr, F8_W, DIN); continue; } r -= I_G8;
        if (r < I_UP) { p0_transpose_item(w_up_a, 512, D, Wa_t, scr, r, F.lane, MapId(), nullptr); continue; } r -= I_UP;
        if (r < I_UP) { p0_transpose_item(w_up_b, 512, D, Wb_t, scr, r, F.lane, MapId(), nullptr); continue; } r -= I_UP;
        p0_transpose_item(w_out, D, D, Wout_t, scr, r, F.lane, MapId(), nullptr);
    }
#define F8_LOAD(I_, V_, r_) do { const int rr_ = (r_); if (rr_ < NEXP * I_W1) { const int e_ = rr_ / I_W1, q_ = rr_ % I_W1; \
            f8_item_load(I_, w1 + (size_t)e_ * D * 2 * FF, D, 2 * FF, W1_t + (size_t)e_ * 2 * FF * D, q_, F.lane, MapW1(), g2, V_); } \
        else { const int r2_ = rr_ - NEXP * I_W1, e_ = r2_ / I_W2, q_ = r2_ % I_W2; \
            f8_item_load(I_, w2 + (size_t)e_ * FF * D, FF, D, W2_t + (size_t)e_ * D * FF, q_, F.lane, MapY16(), (const float*)nullptr, V_); } } while (0)
    {
        F8Item IA, IB; f32x4 va[16], vb[16];
        int r = gw;
        if (r < NEXPERT) {
            F8_LOAD(IA, va, r);
#pragma unroll 1
            for (;;) {
                const bool hb = r + NGW < NEXPERT; if (hb) F8_LOAD(IB, vb, r + NGW);
                f8_item_finish(IA, scr, F.lane, va, F8_W);
                if (!hb) break;
                const bool ha = r + 2 * NGW < NEXPERT; if (ha) F8_LOAD(IA, va, r + 2 * NGW);
                f8_item_finish(IB, scr, F.lane, vb, F8_W);
                if (!ha) break;
                r += 2 * NGW;
            }
        }
    }
#undef F8_LOAD
    const float* x = a.in[0]; const float* g1 = a.in[1]; bf16_t* H1 = (bf16_t*)(F.ws + WS_H1);
    f32x4 gv[4];
#pragma unroll
    for (int j = 0; j < 4; ++j) gv[j] = *((const f32x4*)g1 + F.lane + 64 * j);
    for (int m = 2 * gw; m < T; m += 2 * NGW) {
        const f32x4* xr = (const f32x4*)(x + (size_t)m * D) + F.lane;
        f32x4 v[2][4]; float s[2] = {0.f, 0.f};
#pragma unroll
        for (int q = 0; q < 2; ++q)
#pragma unroll
            for (int j = 0; j < 4; ++j) v[q][j] = xr[q * 256 + 64 * j];
#pragma unroll
        for (int q = 0; q < 2; ++q)
#pragma unroll
            for (int j = 0; j < 4; ++j) s[q] += (v[q][j].x * v[q][j].x + v[q][j].y * v[q][j].y) + (v[q][j].z * v[q][j].z + v[q][j].w * v[q][j].w);
#pragma unroll
        for (int q = 0; q < 2; ++q) {
            const float rstd = 1.0f / sqrtf(wave_sum(s[q]) * (1.f / D) + RMS_EPS);
            u32x2* o8 = (u32x2*)(H1 + (size_t)(m + q) * D) + F.lane; unsigned* o4 = (unsigned*)(F.ws + WS_H1Q + (size_t)(m + q) * D) + F.lane;
#pragma unroll
            for (int j = 0; j < 4; ++j) { const f32x4 hv = v[q][j] * rstd * gv[j]; u32x2 w; w.x = pk2(hv.x, hv.y); w.y = pk2(hv.z, hv.w); o8[64 * j] = w;
                o4[64 * j] = pk4_fp8(hv.x * F8_ACT, hv.y * F8_ACT, hv.z * F8_ACT, hv.w * F8_ACT); }
        }
    }
    float* rope = (float*)(F.ws + WS_ROPE);
    for (int idx = (F.vcu * NTHREADS + F.tid); idx < SEQ * 32; idx += F.G * NTHREADS) {
        const int pos = idx >> 5, i = idx & 31;
        const float invf = (float)exp2(-(double)i * (13.287712379549449 / 32.0));
        const float ang = (float)pos * invf;
        double rev = (double)ang * 0.15915494309189535; rev -= floor(rev);
        const float rv = (float)rev;
        rope[2 * idx] = __builtin_amdgcn_cosf(rv); rope[2 * idx + 1] = __builtin_amdgcn_sinf(rv);
    }
    float* bt = (float*)(F.ws + WS_BT); const float* rpb = a.in[4];
    for (int idx = (F.vcu * NTHREADS + F.tid); idx < 8 * 4 * 15 * 2 * 64 * 4; idx += F.G * NTHREADS) {
        const int reg = idx & 3, ln = (idx >> 2) & 63, hf = (idx >> 8) & 1; int rest = idx >> 9; const int dr = rest % 15; rest /= 15; const int gq = rest & 3, h = rest >> 2;
        const int c = 16 * gq + (ln & 15), base = (gq == 0) ? 0 : (gq == 1) ? 8 : (gq == 2) ? 24 : 32, kc = base + 16 * hf + 4 * (ln >> 4) + reg;
        const int cs = min(max(c - 8, 0), 48);
        bt[idx] = (kc >= cs && kc < cs + 16) ? rpb[h * 465 + dr * 31 + (kc - c + 15)] * LOG2E : -INFINITY;
    }
}

struct DenseSched {
    pg8::StaticOrder so; const char* A; unsigned lda; const char* Bt; int K;
    __device__ __forceinline__ bool next(int i, Unit& u) const { return so.next(i, u); }
    __device__ __forceinline__ const char* a_base(const Unit& u) const { return A + (size_t)u.pm * 256 * lda; }
    static constexpr bool GATHER = false;
    __device__ __forceinline__ unsigned a_off(const Unit&, int rho, const LAS unsigned char*) const { return (unsigned)rho * lda; }
    __device__ __forceinline__ const char* b_base(const Unit& u) const { return Bt + (size_t)u.pn * 256 * K; }
};
struct UpSched {
    pg8::StaticOrder so; const char* OA; const char* OB; const char* Wa; const char* Wb;
    __device__ __forceinline__ bool next(int i, Unit& u) const { const bool ok = so.next(i >> 1, u); u.part = i & 1; return ok; }
    __device__ __forceinline__ const char* a_base(const Unit& u) const { return (u.part ? OB : OA) + (size_t)u.pm * 256 * 1024; }
    static constexpr bool GATHER = false;
    __device__ __forceinline__ unsigned a_off(const Unit&, int rho, const LAS unsigned char*) const { return (unsigned)rho * 1024u; }
    __device__ __forceinline__ const char* b_base(const Unit& u) const { return (u.part ? Wb : Wa) + (size_t)u.pn * 256 * 512 * 2; }
};
template <bool GATHER_> struct MoeSched {
    static constexpr bool GATHER = GATHER_;
    const LAS int* tstart; const LAS int* cnt; const LAS unsigned char* t2e; int G, vcu, log_mt, total;
    const char* A; const int* list; const char* Bt; size_t b_estride; int K;
    __device__ __forceinline__ bool next(int i, Unit& u) const {
        const int L = i * G + vcu; const int blk = L >> 5, w = L & 31;
        const int mtg = (blk << log_mt) + (w & ((1 << log_mt) - 1)), pn = w >> log_mt;
        if (mtg >= total) return false;
        const int e = t2e[mtg];
        u.e = __builtin_amdgcn_readfirstlane(e); u.pm = __builtin_amdgcn_readfirstlane(mtg); u.mt = __builtin_amdgcn_readfirstlane(mtg - tstart[e]); u.pn = __builtin_amdgcn_readfirstlane(pn); u.part = 0; return true;
    }
    __device__ __forceinline__ const char* a_base(const Unit& u) const { return GATHER ? A : A + (size_t)u.pm * 256 * 1024; }
    __device__ __forceinline__ void rows_prefetch(const Unit& u, LAS unsigned char* dst, int lane) const {
        __builtin_amdgcn_global_load_lds((const unsigned*)(list + (size_t)u.e * LISTCAP + u.mt * 256 + 4 * lane), (LAS unsigned*)dst, 16, 0, 0); }
    __device__ __forceinline__ unsigned a_off(const Unit& u, int rho, const LAS unsigned char* rows) const {
        if (!GATHER) return (unsigned)rho * 1024u;
        const int tk = ((const LAS int*)rows)[rho];
        return (u.mt * 256 + rho < cnt[u.e]) ? (unsigned)(tk >> 2) * 1024u : 0u;
    }
    __device__ __forceinline__ const char* b_base(const Unit& u) const { return Bt + (size_t)u.e * b_estride + (size_t)u.pn * 256 * K; }
};

__device__ __forceinline__ size_t hm_off(int t, int nh, int h, int d) { return ((size_t)((t >> 13) * nh + h) * SEQ + (t & (SEQ - 1))) * 64 + d; }
struct EpiInProj {
    unsigned char* ws; const float* bias; const float* rope;
    __device__ __forceinline__ void prefetch(const Unit& u, LAS unsigned char* es, int lane) const {
        __builtin_amdgcn_global_load_lds((const unsigned*)(bias + 256 * u.pn + 4 * lane), (LAS unsigned*)es, 16, 0, 0); }
    __device__ __forceinline__ bool operator()(f32x4 (&acc)[2][2][4][2], const Unit& u, int wr, int wc, int fr, int fq, const LAS unsigned char* es) const {
        const int pn = u.pn; const int row0 = u.pm * 256 + wr * 64 + fr;
#pragma unroll
        for (int bj = 0; bj < 2; ++bj) {
            const bool rp = (pn == 6 || pn == 7 || (pn == 8 && bj == 0));
            const int hb = 256 * pn + 128 * bj;
            if (rp) {
                const int Lb = hb + 64 * (wc >> 1) + 16 * (wc & 1) + 4 * fq, i0 = 16 * (wc & 1) + 4 * fq;
                const LAS float* bl = (const LAS float*)es - 256 * pn;
                const f32x4 b1v = *(const LAS f32x4*)(bl + Lb), b2v = *(const LAS f32x4*)(bl + Lb + 32);
                const float sc = (pn <= 7) ? QSCALE : 1.0f;
                bf16_t* dst = (bf16_t*)(ws + (pn <= 7 ? WS_QB : WS_KB)); const int nh = (pn <= 7) ? 8 : 2; const int cl = Lb - (pn <= 7 ? C_QB : C_KB);
#pragma unroll
                for (int ai = 0; ai < 2; ++ai) {
                    f32x4 cs0a[4], cs1a[4];
#pragma unroll
                    for (int m = 0; m < 4; ++m) { const int pos = (row0 + ai * 128 + m * 16) & (SEQ - 1);
                        cs0a[m] = *(const f32x4*)(rope + (size_t)(pos * 32 + i0) * 2); cs1a[m] = *(const f32x4*)(rope + (size_t)(pos * 32 + i0) * 2 + 4); }
                    asm volatile("" ::: "memory");
#pragma unroll
                    for (int m = 0; m < 4; ++m) {
                        const int row = row0 + ai * 128 + m * 16;
                        const f32x4 cs0 = cs0a[m], cs1 = cs1a[m];
                        const f32x4 x1 = acc[ai][bj][m][0] + b1v, x2 = acc[ai][bj][m][1] + b2v;
                        const float c[4] = {cs0.x, cs0.z, cs1.x, cs1.z}, s[4] = {cs0.y, cs0.w, cs1.y, cs1.w};
                        float o1[4], o2[4];
#pragma unroll
                        for (int e = 0; e < 4; ++e) { o1[e] = (x1[e] * c[e] - x2[e] * s[e]) * sc; o2[e] = (x2[e] * c[e] + x1[e] * s[e]) * sc; }
                        bf16_t* rp_ = dst + hm_off(row, nh, cl >> 6, cl & 63);
                        u32x2 w1; w1.x = pk2(o1[0], o1[1]); w1.y = pk2(o1[2], o1[3]); *(u32x2*)rp_ = w1;
                        u32x2 w2; w2.x = pk2(o2[0], o2[1]); w2.y = pk2(o2[2], o2[3]); *(u32x2*)(rp_ + 32) = w2;
                    }
                }
            } else {
                const int c0 = hb + 32 * wc + 8 * fq;
                const LAS float* bl = (const LAS float*)es - 256 * pn;
                const f32x4 b0 = *(const LAS f32x4*)(bl + c0), b1 = *(const LAS f32x4*)(bl + c0 + 4);
                const int mode = (pn <= 1) ? 1 : (pn >= 9 ? 2 : 0);
                bf16_t* dst; int nh = 8, cl;
                if (pn <= 1) { dst = (bf16_t*)(ws + WS_QA); cl = c0 - C_QA; }
                else if (pn <= 3) { dst = (bf16_t*)(ws + WS_KA); cl = c0 - C_KA; }
                else if (pn <= 5) { dst = (bf16_t*)(ws + WS_VA); cl = c0 - C_VA; }
                else if (pn == 8) { dst = (bf16_t*)(ws + WS_VB); cl = c0 - C_VB; nh = 2; }
                else { dst = (bf16_t*)(ws + WS_SG); cl = c0 - C_GA; }
#pragma unroll
                for (int ai = 0; ai < 2; ++ai)
#pragma unroll
                    for (int m = 0; m < 4; ++m) {
                        const int row = row0 + ai * 128 + m * 16;
                        f32x4 v0 = acc[ai][bj][m][0] + b0, v1 = acc[ai][bj][m][1] + b1;
                        if (mode == 1) { v0 = v0 * QSCALE; v1 = v1 * QSCALE; }
                        if (mode == 2) {
#pragma unroll
                            for (int e = 0; e < 4; ++e) { v0[e] = sigmoidf_(v0[e]); v1[e] = sigmoidf_(v1[e]); } }
                        u32x4 w; w.x = pk2(v0[0], v0[1]); w.y = pk2(v0[2], v0[3]); w.z = pk2(v1[0], v1[1]); w.w = pk2(v1[2], v1[3]);
                        bf16_t* p_ = (pn >= 9) ? dst + (size_t)row * 2048 + cl : dst + hm_off(row, nh, cl >> 6, cl & 63);
                        *(u32x4*)p_ = w;
                    }
            }
        }
        return true;
    }
};
struct EpiGate {
    bf16_t* SG; const float* bias;
    __device__ __forceinline__ void prefetch(const Unit& u, LAS unsigned char* es, int lane) const {
        const float* s = bias + C_GA + 128 * u.pn + (lane < 32 ? 4 * lane : 1024 + 4 * (lane - 32));
        __builtin_amdgcn_global_load_lds((const unsigned*)s, (LAS unsigned*)es, 16, 0, 0); }
    __device__ __forceinline__ bool operator()(f32x4 (&acc)[2][2][4][2], const Unit& u, int wr, int wc, int fr, int fq, const LAS unsigned char* es) const {
        const int row0 = u.pm * 256 + wr * 64 + fr, ch = 32 * wc + 8 * fq;
        const LAS float* bl = (const LAS float*)es + ch;
        f32x4 za_b[2], zb_b[2];
        za_b[0] = *(const LAS f32x4*)bl * -LOG2E; za_b[1] = *(const LAS f32x4*)(bl + 4) * -LOG2E; zb_b[0] = *(const LAS f32x4*)(bl + 128) * -LOG2E; zb_b[1] = *(const LAS f32x4*)(bl + 132) * -LOG2E;
#pragma unroll
        for (int ai = 0; ai < 2; ++ai)
#pragma unroll
            for (int m = 0; m < 4; ++m) {
                const int row = row0 + ai * 128 + m * 16;
                float rt[8], sb[8];
#pragma unroll
                for (int n = 0; n < 2; ++n) {
                    const f32x4 za = acc[ai][0][m][n] * (-F8_INV * LOG2E) + za_b[n], zb = acc[ai][1][m][n] * (-F8_INV * LOG2E) + zb_b[n];
#pragma unroll
                    for (int e = 0; e < 4; ++e) {
                        const float da = 1.0f + __builtin_amdgcn_exp2f(fminf(za[e], 60.0f)), db = 1.0f + __builtin_amdgcn_exp2f(fminf(zb[e], 60.0f));
                        const float r = __builtin_amdgcn_rcpf(da * db), sga = db * r;
                        sb[4 * n + e] = da * r; rt[4 * n + e] = db * sga;
                    }
                }
                u32x4 w; w.x = pk2(rt[0], rt[1]); w.y = pk2(rt[2], rt[3]); w.z = pk2(rt[4], rt[5]); w.w = pk2(rt[6], rt[7]);
                *(u32x4*)(SG + (size_t)row * 2048 + 128 * u.pn + ch) = w;
                w.x = pk2(sb[0], sb[1]); w.y = pk2(sb[2], sb[3]); w.z = pk2(sb[4], sb[5]); w.w = pk2(sb[6], sb[7]);
                *(u32x4*)(SG + (size_t)row * 2048 + 1024 + 128 * u.pn + ch) = w;
            }
        return true;
    }
};
struct EpiUp {
    const bf16_t* P; bf16_t* Mg;
    __device__ __forceinline__ void prefetch(const Unit&, LAS unsigned char*, int) const {}
    template <int PART>
    __device__ __forceinline__ void run(f32x4 (&acc)[2][2][4][2], const Unit& u, int wr, int wc, int fr, int fq) const {
        const int row0 = u.pm * 256 + wr * 64 + fr, cb = u.pn * 256 + 32 * wc + 8 * fq;
        const bf16_t* Pp = P + (PART ? 1024 : 0) + (size_t)row0 * 2048 + cb;
        u32x4 g[2][4][2];
#pragma unroll
        for (int ai = 0; ai < 2; ++ai)
#pragma unroll
            for (int m = 0; m < 4; ++m)
#pragma unroll
                for (int bj = 0; bj < 2; ++bj) g[ai][m][bj] = *(const u32x4*)(Pp + (size_t)(ai * 128 + m * 16) * 2048 + 128 * bj);
        __builtin_amdgcn_sched_barrier(0);
#pragma unroll
        for (int ai = 0; ai < 2; ++ai)
#pragma unroll
            for (int m = 0; m < 4; ++m)
#pragma unroll
                for (int bj = 0; bj < 2; ++bj) {
                    const u32x4 gb = g[ai][m][bj];
                    const float sb[8] = {bflo(gb.x), bfhi(gb.x), bflo(gb.y), bfhi(gb.y), bflo(gb.z), bfhi(gb.z), bflo(gb.w), bfhi(gb.w)};
                    if constexpr (PART == 0) {
#pragma unroll
                        for (int e = 0; e < 4; ++e) { acc[ai][bj][m][0][e] *= sb[e]; acc[ai][bj][m][1][e] *= sb[4 + e]; }
                    } else {
                        const f32x4 v0 = acc[ai][bj][m][0], v1 = acc[ai][bj][m][1];
                        u32x4 w; w.x = pk2(v0[0] * sb[0], v0[1] * sb[1]); w.y = pk2(v0[2] * sb[2], v0[3] * sb[3]); w.z = pk2(v1[0] * sb[4], v1[1] * sb[5]); w.w = pk2(v1[2] * sb[6], v1[3] * sb[7]);
                        *(u32x4*)(Mg + (size_t)(row0 + ai * 128 + m * 16) * D + cb + 128 * bj) = w;
                    }
                }
    }
    __device__ __forceinline__ bool operator()(f32x4 (&acc)[2][2][4][2], const Unit& u, int wr, int wc, int fr, int fq, const LAS unsigned char* es) const {
        if (u.part == 0) run<0>(acc, u, wr, wc, fr, fq); else run<1>(acc, u, wr, wc, fr, fq);
        return u.part != 0;
    }
};
struct EpiAo {
    bf16_t* AO;
    __device__ __forceinline__ void prefetch(const Unit&, LAS unsigned char*, int) const {}
    __device__ __forceinline__ bool operator()(f32x4 (&acc)[2][2][4][2], const Unit& u, int wr, int wc, int fr, int fq, const LAS unsigned char* es) const {
        const int row0 = u.pm * 256 + wr * 64 + fr, col0 = u.pn * 256 + wc * 32 + 8 * fq;
#pragma unroll
        for (int ai = 0; ai < 2; ++ai)
#pragma unroll
            for (int m = 0; m < 4; ++m) {
                bf16_t* rowp = AO + (size_t)(row0 + ai * 128 + m * 16) * D + col0;
#pragma unroll
                for (int bj = 0; bj < 2; ++bj) { const f32x4 v0 = acc[ai][bj][m][0], v1 = acc[ai][bj][m][1];
                    u32x4 w; w.x = pk2(v0[0], v0[1]); w.y = pk2(v0[2], v0[3]); w.z = pk2(v1[0], v1[1]); w.w = pk2(v1[2], v1[3]); *(u32x4*)(rowp + bj * 128) = w; }
            }
        return true;
    }
};
struct EpiMoe1 {
    const float* b1; unsigned char* H;
    __device__ __forceinline__ void prefetch(const Unit& u, LAS unsigned char* es, int lane) const {
        const float* s = b1 + (size_t)u.e * 2 * FF + 128 * u.pn + (lane < 32 ? 4 * lane : FF + 4 * (lane - 32));
        __builtin_amdgcn_global_load_lds((const unsigned*)s, (LAS unsigned*)es, 16, 0, 0); }
    __device__ __forceinline__ bool operator()(f32x4 (&acc)[2][2][4][2], const Unit& u, int wr, int wc, int fr, int fq, const LAS unsigned char* es) const {
        const int p0 = 32 * wc + 8 * fq;
        const LAS float* bg = (const LAS float*)es + p0;
        constexpr float KS = -1.702f * LOG2E, QC = F8_ACT / KS;
        f32x4 bz[2], bq[2];
        bz[0] = *(const LAS f32x4*)bg * KS; bz[1] = *(const LAS f32x4*)(bg + 4) * KS; bq[0] = *(const LAS f32x4*)(bg + 128) * QC + QC; bq[1] = *(const LAS f32x4*)(bg + 132) * QC + QC;
#pragma unroll
        for (int ai = 0; ai < 2; ++ai)
#pragma unroll
            for (int m = 0; m < 4; ++m) {
                const int rho = 128 * ai + 64 * wr + 16 * m + fr;
                float a8[8];
#pragma unroll
                for (int n = 0; n < 2; ++n) {
                    const f32x4 z4 = acc[ai][0][m][n] * (F8_INV * KS) + bz[n], q4 = acc[ai][1][m][n] * (F8_INV * QC) + bq[n];
#pragma unroll
                    for (int p = 0; p < 2; ++p) {
                        f32x2 z = {__builtin_amdgcn_fmed3f(z4[2 * p], 7.0f * KS, 40.0f), __builtin_amdgcn_fmed3f(z4[2 * p + 1], 7.0f * KS, 40.0f)};
                        f32x2 q = {__builtin_amdgcn_fmed3f(q4[2 * p], 8.0f * QC, -6.0f * QC), __builtin_amdgcn_fmed3f(q4[2 * p + 1], 8.0f * QC, -6.0f * QC)};
                        f32x2 d = {__builtin_amdgcn_exp2f(z.x), __builtin_amdgcn_exp2f(z.y)};
                        d = d + 1.0f;
                        const f32x2 nn = q * z; const float r = __builtin_amdgcn_rcpf(d.x * d.y);
                        const f32x2 o = nn * __builtin_shufflevector(d, d, 1, 0) * r;
                        a8[4 * n + 2 * p] = o.x; a8[4 * n + 2 * p + 1] = o.y;
                    }
                }
                u32x2 w; w.x = pk4_fp8(a8[0], a8[1], a8[2], a8[3]); w.y = pk4_fp8(a8[4], a8[5], a8[6], a8[7]);
                *(u32x2*)(H + (size_t)(u.pm * 256 + rho) * FF + 128 * u.pn + p0) = w;
            }
        return true;
    }
};
struct EpiMoe2 {
    const LAS int* cnt; const float* gwl; const float* b2; unsigned char* Y;
    __device__ __forceinline__ void prefetch(const Unit& u, LAS unsigned char* es, int lane) const {
        __builtin_amdgcn_global_load_lds((const unsigned*)(b2 + (size_t)u.e * D + 256 * u.pn + 4 * lane), (LAS unsigned*)es, 16, 0, 0);
        __builtin_amdgcn_global_load_lds((const unsigned*)(gwl + (size_t)u.e * LISTCAP + u.mt * 256 + 4 * lane), (LAS unsigned*)(es + 1024), 16, 0, 0); }
    __device__ __forceinline__ bool operator()(f32x4 (&acc)[2][2][4][2], const Unit& u, int wr, int wc, int fr, int fq, const LAS unsigned char* es) const {
        const int n_e = cnt[u.e]; const int cl = 64 * wc + 16 * fq;
        f32x4 bv[2][2];
#pragma unroll
        for (int bj = 0; bj < 2; ++bj)
#pragma unroll
            for (int n = 0; n < 2; ++n) bv[bj][n] = *(const LAS f32x4*)((const LAS float*)es + cl + 8 * bj + 4 * n);
        float gw[2][4];
#pragma unroll
        for (int ai = 0; ai < 2; ++ai)
#pragma unroll
            for (int m = 0; m < 4; ++m) gw[ai][m] = ((const LAS float*)(es + 1024))[128 * ai + 64 * wr + 16 * m + fr] * F8_Y;
#pragma unroll
        for (int ai = 0; ai < 2; ++ai)
#pragma unroll
            for (int m = 0; m < 4; ++m) {
                const int rho = 128 * ai + 64 * wr + 16 * m + fr;
                if (u.mt * 256 + rho < n_e) {
                    const float g_ = gw[ai][m];
                    u32x4 w;
#pragma unroll
                    for (int bj = 0; bj < 2; ++bj) {
                        const f32x4 v0 = (acc[ai][bj][m][0] * F8_INV + bv[bj][0]) * g_, v1 = (acc[ai][bj][m][1] * F8_INV + bv[bj][1]) * g_;
                        w[2 * bj] = pk4_fp8(v0[0], v0[1], v0[2], v0[3]); w[2 * bj + 1] = pk4_fp8(v1[0], v1[1], v1[2], v1[3]);
                    }
                    *(u32x4*)(Y + (size_t)(u.pm * 256 + rho) * D + u.pn * 256 + cl) = w;
                }
            }
        return true;
    }
};

__device__ __forceinline__ void ld64(const bf16_t* p, float (&f)[64]) {
#pragma unroll
    for (int i = 0; i < 8; ++i) { const u32x4 w = *((const u32x4*)p + i); f[8 * i] = bflo(w.x); f[8 * i + 1] = bfhi(w.x); f[8 * i + 2] = bflo(w.y); f[8 * i + 3] = bfhi(w.y); f[8 * i + 4] = bflo(w.z); f[8 * i + 5] = bfhi(w.z); f[8 * i + 6] = bflo(w.w); f[8 * i + 7] = bfhi(w.w); }
}
__device__ __forceinline__ float dot64(const bf16_t* p, const float (&q)[64]) {
    float s = 0.f;
#pragma unroll
    for (int i = 0; i < 8; ++i) { const u32x4 w = *((const u32x4*)p + i);
        s += q[8 * i] * bflo(w.x) + q[8 * i + 1] * bfhi(w.x) + q[8 * i + 2] * bflo(w.y) + q[8 * i + 3] * bfhi(w.y) + q[8 * i + 4] * bflo(w.z) + q[8 * i + 5] * bfhi(w.z) + q[8 * i + 6] * bflo(w.w) + q[8 * i + 7] * bfhi(w.w); }
    return s;
}
__device__ __forceinline__ void axpy64(const bf16_t* p, float a, float pw, float (&o)[64]) {
#pragma unroll
    for (int i = 0; i < 8; ++i) { const u32x4 w = *((const u32x4*)p + i);
        o[8 * i] = o[8 * i] * a + pw * bflo(w.x); o[8 * i + 1] = o[8 * i + 1] * a + pw * bfhi(w.x); o[8 * i + 2] = o[8 * i + 2] * a + pw * bflo(w.y); o[8 * i + 3] = o[8 * i + 3] * a + pw * bfhi(w.y);
        o[8 * i + 4] = o[8 * i + 4] * a + pw * bflo(w.z); o[8 * i + 5] = o[8 * i + 5] * a + pw * bfhi(w.z); o[8 * i + 6] = o[8 * i + 6] * a + pw * bflo(w.w); o[8 * i + 7] = o[8 * i + 7] * a + pw * bfhi(w.w); }
}
__device__ __forceinline__ void st64(bf16_t* p, const float (&o)[64], float inv) {
#pragma unroll
    for (int i = 0; i < 8; ++i) { u32x4 w; w.x = pk2(o[8 * i] * inv, o[8 * i + 1] * inv); w.y = pk2(o[8 * i + 2] * inv, o[8 * i + 3] * inv); w.z = pk2(o[8 * i + 4] * inv, o[8 * i + 5] * inv); w.w = pk2(o[8 * i + 6] * inv, o[8 * i + 7] * inv); *((u32x4*)p + i) = w; }
}
__device__ __forceinline__ void attn_naive(Frame& F, const Args& a) {
    const bf16_t* QA = (const bf16_t*)(F.ws + WS_QA); const bf16_t* KA = (const bf16_t*)(F.ws + WS_KA); const bf16_t* VA = (const bf16_t*)(F.ws + WS_VA);
    const bf16_t* QB = (const bf16_t*)(F.ws + WS_QB); const bf16_t* KB = (const bf16_t*)(F.ws + WS_KB); const bf16_t* VB = (const bf16_t*)(F.ws + WS_VB);
    bf16_t* OA = (bf16_t*)(F.ws + WS_OA); bf16_t* OB = (bf16_t*)(F.ws + WS_OB);
    const float* rpb = a.in[4]; const float* sinks = a.in[5];
    const int gt = F.vcu * NTHREADS + F.tid, NGT = F.G * NTHREADS;
    for (int it = gt; it < T * 16; it += NGT) {
        const int t = it >> 4, hh = it & 15; const int b = t >> 13, s = t & (SEQ - 1);
        float q[64], o[64];
#pragma unroll
        for (int d = 0; d < 64; ++d) o[d] = 0.f;
        if (hh < 8) {
            const int h = hh, r = s >> 6, c = s & 63; const int rs = min(max(r - 4, 0), 120), cs = min(max(c - 8, 0), 48);
            ld64(QA + hm_off(t, 8, h, 0), q);
            float m = -INFINITY, l = 0.f;
            for (int kr = 0; kr < 8; ++kr)
                for (int kc = 0; kc < 16; ++kc) {
                    const int kt = (b << 13) + ((rs + kr) << 6) + cs + kc;
                    float sc = dot64(KA + hm_off(kt, 8, h, 0), q) + rpb[h * 15 * 31 + (rs + kr - r + 7) * 31 + (cs + kc - c + 15)] * LOG2E;
                    const float mn = fmaxf(m, sc), al = __builtin_amdgcn_exp2f(m - mn), pw = __builtin_amdgcn_exp2f(sc - mn);
                    l = l * al + pw; axpy64(VA + hm_off(kt, 8, h, 0), al, pw, o); m = mn;
                }
            st64(OA + (size_t)t * 512 + h * 64, o, 1.0f / l);
        } else {
            const int hq = hh - 8, kvh = hq >> 2;
            ld64(QB + hm_off(t, 8, hq, 0), q);
            float m = sinks[hq] * LOG2E, l = 1.f;
            const int j0 = max(s - 128, 0), j1 = min(s + 128, SEQ - 1);
            for (int j = j0; j <= j1; ++j) {
                const int kt = (b << 13) + j;
                const float sc = dot64(KB + hm_off(kt, 2, kvh, 0), q);
                const float mn = fmaxf(m, sc), al = __builtin_amdgcn_exp2f(m - mn), pw = __builtin_amdgcn_exp2f(sc - mn);
                l = l * al + pw; axpy64(VB + hm_off(kt, 2, kvh, 0), al, pw, o); m = mn;
            }
            st64(OB + (size_t)t * 512 + hq * 64, o, 1.0f / l);
        }
    }
}


typedef short s16x4 __attribute__((ext_vector_type(4)));
typedef short v4i16_t __attribute__((ext_vector_type(4)));
#define MFMA16(a, b, c) __builtin_amdgcn_mfma_f32_16x16x32_bf16((a), (b), (c), 0, 0, 0)
__device__ __forceinline__ bf16x8 ldK(const LAS unsigned char* img, int key, int chunk) { return *(const LAS bf16x8*)(img + key * 128 + ((chunk ^ ((key >> 1) & 7)) << 4)); }
__device__ __forceinline__ s16x4 ldVt(const LAS unsigned char* img, int key, int dt, int p) {
    const LAS unsigned char* a = img + key * 128 + (((2 * dt + (p >> 1)) ^ (((key >> 1) & 3) << 1)) << 4) + (p & 1) * 8;
    return __builtin_bit_cast(s16x4, __builtin_amdgcn_ds_read_tr16_b64_v4i16((LAS v4i16_t*)a)); }
template <bool ISV> __device__ __forceinline__ void dma_piece(const bf16_t* grow0, LAS unsigned char* img, int k0, int lane) {
    const int key = k0 + (lane >> 3), slot = lane & 7;
    const int ss = ISV ? (slot ^ (((key >> 1) & 3) << 1)) : (slot ^ ((key >> 1) & 7));
    __builtin_amdgcn_global_load_lds((const unsigned*)((const char*)grow0 + (lane >> 3) * 128 + ss * 16), (LAS unsigned*)(img + k0 * 128), 16, 0, 0);
}
__device__ __forceinline__ float xmax16_32(float v) { v = fmaxf(v, __shfl_xor(v, 16)); return fmaxf(v, __shfl_xor(v, 32)); }
__device__ __forceinline__ float xsum16_32(float v) { v += __shfl_xor(v, 16); return v + __shfl_xor(v, 32); }
__device__ __forceinline__ bf16x8 pack8(const f32x4& a, const f32x4& b) { u32x4 w; w.x = pk2(a[0], a[1]); w.y = pk2(a[2], a[3]); w.z = pk2(b[0], b[1]); w.w = pk2(b[2], b[3]); return __builtin_bit_cast(bf16x8, w); }

__device__ __forceinline__ void na_phase(Frame& F, const Args& a) {
    const bf16_t* QA = (const bf16_t*)(F.ws + WS_QA); const bf16_t* KA = (const bf16_t*)(F.ws + WS_KA); const bf16_t* VA = (const bf16_t*)(F.ws + WS_VA);
    bf16_t* OA = (bf16_t*)(F.ws + WS_OA); const f32x4* BT = (const f32x4*)(F.ws + WS_BT);
    LAS unsigned char* imgK = F.lds; LAS unsigned char* imgV = F.lds + 9 * 8192;
    const int lane = F.lane, g = lane >> 4, ql = lane & 15, q4 = (lane & 15) >> 2, p4 = lane & 3;
    const int per = (2048 + F.G - 1) / F.G;
    int res_lo = -1000, res_bh = -1;
    u32x4 pf[4]; int pf_lo = 0, pf_cnt = 0;
    f32x4 bt[8][2]; int bt_key = -1;
    bf16x8 qf0, qf1, qn0, qn1; bool have_q = false;
    for (int i = 0; i < per; ++i) {
        const int u = F.vcu * per + i; if (u >= 2048) break;
        const int p = u & 63, h = (u >> 6) & 7, b = u >> 9, bh = b * 8 + h;
        const int R0 = min(max(2 * p - 4, 0), 120);
        const size_t rowbase = (size_t)bh * SEQ;
        if (res_bh != bh || res_lo != R0) {
            __syncthreads();
            for (int j = F.wave; j < 144; j += 8) {
                const int kr = j >> 4, isv = (j >> 3) & 1, pc = j & 7; const int slot = (R0 + kr) % 9;
                const size_t tok0 = rowbase + (R0 + kr) * 64 + pc * 8;
                if (isv) dma_piece<true>(VA + tok0 * 64, imgV + slot * 8192, pc * 8, lane); else dma_piece<false>(KA + tok0 * 64, imgK + slot * 8192, pc * 8, lane);
            }
            asm volatile("s_waitcnt vmcnt(0)" ::: "memory");
            __syncthreads();
            have_q = false;
        }
        res_bh = bh; res_lo = R0;
        const int r = 2 * p + (F.wave >> 2), gq = F.wave & 3, base = (gq == 0) ? 0 : (gq == 1) ? 8 : (gq == 2) ? 24 : 32;
        const int rs = min(max(r - 4, 0), 120), rs9 = rs % 9, dr0 = rs - r + 7;
        const size_t qrow = rowbase + r * 64 + 16 * gq + ql;
        if (!have_q) { qf0 = *(const bf16x8*)(QA + qrow * 64 + 8 * g); qf1 = *(const bf16x8*)(QA + qrow * 64 + 32 + 8 * g); }
        if (bt_key != h * 64 + dr0) {
            bt_key = h * 64 + dr0;
#pragma unroll
            for (int kr = 0; kr < 8; ++kr)
#pragma unroll
                for (int hf = 0; hf < 2; ++hf) bt[kr][hf] = BT[((((h * 4 + gq) * 15 + dr0 + kr) * 2 + hf) * 64) + lane];
        }
        const bool has_next = (i + 1 < per && u + 1 < 2048 && ((u + 1) >> 6) == (u >> 6));
        pf_cnt = 0;
        if (has_next) {
            const size_t qrow2 = qrow + 128;
            qn0 = *(const bf16x8*)(QA + qrow2 * 64 + 8 * g); qn1 = *(const bf16x8*)(QA + qrow2 * 64 + 32 + 8 * g);
            const int nR0 = min(max(2 * (p + 1) - 4, 0), 120); pf_lo = max(nR0, R0 + 9); pf_cnt = nR0 + 9 - pf_lo;
#pragma unroll
            for (int jj = 0; jj < 4; ++jj) {
                const int j = F.wave + 8 * jj, rowsel = j >> 4, isv = (j >> 3) & 1, pc = j & 7;
                if (rowsel < pf_cnt) {
                    const int key = pc * 8 + (lane >> 3), s16 = lane & 7; const int ss = isv ? (s16 ^ (((key >> 1) & 3) << 1)) : (s16 ^ ((key >> 1) & 7));
                    const bf16_t* src = (isv ? VA : KA) + (rowbase + (size_t)(pf_lo + rowsel) * 64 + key) * 64 + ss * 8;
                    pf[jj] = *(const u32x4*)src;
                }
            }
        }
        f32x4 S[8][2];
#pragma unroll
        for (int kr = 0; kr < 8; ++kr) {
            const int sl = (rs9 + kr >= 9) ? rs9 + kr - 9 : rs9 + kr; const LAS unsigned char* ik = imgK + sl * 8192;
#pragma unroll
            for (int hf = 0; hf < 2; ++hf) {
                const int key = base + 16 * hf + ql;
                f32x4 s = MFMA16(ldK(ik, key, g), qf0, bt[kr][hf]); s = MFMA16(ldK(ik, key, 4 + g), qf1, s); S[kr][hf] = s;
            }
        }
        float m = -INFINITY;
#pragma unroll
        for (int kr = 0; kr < 8; ++kr)
#pragma unroll
            for (int hf = 0; hf < 2; ++hf) { m = fmaxf(fmaxf(m, S[kr][hf][0]), S[kr][hf][1]); m = fmaxf(fmaxf(m, S[kr][hf][2]), S[kr][hf][3]); }
        m = xmax16_32(m);
#pragma unroll
        for (int kr = 0; kr < 8; ++kr)
#pragma unroll
            for (int hf = 0; hf < 2; ++hf)
#pragma unroll
                for (int e = 0; e < 4; ++e) S[kr][hf][e] = __builtin_amdgcn_exp2f(S[kr][hf][e] - m);
        f32x4 o[4], osum = {0.f, 0.f, 0.f, 0.f};
        const bf16x8 ones8 = {0x3F80, 0x3F80, 0x3F80, 0x3F80, 0x3F80, 0x3F80, 0x3F80, 0x3F80};
#pragma unroll
        for (int dt = 0; dt < 4; ++dt) o[dt] = (f32x4){0.f, 0.f, 0.f, 0.f};
#pragma unroll
        for (int kr = 0; kr < 8; ++kr) {
            const int sl = (rs9 + kr >= 9) ? rs9 + kr - 9 : rs9 + kr;
            const bf16x8 pp = pack8(S[kr][0], S[kr][1]); const LAS unsigned char* iv = imgV + sl * 8192;
            const int ka = base + 4 * g + q4;
#pragma unroll
            for (int dt = 0; dt < 4; ++dt) {
                const s16x4 va = ldVt(iv, ka, dt, p4), vb = ldVt(iv, ka + 16, dt, p4);
                const bf16x8 vf = {va[0], va[1], va[2], va[3], vb[0], vb[1], vb[2], vb[3]};
                o[dt] = MFMA16(vf, pp, o[dt]);
            }
            osum = MFMA16(ones8, pp, osum);
        }
        const float inv = 1.0f / osum[0];
        bf16_t* op = OA + ((size_t)b * SEQ + r * 64 + 16 * gq + ql) * 512 + h * 64 + 4 * g;
#pragma unroll
        for (int dt = 0; dt < 4; ++dt) { u32x2 w; w.x = pk2(o[dt][0] * inv, o[dt][1] * inv); w.y = pk2(o[dt][2] * inv, o[dt][3] * inv); *(u32x2*)(op + 16 * dt) = w; }
        if (pf_cnt > 0) {
            __syncthreads();
#pragma unroll
            for (int jj = 0; jj < 4; ++jj) {
                const int j = F.wave + 8 * jj, rowsel = j >> 4, isv = (j >> 3) & 1, pc = j & 7;
                if (rowsel < pf_cnt) { const int slot = (pf_lo + rowsel) % 9; *(LAS u32x4*)((isv ? imgV : imgK) + slot * 8192 + pc * 1024 + lane * 16) = pf[jj]; }
            }
            res_lo = pf_lo + pf_cnt - 9;
            __syncthreads();
        }
        if (has_next) { qf0 = qn0; qf1 = qn1; have_q = true; } else have_q = false;
    }
    __syncthreads();
}

__device__ __forceinline__ void swa_phase(Frame& F, const Args& a) {
    const bf16_t* QB = (const bf16_t*)(F.ws + WS_QB); const bf16_t* KB = (const bf16_t*)(F.ws + WS_KB); const bf16_t* VB = (const bf16_t*)(F.ws + WS_VB);
    bf16_t* OB = (bf16_t*)(F.ws + WS_OB); const float* sinks = a.in[5];
    LAS unsigned char* imgK = F.lds; LAS unsigned char* imgV = F.lds + 65536;
    const int lane = F.lane, g = lane >> 4, ql = lane & 15, q4 = (lane & 15) >> 2, p4 = lane & 3;
    f32x4 mlo, mhi;
#pragma unroll
    for (int e = 0; e < 4; ++e) { mlo[e] = (4 * g + e >= ql) ? 0.f : -INFINITY; mhi[e] = (4 * g + e <= ql) ? 0.f : -INFINITY; }
    const int per = (512 + F.G - 1) / F.G;
    int res_bk = -1, res_hi = -1000;
#define SWA_LOAD_BLOCK(bk, blk) do { const int slot_ = ((blk) + 1) & 3; const bool ok_ = (blk) >= 0 && (blk) < SEQ / 128; \
        for (int j = F.wave; j < 32; j += 8) { const int isv = j >> 4, pc = j & 15; \
            if (ok_) { const size_t tok0 = (size_t)(bk) * SEQ + (blk) * 128 + pc * 8; \
                if (isv) dma_piece<true>(VB + tok0 * 64, imgV + slot_ * 16384, pc * 8, lane); else dma_piece<false>(KB + tok0 * 64, imgK + slot_ * 16384, pc * 8, lane); } \
            else if (isv) { *(LAS u32x4*)(imgV + slot_ * 16384 + pc * 1024 + lane * 16) = (u32x4){0u, 0u, 0u, 0u}; } } } while (0)
    for (int i = 0; i < per; ++i) {
        const int u = F.vcu * per + i; if (u >= 512) break;
        const int n = u & 63, kvh = (u >> 6) & 1, b = u >> 7, bk = b * 2 + kvh;
        if (res_bk != bk || res_hi != n + 1) {
            __syncthreads();
            const bool keep2 = (res_bk == bk && res_hi == n);
            if (!keep2) { SWA_LOAD_BLOCK(bk, n - 1); SWA_LOAD_BLOCK(bk, n); }
            SWA_LOAD_BLOCK(bk, n + 1);
        }
        asm volatile("s_waitcnt vmcnt(0)" ::: "memory");
        __syncthreads();
        res_bk = bk; res_hi = n + 1;
        if (i + 1 < per && u + 1 < 512 && ((u + 1) >> 6) == (u >> 6)) { SWA_LOAD_BLOCK(bk, n + 2); res_hi = n + 2; }
        const int hq = 4 * kvh + (F.wave >> 1), half = F.wave & 1;
        const float sink2 = sinks[hq] * LOG2E;
        const bf16_t* qbase = QB + ((size_t)(b * 8 + hq) * SEQ + 128 * n + 64 * half + ql) * 64 + 8 * g;
        bf16x8 qc0 = *(const bf16x8*)qbase, qc1 = *(const bf16x8*)(qbase + 32);
        const int kswz0 = (g ^ ((ql >> 1) & 7)) << 4, kswz1 = ((4 + g) ^ ((ql >> 1) & 7)) << 4;
        const int vk0 = 4 * g + q4; int vterm[4];
#pragma unroll
        for (int dt = 0; dt < 4; ++dt) vterm[dt] = (((2 * dt + (p4 >> 1)) ^ (((vk0 >> 1) & 3) << 1)) << 4) + (p4 & 1) * 8;
#pragma unroll 1
        for (int sub = 0; sub < 4; ++sub) {
            const int qrel0 = 64 * half + 16 * sub, qpos0 = 128 * n + qrel0;
            const bf16x8 qf0 = qc0, qf1 = qc1;
            if (sub < 3) { qc0 = *(const bf16x8*)(qbase + (sub + 1) * 1024); qc1 = *(const bf16x8*)(qbase + (sub + 1) * 1024 + 32); }
            const int kpos = 128 * n + qrel0 + ql, vpos = 128 * n + qrel0 + vk0;
            f32x4 S[17];
            bf16x8 kA[4][2], kB[4][2];
#define SW_KLD(buf, j, t) do { const LAS unsigned char* p_ = imgK + (((kpos + 16 * (t)) & 511) << 7); buf[j][0] = *(const LAS bf16x8*)(p_ + kswz0); buf[j][1] = *(const LAS bf16x8*)(p_ + kswz1); } while (0)
#define SW_KMM(buf, j, t) do { const f32x4 c_ = ((t) == 0) ? mlo : ((t) == 16) ? mhi : (f32x4){0.f, 0.f, 0.f, 0.f}; f32x4 s_ = MFMA16(buf[j][0], qf0, c_); s_ = MFMA16(buf[j][1], qf1, s_); \
                S[t] = s_; } while (0)
            SW_KLD(kA, 0, 0); SW_KLD(kA, 1, 1); SW_KLD(kA, 2, 2); SW_KLD(kA, 3, 3);
            SW_KLD(kB, 0, 4); SW_KLD(kB, 1, 5); SW_KLD(kB, 2, 6); SW_KLD(kB, 3, 7); __builtin_amdgcn_sched_barrier(0);
            SW_KMM(kA, 0, 0); SW_KMM(kA, 1, 1); SW_KMM(kA, 2, 2); SW_KMM(kA, 3, 3); __builtin_amdgcn_sched_barrier(0);
            SW_KLD(kA, 0, 8); SW_KLD(kA, 1, 9); SW_KLD(kA, 2, 10); SW_KLD(kA, 3, 11); __builtin_amdgcn_sched_barrier(0);
            SW_KMM(kB, 0, 4); SW_KMM(kB, 1, 5); SW_KMM(kB, 2, 6); SW_KMM(kB, 3, 7); __builtin_amdgcn_sched_barrier(0);
            SW_KLD(kB, 0, 12); SW_KLD(kB, 1, 13); SW_KLD(kB, 2, 14); SW_KLD(kB, 3, 15); __builtin_amdgcn_sched_barrier(0);
            SW_KMM(kA, 0, 8); SW_KMM(kA, 1, 9); SW_KMM(kA, 2, 10); SW_KMM(kA, 3, 11); __builtin_amdgcn_sched_barrier(0);
            SW_KLD(kA, 0, 16); __builtin_amdgcn_sched_barrier(0);
            SW_KMM(kB, 0, 12); SW_KMM(kB, 1, 13); SW_KMM(kB, 2, 14); SW_KMM(kB, 3, 15); __builtin_amdgcn_sched_barrier(0);
            SW_KMM(kA, 0, 16);
#undef SW_KLD
#undef SW_KMM
            if (n == 0 || n == SEQ / 128 - 1) {
#pragma unroll
                for (int t = 0; t < 17; ++t) { const int kp_ = qpos0 - 128 + 16 * t; if (kp_ < 0 || kp_ >= SEQ) S[t] = (f32x4){-INFINITY, -INFINITY, -INFINITY, -INFINITY}; }
            }
            float m = -INFINITY;
#pragma unroll
            for (int t = 0; t < 17; ++t) { m = fmaxf(fmaxf(m, S[t][0]), S[t][1]); m = fmaxf(fmaxf(m, S[t][2]), S[t][3]); }
            m = fmaxf(xmax16_32(m), sink2);
#pragma unroll
            for (int t = 0; t < 17; ++t)
#pragma unroll
                for (int e = 0; e < 4; ++e) S[t][e] = __builtin_amdgcn_exp2f(S[t][e] - m);
            f32x4 o[4], osum = {0.f, 0.f, 0.f, 0.f};
#pragma unroll
            for (int dt = 0; dt < 4; ++dt) o[dt] = (f32x4){0.f, 0.f, 0.f, 0.f};
            const f32x4 zero4 = {0.f, 0.f, 0.f, 0.f};
            const bf16x8 ones8 = {0x3F80, 0x3F80, 0x3F80, 0x3F80, 0x3F80, 0x3F80, 0x3F80, 0x3F80};
            s16x4 vA[4][2], vB[4][2];
#define SW_VLD(buf, ks) do { const int ta_ = 2 * (ks), tb_ = (2 * (ks) + 1 < 17) ? 2 * (ks) + 1 : 2 * (ks); \
                const LAS unsigned char* pa_ = imgV + (((vpos + 16 * ta_) & 511) << 7); const LAS unsigned char* pb_ = imgV + (((vpos + 16 * tb_) & 511) << 7); \
                _Pragma("unroll") for (int dt = 0; dt < 4; ++dt) { \
                    buf[dt][0] = __builtin_bit_cast(s16x4, __builtin_amdgcn_ds_read_tr16_b64_v4i16((LAS v4i16_t*)(pa_ + vterm[dt]))); \
                    buf[dt][1] = __builtin_bit_cast(s16x4, __builtin_amdgcn_ds_read_tr16_b64_v4i16((LAS v4i16_t*)(pb_ + vterm[dt]))); } } while (0)
#define SW_VMM(buf, ks) do { const bf16x8 pp_ = pack8(S[2 * (ks)], (2 * (ks) + 1 < 17) ? S[(2 * (ks) + 1 < 17) ? 2 * (ks) + 1 : 0] : zero4); \
                _Pragma("unroll") for (int dt = 0; dt < 4; ++dt) { const bf16x8 vf_ = {buf[dt][0][0], buf[dt][0][1], buf[dt][0][2], buf[dt][0][3], buf[dt][1][0], buf[dt][1][1], buf[dt][1][2], buf[dt][1][3]}; \
                    o[dt] = MFMA16(vf_, pp_, o[dt]); } osum = MFMA16(ones8, pp_, osum); } while (0)
            SW_VLD(vA, 0); SW_VLD(vB, 1); __builtin_amdgcn_sched_barrier(0);
            SW_VMM(vA, 0); __builtin_amdgcn_sched_barrier(0); SW_VLD(vA, 2); __builtin_amdgcn_sched_barrier(0);
            SW_VMM(vB, 1); __builtin_amdgcn_sched_barrier(0); SW_VLD(vB, 3); __builtin_amdgcn_sched_barrier(0);
            SW_VMM(vA, 2); __builtin_amdgcn_sched_barrier(0); SW_VLD(vA, 4); __builtin_amdgcn_sched_barrier(0);
            SW_VMM(vB, 3); __builtin_amdgcn_sched_barrier(0); SW_VLD(vB, 5); __builtin_amdgcn_sched_barrier(0);
            SW_VMM(vA, 4); __builtin_amdgcn_sched_barrier(0); SW_VLD(vA, 6); __builtin_amdgcn_sched_barrier(0);
            SW_VMM(vB, 5); __builtin_amdgcn_sched_barrier(0); SW_VLD(vB, 7); __builtin_amdgcn_sched_barrier(0);
            SW_VMM(vA, 6); __builtin_amdgcn_sched_barrier(0); SW_VLD(vA, 8); __builtin_amdgcn_sched_barrier(0);
            SW_VMM(vB, 7); __builtin_amdgcn_sched_barrier(0);
            SW_VMM(vA, 8);
#undef SW_VLD
#undef SW_VMM
            const float inv = 1.0f / (osum[0] + __builtin_amdgcn_exp2f(sink2 - m));
            bf16_t* op = OB + ((size_t)b * SEQ + qpos0 + ql) * 512 + hq * 64 + 4 * g;
#pragma unroll
            for (int dt = 0; dt < 4; ++dt) { u32x2 w; w.x = pk2(o[dt][0] * inv, o[dt][1] * inv); w.y = pk2(o[dt][2] * inv, o[dt][3] * inv); *(u32x2*)(op + 16 * dt) = w; }
        }
    }
#undef SWA_LOAD_BLOCK
    asm volatile("s_waitcnt vmcnt(0)" ::: "memory");
    __syncthreads();
}

__device__ __forceinline__ void router_phase(Frame& F, const Args& a) {
    const float* x = a.in[0]; bf16_t* AO = (bf16_t*)(F.ws + WS_AO); const float* g2 = a.in[9]; const float* wr_ = a.in[10]; const float* br = a.in[11];
    unsigned char* H2N = (unsigned char*)(F.ws + WS_H2N); float* gwl = (float*)(F.ws + WS_GWL); int* list = (int*)(F.ws + WS_LIST); int* inv = (int*)(F.ws + WS_INV);
    unsigned* counts = (unsigned*)(F.ws + WS_CTL) + CW_CNT;
    LAS float* wL = (LAS float*)F.lds;
    LAS float* lgs = (LAS float*)(F.lds + RING_BYTES) + F.wave * 512;
    LAS int* sel = (LAS int*)(F.lds + SEL_OFF); LAS float* selg = (LAS float*)(F.lds + SELG_OFF);
    {
        f32x4 wv[16]; float gk[16];
#pragma unroll
        for (int j = 0; j < 16; ++j) { const int i4 = F.tid + NTHREADS * j; wv[j] = *((const f32x4*)wr_ + i4); gk[j] = g2[i4 >> 3]; }
#pragma unroll
        for (int j = 0; j < 16; ++j) { const int i = 4 * (F.tid + NTHREADS * j), k = i >> 5, e = i & 31;
#pragma unroll
            for (int c = 0; c < 4; ++c) wL[k * 32 + 2 * ((e + c) & 15) + ((e + c) >> 4)] = wv[j][c] * gk[j]; }
    }
    __syncthreads();
    const int lane = F.lane, ti = lane & 15, q = lane >> 4;
    for (int ch = blockIdx.x; ch < T / 128; ch += F.G) {
        const int t0 = ch * 128 + F.wave * 16;
        const float* xrow = x + (size_t)(t0 + ti) * D + 4 * q; bf16_t* arow = AO + (size_t)(t0 + ti) * D + 4 * q;
        f32x4 acc0 = {0.f, 0.f, 0.f, 0.f}, acc1 = {0.f, 0.f, 0.f, 0.f}; float ss = 0.f;
#pragma unroll 4
        for (int s = 0; s < 64; ++s) {
            f32x4 v = *(const f32x4*)(xrow + 16 * s); const u32x2 w = *(const u32x2*)(arow + 16 * s);
            v.x += bflo(w.x); v.y += bfhi(w.x); v.z += bflo(w.y); v.w += bfhi(w.y);
            { u32x2 xb; xb.x = pk2(v.x, v.y); xb.y = pk2(v.z, v.w); *(u32x2*)(arow + 16 * s) = xb; }
            ss += (v.x * v.x + v.y * v.y) + (v.z * v.z + v.w * v.w);
            const LAS float* wp = wL + (16 * s + 4 * q) * 32 + 2 * ti;
#pragma unroll
            for (int u = 0; u < 4; ++u) {
                const f32x2 b = *(const LAS f32x2*)(wp + 32 * u);
                acc0 = __builtin_amdgcn_mfma_f32_16x16x4f32(v[u], b.x, acc0, 0, 0, 0);
                acc1 = __builtin_amdgcn_mfma_f32_16x16x4f32(v[u], b.y, acc1, 0, 0, 0);
            }
        }
        ss += __shfl_xor(ss, 16); ss += __shfl_xor(ss, 32);
        const float rstd = 1.0f / sqrtf(ss * (1.f / D) + RMS_EPS);
#pragma unroll
        for (int r = 0; r < 4; ++r) { lgs[(4 * q + r) * 32 + ti] = acc0[r]; lgs[(4 * q + r) * 32 + 16 + ti] = acc1[r]; }
        asm volatile("s_waitcnt lgkmcnt(0)" ::: "memory");
        if (lane < 16) {
            float lg[32];
#pragma unroll
            for (int e4 = 0; e4 < 8; ++e4) { const f32x4 v4 = *(const LAS f32x4*)(lgs + lane * 32 + 4 * e4); const f32x4 b4 = *(const f32x4*)(br + 4 * e4);
                lg[4 * e4] = v4.x * rstd + b4.x; lg[4 * e4 + 1] = v4.y * rstd + b4.y; lg[4 * e4 + 2] = v4.z * rstd + b4.z; lg[4 * e4 + 3] = v4.w * rstd + b4.w; }
            float tv[4]; int tix[4];
#pragma unroll
            for (int k = 0; k < 4; ++k) {
                float best = -INFINITY; int bi = 0;
#pragma unroll
                for (int e = 0; e < 32; ++e) if (lg[e] > best) { best = lg[e]; bi = e; }
#pragma unroll
                for (int e = 0; e < 32; ++e) lg[e] = (e == bi) ? -INFINITY : lg[e];
                tv[k] = best; tix[k] = bi;
            }
            const float e1 = __expf(tv[1] - tv[0]), e2 = __expf(tv[2] - tv[0]), e3 = __expf(tv[3] - tv[0]);
            const float inv = 1.0f / (1.0f + e1 + e2 + e3);
            const int rloc = F.wave * 16 + lane;
            sel[rloc * 4 + 0] = tix[0]; sel[rloc * 4 + 1] = tix[1]; sel[rloc * 4 + 2] = tix[2]; sel[rloc * 4 + 3] = tix[3];
            selg[rloc * 4 + 0] = inv; selg[rloc * 4 + 1] = e1 * inv; selg[rloc * 4 + 2] = e2 * inv; selg[rloc * 4 + 3] = e3 * inv;
        }
#pragma unroll 4
        for (int r = 0; r < 16; ++r) {
            const float rq = __shfl(rstd, r) * F8_ACT; const int t = t0 + r;
            const u32x4* ar = (const u32x4*)(AO + (size_t)t * D) + 2 * lane;
            const u32x4 wa = ar[0], wb = ar[1];
            u32x4 o; o.x = pk4_fp8(bflo(wa.x) * rq, bfhi(wa.x) * rq, bflo(wa.y) * rq, bfhi(wa.y) * rq); o.y = pk4_fp8(bflo(wa.z) * rq, bfhi(wa.z) * rq, bflo(wa.w) * rq, bfhi(wa.w) * rq);
            o.z = pk4_fp8(bflo(wb.x) * rq, bfhi(wb.x) * rq, bflo(wb.y) * rq, bfhi(wb.y) * rq); o.w = pk4_fp8(bflo(wb.z) * rq, bfhi(wb.z) * rq, bflo(wb.w) * rq, bfhi(wb.w) * rq);
            *((u32x4*)(H2N + (size_t)t * D) + lane) = o;
        }
        LAS int* lcnt = (LAS int*)(F.lds + TS_OFF) + 96; LAS int* lbase = lcnt + 32;
        if (F.tid < 32) lcnt[F.tid] = 0;
        __syncthreads();
        const int myj = F.tid, mye = sel[myj];
        const int mypos = __hip_atomic_fetch_add(lcnt + mye, 1, __ATOMIC_RELAXED, __HIP_MEMORY_SCOPE_WORKGROUP);
        __syncthreads();
        if (F.tid < 32) { const int c = lcnt[F.tid]; lbase[F.tid] = c > 0 ? (int)__hip_atomic_fetch_add(counts + F.tid, (unsigned)c, RLX_AGENT) : 0; }
        __syncthreads();
        { const int idx = lbase[mye] + mypos, slot = mye * LISTCAP + idx, tk = (ch * 128 + (myj >> 2)) * 4 + (myj & 3); list[slot] = tk; gwl[slot] = selg[myj]; inv[tk] = (mye << 16) | idx; }
        __syncthreads();
    }
}

__device__ __forceinline__ void moe_tables(Frame& F) {
    LAS int* ts = (LAS int*)(F.lds + TS_OFF); LAS int* cn = ts + 40;
    unsigned* counts = (unsigned*)(F.ws + WS_CTL) + CW_CNT;
    if (F.tid < 32) cn[F.tid] = (int)__hip_atomic_load(counts + F.tid, RLX_AGENT);
    __syncthreads();
    if (F.tid == 0) { int s = 0; for (int e = 0; e < 32; ++e) { ts[e] = s; s += (cn[e] + 255) >> 8; } ts[32] = s; ts[33] = 0x7fffffff; }
    __syncthreads();
    { LAS unsigned char* t2e = F.lds + T2E_OFF; const int total = ts[32];
      for (int m = F.tid; m < total; m += NTHREADS) { int e = 0; while (ts[e + 1] <= m) ++e; t2e[m] = (unsigned char)e; } }
    __syncthreads();
}

__device__ __forceinline__ void combine_phase(Frame& F, const Args& a) {
    moe_tables(F);
    const LAS int* ts = (const LAS int*)(F.lds + TS_OFF);
    float* out = a.out; const float* x = a.in[0]; const float* fg = a.in[16]; const unsigned char* Y = (const unsigned char*)(F.ws + WS_YTK); const bf16_t* AO = (const bf16_t*)(F.ws + WS_AO);
    const int* inv = (const int*)(F.ws + WS_INV);
    const int gw = F.vcu * NWAVES + F.wave, NGW = F.G * NWAVES;
    f32x4 gv[4];
#pragma unroll
    for (int j = 0; j < 4; ++j) gv[j] = *((const f32x4*)fg + F.lane + 64 * j);
    const int ntok = (T - gw + NGW - 1) / NGW;
    for (int i0 = 0; i0 < ntok; i0 += 16) {
        const int ti_ = i0 + (F.lane >> 2); int invv = 0;
        if (ti_ < ntok) invv = __hip_atomic_load(inv + 4 * (size_t)(gw + ti_ * NGW) + (F.lane & 3), RLX_AGENT);
        const int rowv = ts[(invv >> 16) & 31] * 256 + (invv & 0xffff);
        const int nloc = min(16, ntok - i0);
#define CB_LOAD(AV, YV, i_) do { const int t_ = gw + (i0 + (i_)) * NGW; int row_[4]; \
            _Pragma("unroll") for (int k = 0; k < 4; ++k) row_[k] = __builtin_amdgcn_readlane(rowv, 4 * (i_) + k); \
            _Pragma("unroll") for (int j = 0; j < 4; ++j) { AV[j] = *((const u32x2*)(AO + (size_t)t_ * D) + F.lane + 64 * j); \
                _Pragma("unroll") for (int k = 0; k < 4; ++k) YV[k][j] = *((const unsigned*)(Y + (size_t)row_[k] * D) + F.lane + 64 * j); } } while (0)
#define CB_PROC(AV, YV, i_) do { const int t_ = gw + (i0 + (i_)) * NGW; f32x4 v[4]; float ss = 0.f; \
            _Pragma("unroll") for (int j = 0; j < 4; ++j) { f32x4 ysum = {0.f, 0.f, 0.f, 0.f}; \
                _Pragma("unroll") for (int k = 0; k < 4; ++k) { const f32x2 lo2 = __builtin_amdgcn_cvt_pk_f32_fp8((int)YV[k][j], false), hi2 = __builtin_amdgcn_cvt_pk_f32_fp8((int)YV[k][j], true); \
                    ysum.x += lo2.x; ysum.y += lo2.y; ysum.z += hi2.x; ysum.w += hi2.y; } \
                v[j] = ysum * F8_YINV; v[j].x += bflo(AV[j].x); v[j].y += bfhi(AV[j].x); v[j].z += bflo(AV[j].y); v[j].w += bfhi(AV[j].y); \
                ss += (v[j].x * v[j].x + v[j].y * v[j].y) + (v[j].z * v[j].z + v[j].w * v[j].w); } \
            const float rstd = 1.0f / sqrtf(wave_sum(ss) * (1.f / D) + RMS_EPS); f32x4* orow = (f32x4*)(out + (size_t)t_ * D) + F.lane; \
            _Pragma("unroll") for (int j = 0; j < 4; ++j) orow[64 * j] = v[j] * rstd * gv[j]; } while (0)
        u32x2 avA[4], avB[4]; unsigned yvA[4][4], yvB[4][4];
        CB_LOAD(avA, yvA, 0);
#pragma unroll 1
        for (int i = 0; i < nloc; i += 2) {
            if (i + 1 < nloc) CB_LOAD(avB, yvB, i + 1);
            CB_PROC(avA, yvA, i);
            if (i + 2 < nloc) CB_LOAD(avA, yvA, i + 2);
            if (i + 1 < nloc) CB_PROC(avB, yvB, i + 1);
        }
#undef CB_LOAD
#undef CB_PROC
    }
}

constexpr int N_PHASES = 9;
#ifndef PROBE_PHASE
#define PROBE_PHASE -1
#endif
#ifndef PROBE_REPS
#define PROBE_REPS 2
#endif
template <int k> __device__ __forceinline__ void run_phase(Frame& F0, const Args& args) {
    Frame F = F0; { int t_ = threadIdx.x; asm volatile("" : "+v"(t_)); F.tid = t_; F.lane = t_ & 63; F.wave = __builtin_amdgcn_readfirstlane(t_ >> 6); }
    if constexpr (k == 0) { p0_prologue(F, args); }
    else if constexpr (k == 1) {
        { DenseSched S; S.so.init(T, C_GA, F.G, (int)blockIdx.x); S.A = (const char*)(F.ws + WS_H1); S.lda = D * 2; S.Bt = (const char*)(F.ws + WS_WIN); S.K = 2 * D;
          EpiInProj E{F.ws, args.in[3], (const float*)(F.ws + WS_ROPE)};
          pg8::gemm_phase<true, true, false>(F.lds, 2 * D, S, E); }
        { DenseSched S; S.so.init(T, 2048, F.G, (int)blockIdx.x); if (F.G == 256) S.so.tail_lo = 128; S.A = (const char*)(F.ws + WS_H1Q); S.lda = D; S.Bt = (const char*)(F.ws + WS_WING8); S.K = D;
          EpiGate E{(bf16_t*)(F.ws + WS_SG), args.in[3]};
          pg8::gemm_phase<true, true, true>(F.lds, D, S, E); }
    } else if constexpr (k == 2) {
#if ATTN_NAIVE
        attn_naive(F, args);
#else
        na_phase(F, args); swa_phase(F, args);
#if PROBE_ATTN == 1
        na_phase(F, args); na_phase(F, args);
#elif PROBE_ATTN == 2
        swa_phase(F, args); swa_phase(F, args);
#endif
#endif
    } else if constexpr (k == 3) {
        UpSched S; S.so.init(T, D, F.G, (int)blockIdx.x); S.OA = (const char*)(F.ws + WS_OA); S.OB = (const char*)(F.ws + WS_OB); S.Wa = (const char*)(F.ws + WS_WA); S.Wb = (const char*)(F.ws + WS_WB);
        EpiUp E{(const bf16_t*)(F.ws + WS_SG), (bf16_t*)(F.ws + WS_MERGED)};
        pg8::gemm_phase<true, true, false>(F.lds, 2 * 512, S, E);
    } else if constexpr (k == 4) {
        DenseSched S; S.so.init(T, D, F.G, (int)blockIdx.x); S.A = (const char*)(F.ws + WS_MERGED); S.lda = D * 2; S.Bt = (const char*)(F.ws + WS_WOUT); S.K = 2 * D;
        EpiAo E{(bf16_t*)(F.ws + WS_AO)};
        pg8::gemm_phase<true, true, false>(F.lds, 2 * D, S, E);
    } else if constexpr (k == 5) { router_phase(F, args); }
    else if constexpr (k == 6) {
        moe_tables(F);
        const LAS int* ts = (const LAS int*)(F.lds + TS_OFF);
        MoeSched<true> S; S.tstart = ts; S.cnt = ts + 40; S.t2e = (const LAS unsigned char*)(F.lds + T2E_OFF); S.G = F.G; S.vcu = F.vcu; S.log_mt = 2; S.total = ts[32];
        S.A = (const char*)(F.ws + WS_H2N); S.list = (const int*)(F.ws + WS_LIST); S.Bt = (const char*)(F.ws + WS_W1); S.b_estride = (size_t)2 * FF * D; S.K = D;
        EpiMoe1 E{args.in[13], (unsigned char*)(F.ws + WS_HACT)};
        pg8::gemm_phase<true, true, true>(F.lds, D, S, E);
    } else if constexpr (k == 7) {
        moe_tables(F);
        const LAS int* ts = (const LAS int*)(F.lds + TS_OFF);
        MoeSched<false> S; S.tstart = ts; S.cnt = ts + 40; S.t2e = (const LAS unsigned char*)(F.lds + T2E_OFF); S.G = F.G; S.vcu = F.vcu; S.log_mt = 3; S.total = ts[32];
        S.A = (const char*)(F.ws + WS_HACT); S.list = (const int*)(F.ws + WS_LIST); S.Bt = (const char*)(F.ws + WS_W2); S.b_estride = (size_t)D * FF; S.K = FF;
        EpiMoe2 E{ts + 40, (const float*)(F.ws + WS_GWL), args.in[15], (unsigned char*)(F.ws + WS_YTK)};
        pg8::gemm_phase<true, true, true>(F.lds, FF, S, E);
    } else if constexpr (k == 8) { combine_phase(F, args); }
}
__global__ void __launch_bounds__(NTHREADS, 2) fwd_kernel(Args args) {
    extern __shared__ __attribute__((aligned(16))) unsigned char lds_raw[];
    Frame F;
    F.lds = (LAS unsigned char*)lds_raw;
    F.tid = threadIdx.x; F.lane = F.tid & 63; F.wave = __builtin_amdgcn_readfirstlane(F.tid >> 6);
    F.G = gridDim.x; { const int bx = blockIdx.x; F.vcu = (F.G % 8 == 0) ? (bx % 8) * (F.G / 8) + bx / 8 : bx; }
    F.ws = args.ws;
    volatile LAS unsigned* MISC = (volatile LAS unsigned*)(F.lds + MISC_OFF);
    for (int u = F.tid; u < 256; u += NTHREADS) MISC[u] = 0u;
    __syncthreads();
    unsigned* ctl = (unsigned*)(F.ws + WS_CTL);
    XcdBarrier bar; bar.bar = ctl + CW_BAR + args.li * XCD_BAR_WORDS; bar.x = 0; bar.st = nullptr;
    const int lo = args.ph_lo, hi = args.ph_hi;
    if (hi - lo > 1) bar = xcd_barrier_post(ctl + CW_BAR + args.li * XCD_BAR_WORDS, MISC + 8);
#define PHASE(k) do { if (lo <= (k) && (k) < hi) { run_phase<k>(F, args); if ((k) + 1 < hi) xcd_barrier(bar); } } while (0)
    PHASE(0); PHASE(1); PHASE(2); PHASE(3); PHASE(4); PHASE(5); PHASE(6); PHASE(7); PHASE(8);
#undef PHASE
}

extern "C" void kernel_launch(void* const* d_in, const int* in_sizes, int n_in, void* d_out, int out_size, void* d_ws, size_t ws_size, hipStream_t stream) {
    static int grid = 0;
    if (grid == 0) {
        if (n_in != 17 || in_sizes[0] != T * D || out_size != T * D || ws_size < WS_END) { fprintf(stderr, "kernel_launch: unexpected shapes (n_in %d, in0 %d, out %d, ws %zu); nothing launched\n", n_in, n_in > 0 ? in_sizes[0] : -1, out_size, ws_size); grid = -1; return; }
        int dev = 0, cus = 0, per_cu = 0;
        if (hipGetDevice(&dev) != hipSuccess || hipDeviceGetAttribute(&cus, hipDeviceAttributeMultiprocessorCount, dev) != hipSuccess) { grid = -1; return; }
        if (hipFuncSetAttribute((const void*)fwd_kernel, hipFuncAttributeMaxDynamicSharedMemorySize, LDS_BYTES) != hipSuccess) { fprintf(stderr, "kernel_launch: hipFuncSetAttribute failed\n"); grid = -1; return; }
        if (hipOccupancyMaxActiveBlocksPerMultiprocessor(&per_cu, (const void*)fwd_kernel, NTHREADS, LDS_BYTES) != hipSuccess || per_cu < 1) { fprintf(stderr, "kernel_launch: occupancy query reports %d blocks per CU\n", per_cu); per_cu = 1; }
        (void)hipGetLastError();
        grid = cus;
    }
    if (grid < 0) return;
    (void)hipMemsetAsync((char*)d_ws + WS_CTL, 0, CTL_ZERO_BYTES, stream);
    Args a{};
    for (int i = 0; i < 17; ++i) a.in[i] = (const float*)d_in[i];
    a.out = (float*)d_out; a.ws = (unsigned char*)d_ws;
    void* kargs[] = {&a};
#if MK_SPLIT
    for (int p = 0; p < N_PHASES; ++p) {
        a.ph_lo = p; a.ph_hi = p + 1; a.li = 0;
        hipLaunchKernelGGL(fwd_kernel, dim3(grid), dim3(NTHREADS), LDS_BYTES, stream, a);
    }
#elif PROBE_PHASE >= 0
    {
        int li = 0;
        a.ph_lo = 0; a.ph_hi = PROBE_PHASE + 1; a.li = li++;
        (void)hipLaunchCooperativeKernel((const void*)fwd_kernel, dim3(grid), dim3(NTHREADS), kargs, LDS_BYTES, stream);
        for (int r = 0; r < PROBE_REPS; ++r) { a.ph_lo = PROBE_PHASE; a.ph_hi = PROBE_PHASE + 1; a.li = li++;
            if (PROBE_PHASE == 5) (void)hipMemsetAsync((char*)d_ws + WS_CTL + CW_CNT * 4, 0, 128, stream);
            (void)hipLaunchCooperativeKernel((const void*)fwd_kernel, dim3(grid), dim3(NTHREADS), kargs, LDS_BYTES, stream); }
        if (PROBE_PHASE + 1 < N_PHASES) { a.ph_lo = PROBE_PHASE + 1; a.ph_hi = N_PHASES; a.li = li++;
            (void)hipLaunchCooperativeKernel((const void*)fwd_kernel, dim3(grid), dim3(NTHREADS), kargs, LDS_BYTES, stream); }
    }
#else
    a.ph_lo = 0; a.ph_hi = N_PHASES; a.li = 0;
    hipError_t e = hipLaunchCooperativeKernel((const void*)fwd_kernel, dim3(grid), dim3(NTHREADS), kargs, LDS_BYTES, stream);
    if (e != hipSuccess) fprintf(stderr, "kernel_launch: cooperative launch failed: %s (grid %d)\n", hipGetErrorString(e), grid);
#endif
}
```

```cpp
#include <hip/hip_runtime.h>
#include <cstdio>
#include <cstdint>

#ifndef PROBE_ATTN
#define PROBE_ATTN 0
#endif
#ifndef ATTN_NAIVE
#define ATTN_NAIVE 0
#endif
#ifndef MK_SPLIT
#define MK_SPLIT 0
#endif

#define LAS __attribute__((address_space(3)))
#define GAS __attribute__((address_space(1)))
typedef unsigned short bf16_t;
typedef short bf16x8 __attribute__((ext_vector_type(8)));
typedef float f32x4 __attribute__((ext_vector_type(4)));
typedef float f32x2 __attribute__((ext_vector_type(2)));
typedef unsigned u32x4 __attribute__((ext_vector_type(4)));
typedef unsigned u32x2 __attribute__((ext_vector_type(2)));
typedef __bf16 bf16x2_t __attribute__((ext_vector_type(2)));

constexpr int NB = 4, SEQ = 8192, T = NB * SEQ, D = 1024, DIN = 4352;
constexpr int NEXP = 32, FF = 1024, LISTCAP = 32768;
constexpr float RMS_EPS = 1e-5f;
constexpr float LOG2E = 1.4426950408889634f;
constexpr float QSCALE = 0.125f * LOG2E;
constexpr int C_QA = 0, C_KA = 512, C_VA = 1024, C_QB = 1536, C_KB = 2048, C_VB = 2176, C_GA = 2304, C_GB = 3328;

constexpr size_t MiB = 1u << 20;
constexpr size_t WS_CTL = 0, CTL_ZERO_BYTES = 1 * MiB;
constexpr size_t WS_ROPE = 1 * MiB;
constexpr size_t WS_BT = 3 * MiB;
constexpr size_t WS_WIN = 4 * MiB;
constexpr size_t WS_WA = 13 * MiB, WS_WB = 14 * MiB, WS_WOUT = 15 * MiB;
constexpr size_t WS_W2 = 17 * MiB;
constexpr size_t WS_GWL = 744 * MiB;
constexpr size_t WS_LIST = 83 * MiB;
constexpr size_t WS_AO = 88 * MiB;
constexpr size_t WS_PROJ = 152 * MiB;
constexpr size_t WS_QA = WS_PROJ, WS_KA = WS_PROJ + 32 * MiB, WS_VA = WS_PROJ + 64 * MiB, WS_QB = WS_PROJ + 96 * MiB;
constexpr size_t WS_KB = WS_PROJ + 128 * MiB, WS_VB = WS_PROJ + 136 * MiB;
constexpr size_t WS_SG = WS_PROJ + 144 * MiB;
constexpr size_t WS_HACT = WS_PROJ;
constexpr size_t WS_W1 = 424 * MiB;
constexpr size_t WS_H1 = 552 * MiB;
constexpr size_t WS_H2N = WS_H1;
constexpr size_t WS_OA = 616 * MiB, WS_OB = 648 * MiB;
constexpr size_t WS_MERGED = 680 * MiB;
constexpr size_t WS_YTK = 424 * MiB;
constexpr size_t WS_H1Q = 680 * MiB;
constexpr size_t WS_WING8 = 50 * MiB;
constexpr size_t WS_INV = 748 * MiB;
constexpr size_t WS_END = 749 * MiB;
constexpr int CW_CNT = 64;
constexpr int CW_BAR = 4096;

constexpr int RING_BYTES = 131072;
constexpr int ATT_BYTES = 147456;
constexpr int MISC_OFF = ATT_BYTES;
constexpr int SEL_OFF = MISC_OFF + 1024;
constexpr int SELG_OFF = SEL_OFF + 2048;
constexpr int TS_OFF = SELG_OFF + 2048;
constexpr int T2E_OFF = TS_OFF + 1536;
constexpr int LDS_BYTES = 155648;
constexpr int NWAVES = 8, NTHREADS = 512;

#define RLX_AGENT __ATOMIC_RELAXED, __HIP_MEMORY_SCOPE_AGENT

__device__ __forceinline__ unsigned f2bf(float f) { unsigned u = __builtin_bit_cast(unsigned, f); return (u + 0x7fffu + ((u >> 16) & 1u)) >> 16; }
__device__ __forceinline__ unsigned pk2(float lo, float hi) { f32x2 v = {lo, hi}; bf16x2_t b = __builtin_convertvector(v, bf16x2_t); return __builtin_bit_cast(unsigned, b); }
constexpr float F8_ACT = 4.0f, F8_W = 128.0f, F8_INV = 1.0f / 512.0f, F8_Y = 32.0f, F8_YINV = 1.0f / 32.0f;
__device__ __forceinline__ unsigned pk4_fp8(float a, float b, float c, float d) { int w = 0; w = __builtin_amdgcn_cvt_pk_fp8_f32(a, b, w, false); w = __builtin_amdgcn_cvt_pk_fp8_f32(c, d, w, true); return (unsigned)w; }
__device__ __forceinline__ float bflo(unsigned w) { return __uint_as_float(w << 16); }
__device__ __forceinline__ float bfhi(unsigned w) { return __uint_as_float(w & 0xffff0000u); }
__device__ __forceinline__ float sigmoidf_(float x) { return __builtin_amdgcn_rcpf(1.0f + __builtin_amdgcn_exp2f(-x * LOG2E)); }
__device__ __forceinline__ const char* uniform_ptr(const char* p) {
    const unsigned long long v = (unsigned long long)p;
    const unsigned lo = __builtin_amdgcn_readfirstlane((unsigned)v), hi = __builtin_amdgcn_readfirstlane((unsigned)(v >> 32));
    return (const char*)(((unsigned long long)hi << 32) | lo);
}
__device__ __forceinline__ float wave_sum(float v) {
#pragma unroll
    for (int o = 1; o < 64; o <<= 1) v += __shfl_xor(v, o);
    return v;
}

namespace pg8 {
constexpr int BM = 256, BK = 64, HALF = 128, HTB = HALF * BK * 2, STAGE_BYTES = 8 * HTB, NXCD = 8, WGM = 8;
__host__ __device__ __forceinline__ int lds_byte(int r, int c) { const int st = (r >> 4) * 2 + (c >> 5), rr = r & 15, cc = c & 31, ob = rr * 64 + cc * 2; return st * 1024 + (ob ^ (((ob >> 9) & 1) << 5)); }
__host__ __device__ __forceinline__ void stage_rc(int b, int& R, int& C) { const int st = b / 1024, sb = b % 1024, swz = sb ^ (((sb >> 9) & 1) << 5); R = (st >> 1) * 16 + swz / 64; C = (st & 1) * 32 + (swz % 64) / 2; }
__host__ __device__ __forceinline__ int perm32(int rho) { const int n = rho >> 4, i = rho & 15; return 8 * (i >> 2) + 4 * n + (i & 3); }

struct Unit { int pm, pn, e, mt, part; };

struct StaticOrder {
    int nM, nN, nwg, G, c, tail_lo;
    __device__ void init(int M, int N, int G_, int c_) { nM = M / BM; nN = N / BM; nwg = nM * nN; G = G_; c = c_; tail_lo = -1; }
    __device__ bool next(int i, Unit& u) const {
        long L = (long)i * G + c;
        if (tail_lo >= 0 && i >= 3) { if (c < tail_lo || i >= 5) return false; L = 3L * G + 2 * (c - tail_lo) + (i - 3); }
        if (L >= nwg) return false;
        int wgid = (int)L; { const int q = nwg / NXCD, r = nwg % NXCD, xcd = wgid % NXCD, off = wgid / NXCD; wgid = (xcd < r ? xcd * (q + 1) : r * (q + 1) + (xcd - r) * q) + off; }
        const int nig = WGM * nN, gid = wgid / nig, fm = gid * WGM, gsz = (nM - fm) < WGM ? (nM - fm) : WGM;
        u.pm = fm + ((wgid % nig) % gsz); u.pn = (wgid % nig) / gsz; u.e = 0; u.mt = 0; u.part = 0; return true;
    }
};

typedef int v8i32_t __attribute__((ext_vector_type(8)));
typedef int v4i32_t __attribute__((ext_vector_type(4)));
__device__ __forceinline__ v8i32_t cat8(const bf16x8& a, const bf16x8& b) { const v4i32_t x = __builtin_bit_cast(v4i32_t, a), y = __builtin_bit_cast(v4i32_t, b); return __builtin_shufflevector(x, y, 0, 1, 2, 3, 4, 5, 6, 7); }
template <bool PERM, bool ALIGN_EPI, bool FP8, class Sched, class Epi>
__device__ __forceinline__ void gemm_phase(LAS unsigned char* lds, const int KB, const Sched& S, const Epi& E) {
    const int tid = threadIdx.x, wid = __builtin_amdgcn_readfirstlane(tid >> 6), lane = tid & 63, wr = wid >> 2, wc = wid & 3, fr = lane & 15, fq = lane >> 4;
    const int nt = KB / 128;
    int R[2], C2[2]; unsigned voffB[2];
#pragma unroll
    for (int i = 0; i < 2; ++i) { int r_, c_; stage_rc(tid * 16 + i * 8192, r_, c_); R[i] = r_; C2[i] = c_ * 2; const int Rb = PERM ? ((r_ & ~31) + perm32(r_ & 31)) : r_; voffB[i] = (unsigned)(Rb * KB + c_ * 2); }
    const size_t kstep = (size_t)(BK * 2);
    const size_t hstepB = (size_t)HALF * KB;
    const unsigned ldsw = (unsigned)wid * 1024u;
    const int aoff = lds_byte(wr * 64 + fr, fq * 8), boff = lds_byte(wc * 32 + fr, fq * 8);
#define PG8_SA(b, h) (((b) * 2 + (h)) * HTB)
#define PG8_SB(b, h) ((4 + (b) * 2 + (h)) * HTB)
#define PG8_STAGE_B(bufoff, gbase) do { _Pragma("unroll") for (int _i = 0; _i < 2; ++_i) \
        __builtin_amdgcn_global_load_lds((const unsigned*)((const char*)(gbase) + voffB[_i]), (LAS unsigned*)(lds + (bufoff) + ldsw + _i * 8192), 16, 0, 0); } while (0)
#define PG8_STAGE_A(bufoff, gbase, o0, o1) do { \
        __builtin_amdgcn_global_load_lds((const unsigned*)((const char*)(gbase) + (o0)), (LAS unsigned*)(lds + (bufoff) + ldsw), 16, 0, 0); \
        __builtin_amdgcn_global_load_lds((const unsigned*)((const char*)(gbase) + (o1)), (LAS unsigned*)(lds + (bufoff) + ldsw + 8192), 16, 0, 0); } while (0)
#define PG8_LDA(dst, b, h) do { _Pragma("unroll") for (int m = 0; m < 4; ++m) { const LAS unsigned char* p_ = lds + PG8_SA(b, h) + aoff + m * 2048; \
        dst[m] = __builtin_shufflevector(*(const LAS v4i32_t*)p_, *(const LAS v4i32_t*)(p_ + 1024), 0, 1, 2, 3, 4, 5, 6, 7); } } while (0)
#define PG8_LDB(dst, b, h) do { _Pragma("unroll") for (int n = 0; n < 2; ++n) { const LAS unsigned char* p_ = lds + PG8_SB(b, h) + boff + n * 2048; \
        dst[n] = __builtin_shufflevector(*(const LAS v4i32_t*)p_, *(const LAS v4i32_t*)(p_ + 1024), 0, 1, 2, 3, 4, 5, 6, 7); } } while (0)
#define PG8_LO(v) __builtin_bit_cast(bf16x8, __builtin_shufflevector(v, v, 0, 1, 2, 3))
#define PG8_HI(v) __builtin_bit_cast(bf16x8, __builtin_shufflevector(v, v, 4, 5, 6, 7))
#define PG8_MMA(ai, bj, At, Bt) do { __builtin_amdgcn_s_setprio(1); _Pragma("unroll") for (int m = 0; m < 4; ++m) _Pragma("unroll") for (int n = 0; n < 2; ++n) { \
        if constexpr (FP8) asm volatile("v_mfma_scale_f32_16x16x128_f8f6f4 %0, %1, %2, %0, %3, %3 op_sel_hi:[0,0,0]" : "+v"(acc[ai][bj][m][n]) : "v"(Bt[n]), "v"(At[m]), "v"(one_scale)); \
        else { acc[ai][bj][m][n] = __builtin_amdgcn_mfma_f32_16x16x32_bf16(PG8_LO(Bt[n]), PG8_LO(At[m]), acc[ai][bj][m][n], 0, 0, 0); \
               acc[ai][bj][m][n] = __builtin_amdgcn_mfma_f32_16x16x32_bf16(PG8_HI(Bt[n]), PG8_HI(At[m]), acc[ai][bj][m][n], 0, 0, 0); } } \
        __builtin_amdgcn_s_setprio(0); } while (0)
#define PG8_WAIT_V(n) asm volatile("s_waitcnt vmcnt(" #n ")" ::: "memory")
#define PG8_WAIT_L(n) asm volatile("s_waitcnt lgkmcnt(" #n ")" ::: "memory")
#define PG8_BAR __builtin_amdgcn_s_barrier()
#define PG8_SCHED __builtin_amdgcn_sched_barrier(0)
    Unit cur, nxt; int ui = 0;
    if (!S.next(0, cur)) return;
    f32x4 acc[2][2][4][2];
#pragma unroll
    for (int a = 0; a < 2; ++a)
#pragma unroll
        for (int b = 0; b < 2; ++b)
#pragma unroll
            for (int m = 0; m < 4; ++m)
#pragma unroll
                for (int n = 0; n < 2; ++n) acc[a][b][m][n] = (f32x4){0.f, 0.f, 0.f, 0.f};
    v8i32_t At[4], B0[2], B1[2];
    const int one_scale = 0x7f7f7f7f;
    const char* cA = S.a_base(cur); const char* cB = S.b_base(cur);
    LAS unsigned char* const eslot0 = lds + STAGE_BYTES;
    if (wid == 0) E.prefetch(cur, eslot0, lane);
    if constexpr (Sched::GATHER) { if (wid == 0) S.rows_prefetch(cur, eslot0 + 2048, lane); asm volatile("s_waitcnt vmcnt(0)" ::: "memory"); __syncthreads(); }
    unsigned oA00 = S.a_off(cur, R[0], eslot0 + 2048) + C2[0], oA01 = S.a_off(cur, R[1], eslot0 + 2048) + C2[1], oA10 = S.a_off(cur, HALF + R[0], eslot0 + 2048) + C2[0], oA11 = S.a_off(cur, HALF + R[1], eslot0 + 2048) + C2[1];
    PG8_STAGE_B(PG8_SB(0, 0), cB); PG8_STAGE_B(PG8_SB(0, 1), cB + hstepB); PG8_STAGE_A(PG8_SA(0, 0), cA, oA00, oA01); PG8_STAGE_A(PG8_SA(0, 1), cA, oA10, oA11);
    if (wr == 1) PG8_BAR;
    PG8_WAIT_V(2); PG8_BAR;
    PG8_STAGE_B(PG8_SB(1, 0), cB + kstep); PG8_STAGE_A(PG8_SA(1, 0), cA + kstep, oA00, oA01); PG8_STAGE_B(PG8_SB(1, 1), cB + hstepB + kstep);
    PG8_WAIT_V(6); PG8_BAR;
    for (;;) {
        const bool has_next = S.next(ui + 1, nxt);
        const char* nA = has_next ? S.a_base(nxt) : cA; const char* nB = has_next ? S.b_base(nxt) : cB;
        LAS unsigned char* const nrows = eslot0 + ((ui + 1) & 1) * 4096 + 2048;
        if constexpr (Sched::GATHER) { if (has_next && wid == 0) S.rows_prefetch(nxt, nrows, lane); }
        for (int t = 0; t < nt; t += 2) {
            const bool last = (t == nt - 2);
            const char* a1 = cA + (size_t)(t + 1) * kstep;
            const char* a2 = last ? nA : cA + (size_t)(t + 2) * kstep; const char* b2 = last ? nB : cB + (size_t)(t + 2) * kstep;
            const char* a3 = a2 + kstep; const char* b3 = b2 + kstep;
            unsigned p00 = oA00, p01 = oA01;
            if (last && has_next) { p00 = S.a_off(nxt, R[0], nrows) + C2[0]; p01 = S.a_off(nxt, R[1], nrows) + C2[1]; }
            PG8_LDB(B0, 0, 0); PG8_LDB(B1, 0, 1); PG8_SCHED; PG8_LDA(At, 0, 0); PG8_STAGE_A(PG8_SA(1, 1), a1, oA10, oA11);
            PG8_WAIT_V(8); PG8_WAIT_L(0); PG8_BAR; PG8_MMA(0, 0, At, B0); PG8_MMA(0, 1, At, B1); PG8_BAR; PG8_SCHED;
            unsigned p10 = oA10, p11 = oA11;
            if (last && has_next) { p10 = S.a_off(nxt, HALF + R[0], nrows) + C2[0]; p11 = S.a_off(nxt, HALF + R[1], nrows) + C2[1]; }
            PG8_LDA(At, 0, 1); PG8_STAGE_B(PG8_SB(0, 0), b2); PG8_STAGE_B(PG8_SB(0, 1), b2 + hstepB); PG8_STAGE_A(PG8_SA(0, 0), a2, p00, p01);
            PG8_WAIT_V(8); PG8_WAIT_L(0); PG8_BAR; PG8_MMA(1, 0, At, B0); PG8_MMA(1, 1, At, B1); PG8_BAR; PG8_SCHED;
            PG8_LDB(B0, 1, 0); PG8_LDB(B1, 1, 1); PG8_SCHED; PG8_LDA(At, 1, 0); PG8_STAGE_A(PG8_SA(0, 1), a2, p10, p11);
            PG8_WAIT_V(8); PG8_WAIT_L(0); PG8_BAR; PG8_MMA(0, 0, At, B0); PG8_MMA(0, 1, At, B1); PG8_BAR; PG8_SCHED;
            PG8_LDA(At, 1, 1); PG8_STAGE_B(PG8_SB(1, 0), b3); PG8_STAGE_B(PG8_SB(1, 1), b3 + hstepB); PG8_STAGE_A(PG8_SA(1, 0), a3, p00, p01);
            PG8_WAIT_V(8); PG8_WAIT_L(0); PG8_BAR; PG8_MMA(1, 0, At, B0); PG8_MMA(1, 1, At, B1); PG8_BAR; PG8_SCHED;
            if (last) { oA00 = p00; oA01 = p01; oA10 = p10; oA11 = p11; }
        }
        if constexpr (ALIGN_EPI) { if (wr == 0) PG8_BAR; }
        if constexpr (FP8) asm volatile("s_nop 15\n\ts_nop 7" ::: "memory");
        const bool zero = E(acc, cur, wr, wc, fr, fq, eslot0 + (ui & 1) * 4096);
        if (!has_next) break;
        if (zero) {
#pragma unroll
            for (int a = 0; a < 2; ++a)
#pragma unroll
                for (int b = 0; b < 2; ++b)
#pragma unroll
                    for (int m = 0; m < 4; ++m)
#pragma unroll
                        for (int n = 0; n < 2; ++n) acc[a][b][m][n] = (f32x4){0.f, 0.f, 0.f, 0.f};
        }
        cur = nxt; cA = nA; cB = nB; ++ui;
        if (wid == 0) E.prefetch(cur, eslot0 + (ui & 1) * 4096, lane);
        if constexpr (ALIGN_EPI) { if (wr == 1) PG8_BAR; }
    }
    PG8_WAIT_V(0);
    if constexpr (!ALIGN_EPI) { if (wr == 0) PG8_BAR; }
    PG8_BAR;
#undef PG8_SA
#undef PG8_SB
#undef PG8_STAGE_A
#undef PG8_STAGE_B
#undef PG8_LDA
#undef PG8_LDB
#undef PG8_MMA
#undef PG8_LO
#undef PG8_HI
#undef PG8_WAIT_V
#undef PG8_WAIT_L
#undef PG8_BAR
#undef PG8_SCHED
}
}
using pg8::Unit;

#define XB_TMO      128
#define XB_XCNT(j)  (256  + 64 * (j))
#define XB_XSUB(j)  (1280 + 64 * (j))
#define XB_XGEN(j)  (2304 + 64 * (j))
#define XB_TOP      3328
#define XB_TOPGEN   3392
#define XCD_BAR_WORDS 3456
#define XB_SPIN_CAP (1u << 18)
__device__ __forceinline__ unsigned xb_ld(unsigned* p)              { return __hip_atomic_load(p, __ATOMIC_RELAXED, __HIP_MEMORY_SCOPE_AGENT); }
__device__ __forceinline__ unsigned xb_add(unsigned* p, unsigned v) { return __hip_atomic_fetch_add(p, v, __ATOMIC_RELAXED, __HIP_MEMORY_SCOPE_AGENT); }
__device__ __forceinline__ unsigned xb_xcc_id() { return (unsigned)__builtin_amdgcn_s_getreg((3 << 11) | 20) & 0xFu; }
#define XB_SPIN(cond, bar) do { unsigned _sp = 0; while (cond) { __builtin_amdgcn_s_sleep(1); \
    if ((++_sp & 255u) == 0u) { if (xb_ld(&(bar)[XB_TMO])) break; if (_sp > XB_SPIN_CAP) { atomicAdd(&(bar)[XB_TMO], 1u); break; } } } } while (0)
struct XcdBarrier { unsigned* bar; unsigned x; volatile LAS unsigned* st; };
__device__ __forceinline__ XcdBarrier xcd_barrier_post(unsigned* bar, volatile LAS unsigned* st) {
    XcdBarrier b; b.bar = bar; b.x = xb_xcc_id(); b.st = st;
    if (threadIdx.x == 0) (void)xb_add(&bar[XB_XCNT(b.x)], 1u);
    return b;
}
__device__ __forceinline__ void xcd_barrier_complete(unsigned* bar, unsigned x, unsigned& nloc, unsigned& nx) {
    const unsigned G = gridDim.x * gridDim.y * gridDim.z;
    unsigned sum, cnt, mine, sp = 0u;
    for (;;) {
        sum = 0u; cnt = 0u; mine = 0u;
#pragma unroll
        for (unsigned j = 0; j < 16; ++j) { const unsigned c = xb_ld(&bar[XB_XCNT(j)]); sum += c; cnt += (c > 0u) ? 1u : 0u; mine = (j == x) ? c : mine; }
        if (sum == G) break;
        __builtin_amdgcn_s_sleep(1);
        if ((++sp & 255u) == 0u) { if (xb_ld(&bar[XB_TMO])) break; if (sp > XB_SPIN_CAP) { atomicAdd(&bar[XB_TMO], 1u); break; } }
    }
    nloc = mine > 0u ? mine : 1u; nx = cnt > 0u ? cnt : 1u;
}
__device__ __forceinline__ void xcd_barrier(const XcdBarrier& b) {
    asm volatile("s_waitcnt vmcnt(0)" ::: "memory");
    __syncthreads();
    if (threadIdx.x == 0) {
        unsigned* bar = b.bar;
        __builtin_amdgcn_s_waitcnt(0);
        unsigned nloc = b.st[0], nx = b.st[1];
        if (nloc == 0u) { xcd_barrier_complete(bar, b.x, nloc, nx); b.st[0] = nloc; b.st[1] = nx; }
        const unsigned old = xb_add(&bar[XB_XSUB(b.x)], 1u);
        const unsigned gen = old / nloc;
        if (old + 1u == (gen + 1u) * nloc) {
            __builtin_amdgcn_fence(__ATOMIC_RELEASE, "agent");
            asm volatile("s_waitcnt vmcnt(0)" ::: "memory");
            const unsigned og = xb_add(&bar[XB_TOP], 1u);
            const unsigned tg = og / nx;
            if (og + 1u == (tg + 1u) * nx) xb_add(&bar[XB_TOPGEN], 1u);
            else XB_SPIN(xb_ld(&bar[XB_TOPGEN]) == tg, bar);
            __builtin_amdgcn_fence(__ATOMIC_ACQUIRE, "agent");
            xb_add(&bar[XB_XGEN(b.x)], 1u);
            asm volatile("s_waitcnt vmcnt(0)" ::: "memory");
        } else {
            XB_SPIN(xb_ld(&bar[XB_XGEN(b.x)]) == gen, bar);
            __builtin_amdgcn_fence(__ATOMIC_ACQUIRE, "agent");
            asm volatile("s_waitcnt vmcnt(0)" ::: "memory");
        }
    }
    __syncthreads();
}

struct Args { const float* in[17]; float* out; unsigned char* ws; int ph_lo, ph_hi, li, pad; };
struct Frame {
    LAS unsigned char* lds;
    int tid, lane, wave, G, vcu;
    unsigned char* ws;
};

struct MapId { __device__ __forceinline__ int operator()(int n) const { return n; } };
struct MapWin { __device__ __forceinline__ int operator()(int n) const {
    const int tile = n >> 8, bj = (n >> 7) & 1;
    if (tile == 6 || tile == 7 || (tile == 8 && bj == 0)) {
        const int hb = n & ~127, p = n & 127, wc = p >> 5, fq = (p >> 3) & 3, nn = (p >> 2) & 1, e = p & 3;
        return hb + 64 * (wc >> 1) + 32 * nn + 16 * (wc & 1) + 4 * fq + e;
    }
    return n; } };
struct MapGate { __device__ __forceinline__ int operator()(int n) const { return C_GA + 1024 * ((n >> 7) & 1) + 128 * (n >> 8) + (n & 127); } };
struct MapY16 { __device__ __forceinline__ int operator()(int n) const { const int p = n & 255, bj = p >> 7, wc = (p >> 5) & 3, fq = (p >> 3) & 3, j = p & 7; return (n & ~255) + 64 * wc + 16 * fq + 8 * bj + j; } };
struct MapW1 { __device__ __forceinline__ int operator()(int n) const { const int pn = n >> 8, r = n & 255; return 1024 * (r >> 7) + 128 * pn + (r & 127); } };

template <class Map>
__device__ __forceinline__ void p0_transpose_item(const float* W, int K, int N, bf16_t* WT, LAS float* scr, int item, int lane, const Map& map, const float* kscale, int ncols = 0) {
    const int nblk = (ncols ? ncols : N) / 64, kb = item / nblk, nb = item % nblk, k0 = 64 * kb, n0 = 64 * nb;
    const int srcc = map(n0 + 4 * (lane & 15));
    f32x4 v[16];
#pragma unroll
    for (int i = 0; i < 16; ++i) v[i] = *(const f32x4*)(W + (size_t)(k0 + 4 * i + (lane >> 4)) * N + srcc);
    if (kscale) {
#pragma unroll
        for (int i = 0; i < 16; ++i) v[i] = v[i] * kscale[k0 + 4 * i + (lane >> 4)];
    }
#pragma unroll
    for (int i = 0; i < 16; ++i) *(LAS f32x4*)(scr + (4 * i + (lane >> 4)) * 68 + 4 * (lane & 15)) = v[i];
    asm volatile("s_waitcnt lgkmcnt(0)" ::: "memory");
    const int kc = lane & 7, ngl = lane >> 3;
#pragma unroll
    for (int pp = 0; pp < 2; ++pp) {
        const int ng = 8 * pp + ngl; f32x4 r[8];
#pragma unroll
        for (int j = 0; j < 8; ++j) r[j] = *(const LAS f32x4*)(scr + (8 * kc + j) * 68 + 4 * ng);
#pragma unroll
        for (int e = 0; e < 4; ++e) { u32x4 o; o.x = pk2(r[0][e], r[1][e]); o.y = pk2(r[2][e], r[3][e]); o.z = pk2(r[4][e], r[5][e]); o.w = pk2(r[6][e], r[7][e]);
            *(u32x4*)(WT + (size_t)(n0 + 4 * ng + e) * K + k0 + 8 * kc) = o; }
    }
    asm volatile("s_waitcnt lgkmcnt(0)" ::: "memory");
}

template <class Map>
__device__ __forceinline__ void p0_transpose_item_fp8(const float* W, int K, int N, unsigned char* WT, LAS float* scr, int item, int lane, const Map& map, const float* kscale, float scale, int pitch = 0) {
    if (pitch == 0) pitch = N;
    const int nblk = N / 32, kb = item / nblk, nb = item % nblk, k0 = 128 * kb, n0 = 32 * nb;
    const int srcc = map(n0 + 4 * (lane & 7));
    f32x4 v[16];
#pragma unroll
    for (int i = 0; i < 16; ++i) v[i] = *(const f32x4*)(W + (size_t)(k0 + 8 * i + (lane >> 3)) * pitch + srcc);
#pragma unroll
    for (int i = 0; i < 16; ++i) v[i] = v[i] * (kscale ? kscale[k0 + 8 * i + (lane >> 3)] * scale : scale);
#pragma unroll
    for (int i = 0; i < 16; ++i) *(LAS f32x4*)(scr + (8 * i + (lane >> 3)) * 36 + 4 * (lane & 7)) = v[i];
    asm volatile("s_waitcnt lgkmcnt(0)" ::: "memory");
    const int kc = lane & 15, ngl = lane >> 4;
#pragma unroll
    for (int pp = 0; pp < 2; ++pp) {
        const int ng = 4 * pp + ngl; f32x4 r[8];
#pragma unroll
        for (int j = 0; j < 8; ++j) r[j] = *(const LAS f32x4*)(scr + (8 * kc + j) * 36 + 4 * ng);
#pragma unroll
        for (int e = 0; e < 4; ++e) { u32x2 o; o.x = pk4_fp8(r[0][e], r[1][e], r[2][e], r[3][e]); o.y = pk4_fp8(r[4][e], r[5][e], r[6][e], r[7][e]);
            *(u32x2*)(WT + (size_t)(n0 + 4 * ng + e) * K + k0 + 8 * kc) = o; }
    }
    asm volatile("s_waitcnt lgkmcnt(0)" ::: "memory");
}

struct F8Item { const float* W; unsigned char* WT; int K, N, k0, n0, srcc; f32x4 ks0, ks1; };
template <class Map> __device__ __forceinline__ void f8_item_load(F8Item& I, const float* W, int K, int N, unsigned char* WT, int item, int lane, const Map& map, const float* kscale, f32x4 (&v)[16]) {
    const int nblk = N / 32, kb = item / nblk, nb = item % nblk;
    I.W = W; I.WT = WT; I.K = K; I.N = N; I.k0 = 128 * kb; I.n0 = 32 * nb; I.srcc = map(I.n0 + 4 * (lane & 7));
    if (kscale) { const float* kp = kscale + I.k0 + 8 * (lane & 15); I.ks0 = *(const f32x4*)kp; I.ks1 = *(const f32x4*)(kp + 4); }
    else { I.ks0 = (f32x4){1.f, 1.f, 1.f, 1.f}; I.ks1 = I.ks0; }
#pragma unroll
    for (int i = 0; i < 16; ++i) v[i] = *(const f32x4*)(W + (size_t)(I.k0 + 8 * i + (lane >> 3)) * N + I.srcc);
}
__device__ __forceinline__ void f8_item_finish(const F8Item& I, LAS float* scr, int lane, f32x4 (&v)[16], float scale) {
#pragma unroll
    for (int i = 0; i < 16; ++i) *(LAS f32x4*)(scr + (8 * i + (lane >> 3)) * 36 + 4 * (lane & 7)) = v[i];
    asm volatile("s_waitcnt lgkmcnt(0)" ::: "memory");
    const int kc = lane & 15, ngl = lane >> 4;
    const f32x4 s0 = I.ks0 * scale, s1 = I.ks1 * scale;
#pragma unroll
    for (int pp = 0; pp < 2; ++pp) {
        const int ng = 4 * pp + ngl; f32x4 r[8];
#pragma unroll
        for (int j = 0; j < 8; ++j) r[j] = *(const LAS f32x4*)(scr + (8 * kc + j) * 36 + 4 * ng) * (j < 4 ? s0[j] : s1[j - 4]);
#pragma unroll
        for (int e = 0; e < 4; ++e) { u32x2 o; o.x = pk4_fp8(r[0][e], r[1][e], r[2][e], r[3][e]); o.y = pk4_fp8(r[4][e], r[5][e], r[6][e], r[7][e]);
            *(u32x2*)(I.WT + (size_t)(I.n0 + 4 * ng + e) * I.K + I.k0 + 8 * kc) = o; }
    }
    asm volatile("s_waitcnt lgkmcnt(0)" ::: "memory");
}

__device__ __forceinline__ void p0_prologue(Frame& F, const Args& a) {
    LAS float* scr = (LAS float*)(F.lds + F.wave * 18432);
    const int gw = F.vcu * NWAVES + F.wave, NGW = F.G * NWAVES;
    const float* w_in = a.in[2]; const float* w_up_a = a.in[6]; const float* w_up_b = a.in[7]; const float* w_out = a.in[8];
    const float* w1 = a.in[12]; const float* w2 = a.in[14]; const float* g2 = a.in[9];
    bf16_t* Win_t = (bf16_t*)(F.ws + WS_WIN); bf16_t* Wa_t = (bf16_t*)(F.ws + WS_WA); bf16_t* Wb_t = (bf16_t*)(F.ws + WS_WB); bf16_t* Wout_t = (bf16_t*)(F.ws + WS_WOUT);
    unsigned char* W1_t = (unsigned char*)(F.ws + WS_W1); unsigned char* W2_t = (unsigned char*)(F.ws + WS_W2);
    constexpr int I_IN = (D / 64) * (C_GA / 64), I_G8 = (D / 128) * (2048 / 32), I_UP = (512 / 64) * (D / 64), I_OUT = (D / 64) * (D / 64), I_W1 = (D / 128) * (2 * FF / 32), I_W2 = (FF / 128) * (D / 32);
        constexpr int NSMALL = I_IN + I_G8 + 2 * I_UP + I_OUT, NEXPERT = NEXP * (I_W1 + I_W2);
    for (int it = gw; it < NSMALL; it += NGW) {
        int r = it;
        if (r < I_IN) { p0_transpose_item(w_in, D, DIN, Win_t, scr, r, F.lane, MapWin(), nullptr, C_GA); continue; } r -= I_IN;
        if (r < I_G8) { p0_transpose_item_fp8(w_in, D, 2048, (unsigned char*)(F.ws + WS_WING8), scr, r, F.lane, MapGate(), nullptr, F8_W, DIN); continue; } r -= I_G8;
        if (r < I_UP) { p0_transpose_item(w_up_a, 512, D, Wa_t, scr, r, F.lane, MapId(), nullptr); continue; } r -= I_UP;
        if (r < I_UP) { p0_transpose_item(w_up_b, 512, D, Wb_t, scr, r, F.lane, MapId(), nullptr); continue; } r -= I_UP;
        p0_transpose_item(w_out, D, D, Wout_t, scr, r, F.lane, MapId(), nullptr);
    }
#define F8_LOAD(I_, V_, r_) do { const int rr_ = (r_); const bool w1_ = rr_ < NEXP * I_W1; const int r2_ = w1_ ? rr_ : rr_ - NEXP * I_W1; \
        const int e_ = w1_ ? r2_ / I_W1 : r2_ / I_W2, q_ = w1_ ? r2_ % I_W1 : r2_ % I_W2, N_ = w1_ ? 2 * FF : D, nblk_ = N_ / 32, kb_ = q_ / nblk_, nb_ = q_ % nblk_; \
        I_.W = w1_ ? w1 + (size_t)e_ * D * 2 * FF : w2 + (size_t)e_ * FF * D; I_.WT = w1_ ? W1_t + (size_t)e_ * 2 * FF * D : W2_t + (size_t)e_ * D * FF; \
        I_.K = D; I_.N = N_; I_.k0 = 128 * kb_; I_.n0 = 32 * nb_; { const int n_ = I_.n0 + 4 * (F.lane & 7); I_.srcc = w1_ ? MapW1()(n_) : MapY16()(n_); } \
        { const float* kp_ = g2 + I_.k0 + 8 * (F.lane & 15); const f32x4 k0_ = *(const f32x4*)kp_, k1_ = *(const f32x4*)(kp_ + 4); const f32x4 one_ = {1.f, 1.f, 1.f, 1.f}; \
          I_.ks0 = w1_ ? k0_ : one_; I_.ks1 = w1_ ? k1_ : one_; } \
        _Pragma("unroll") for (int i_ = 0; i_ < 16; ++i_) V_[i_] = *(const f32x4*)(I_.W + (size_t)(I_.k0 + 8 * i_ + (F.lane >> 3)) * N_ + I_.srcc); } while (0)
    {
        static_assert(D == FF && (NEXP * ((D / 128) * (2 * FF / 32) + (FF / 128) * (D / 32))) % 8 == 0, "expert items: K = 1024 for both weight sets, item count a multiple of the waves per block");
        F8Item IA, IB; f32x4 va[16], vb[16];
        int r = gw;
        if (r < NEXPERT) {
            F8_LOAD(IA, va, r);
#pragma unroll 1
            for (;;) {
                const bool hb = r + NGW < NEXPERT; __builtin_amdgcn_s_barrier(); F8_LOAD(IB, vb, hb ? r + NGW : r);
                f8_item_finish(IA, scr, F.lane, va, F8_W);
                if (!hb) break;
                const bool ha = r + 2 * NGW < NEXPERT; __builtin_amdgcn_s_barrier(); F8_LOAD(IA, va, ha ? r + 2 * NGW : r + NGW);
                f8_item_finish(IB, scr, F.lane, vb, F8_W);
                if (!ha) break;
                r += 2 * NGW;
            }
        }
    }
#undef F8_LOAD
    const float* x = a.in[0]; const float* g1 = a.in[1]; bf16_t* H1 = (bf16_t*)(F.ws + WS_H1);
    f32x4 gv[4];
#pragma unroll
    for (int j = 0; j < 4; ++j) gv[j] = *((const f32x4*)g1 + F.lane + 64 * j);
    for (int m = 2 * gw; m < T; m += 2 * NGW) {
        const f32x4* xr = (const f32x4*)(x + (size_t)m * D) + F.lane;
        f32x4 v[2][4]; float s[2] = {0.f, 0.f};
#pragma unroll
        for (int q = 0; q < 2; ++q)
#pragma unroll
            for (int j = 0; j < 4; ++j) v[q][j] = xr[q * 256 + 64 * j];
#pragma unroll
        for (int q = 0; q < 2; ++q)
#pragma unroll
            for (int j = 0; j < 4; ++j) s[q] += (v[q][j].x * v[q][j].x + v[q][j].y * v[q][j].y) + (v[q][j].z * v[q][j].z + v[q][j].w * v[q][j].w);
#pragma unroll
        for (int q = 0; q < 2; ++q) {
            const float rstd = 1.0f / sqrtf(wave_sum(s[q]) * (1.f / D) + RMS_EPS);
            u32x2* o8 = (u32x2*)(H1 + (size_t)(m + q) * D) + F.lane; unsigned* o4 = (unsigned*)(F.ws + WS_H1Q + (size_t)(m + q) * D) + F.lane;
#pragma unroll
            for (int j = 0; j < 4; ++j) { const f32x4 hv = v[q][j] * rstd * gv[j]; u32x2 w; w.x = pk2(hv.x, hv.y); w.y = pk2(hv.z, hv.w); o8[64 * j] = w;
                o4[64 * j] = pk4_fp8(hv.x * F8_ACT, hv.y * F8_ACT, hv.z * F8_ACT, hv.w * F8_ACT); }
        }
    }
    float* rope = (float*)(F.ws + WS_ROPE);
    for (int idx = (F.vcu * NTHREADS + F.tid); idx < SEQ * 32; idx += F.G * NTHREADS) {
        const int pos = idx >> 5, i = idx & 31;
        const float invf = (float)exp2(-(double)i * (13.287712379549449 / 32.0));
        const float ang = (float)pos * invf;
        double rev = (double)ang * 0.15915494309189535; rev -= floor(rev);
        const float rv = (float)rev;
        rope[2 * idx] = __builtin_amdgcn_cosf(rv); rope[2 * idx + 1] = __builtin_amdgcn_sinf(rv);
    }
    float* bt = (float*)(F.ws + WS_BT); const float* rpb = a.in[4];
    for (int idx = (F.vcu * NTHREADS + F.tid); idx < 8 * 4 * 15 * 2 * 64 * 4; idx += F.G * NTHREADS) {
        const int reg = idx & 3, ln = (idx >> 2) & 63, hf = (idx >> 8) & 1; int rest = idx >> 9; const int dr = rest % 15; rest /= 15; const int gq = rest & 3, h = rest >> 2;
        const int c = 16 * gq + (ln & 15), base = (gq == 0) ? 0 : (gq == 1) ? 8 : (gq == 2) ? 24 : 32, kc = base + 16 * hf + 4 * (ln >> 4) + reg;
        const int cs = min(max(c - 8, 0), 48);
        bt[idx] = (kc >= cs && kc < cs + 16) ? rpb[h * 465 + dr * 31 + (kc - c + 15)] * LOG2E : -INFINITY;
    }
}

struct DenseSched {
    pg8::StaticOrder so; const char* A; unsigned lda; const char* Bt; int K;
    __device__ __forceinline__ bool next(int i, Unit& u) const { return so.next(i, u); }
    __device__ __forceinline__ const char* a_base(const Unit& u) const { return A + (size_t)u.pm * 256 * lda; }
    static constexpr bool GATHER = false;
    __device__ __forceinline__ unsigned a_off(const Unit&, int rho, const LAS unsigned char*) const { return (unsigned)rho * lda; }
    __device__ __forceinline__ const char* b_base(const Unit& u) const { return Bt + (size_t)u.pn * 256 * K; }
};
struct UpSched {
    pg8::StaticOrder so; const char* OA; const char* OB; const char* Wa; const char* Wb;
    __device__ __forceinline__ bool next(int i, Unit& u) const { const bool ok = so.next(i >> 1, u); u.part = i & 1; return ok; }
    __device__ __forceinline__ const char* a_base(const Unit& u) const { return (u.part ? OB : OA) + (size_t)u.pm * 256 * 1024; }
    static constexpr bool GATHER = false;
    __device__ __forceinline__ unsigned a_off(const Unit&, int rho, const LAS unsigned char*) const { return (unsigned)rho * 1024u; }
    __device__ __forceinline__ const char* b_base(const Unit& u) const { return (u.part ? Wb : Wa) + (size_t)u.pn * 256 * 512 * 2; }
};
template <bool GATHER_> struct MoeSched {
    static constexpr bool GATHER = GATHER_;
    const LAS int* tstart; const LAS int* cnt; const LAS unsigned char* t2e; int G, vcu, log_mt, total;
    const char* A; const int* list; const char* Bt; size_t b_estride; int K;
    __device__ __forceinline__ bool next(int i, Unit& u) const {
        const int L = i * G + vcu; const int blk = L >> 5, w = L & 31;
        const int mtg = (blk << log_mt) + (w & ((1 << log_mt) - 1)), pn = w >> log_mt;
        if (mtg >= total) return false;
        const int e = t2e[mtg];
        u.e = __builtin_amdgcn_readfirstlane(e); u.pm = __builtin_amdgcn_readfirstlane(mtg); u.mt = __builtin_amdgcn_readfirstlane(mtg - tstart[e]); u.pn = __builtin_amdgcn_readfirstlane(pn); u.part = 0; return true;
    }
    __device__ __forceinline__ const char* a_base(const Unit& u) const { return GATHER ? A : A + (size_t)u.pm * 256 * 1024; }
    __device__ __forceinline__ void rows_prefetch(const Unit& u, LAS unsigned char* dst, int lane) const {
        __builtin_amdgcn_global_load_lds((const unsigned*)(list + (size_t)u.e * LISTCAP + u.mt * 256 + 4 * lane), (LAS unsigned*)dst, 16, 0, 0); }
    __device__ __forceinline__ unsigned a_off(const Unit& u, int rho, const LAS unsigned char* rows) const {
        if (!GATHER) return (unsigned)rho * 1024u;
        const int tk = ((const LAS int*)rows)[rho];
        return (u.mt * 256 + rho < cnt[u.e]) ? (unsigned)(tk >> 2) * 1024u : 0u;
    }
    __device__ __forceinline__ const char* b_base(const Unit& u) const { return Bt + (size_t)u.e * b_estride + (size_t)u.pn * 256 * K; }
};

__device__ __forceinline__ size_t hm_off(int t, int nh, int h, int d) { return ((size_t)((t >> 13) * nh + h) * SEQ + (t & (SEQ - 1))) * 64 + d; }
struct EpiInProj {
    unsigned char* ws; const float* bias; const float* rope;
    __device__ __forceinline__ void prefetch(const Unit& u, LAS unsigned char* es, int lane) const {
        __builtin_amdgcn_global_load_lds((const unsigned*)(bias + 256 * u.pn + 4 * lane), (LAS unsigned*)es, 16, 0, 0); }
    __device__ __forceinline__ bool operator()(f32x4 (&acc)[2][2][4][2], const Unit& u, int wr, int wc, int fr, int fq, const LAS unsigned char* es) const {
        const int pn = u.pn; const int row0 = u.pm * 256 + wr * 64 + fr;
#pragma unroll
        for (int bj = 0; bj < 2; ++bj) {
            const bool rp = (pn == 6 || pn == 7 || (pn == 8 && bj == 0));
            const int hb = 256 * pn + 128 * bj;
            if (rp) {
                const int Lb = hb + 64 * (wc >> 1) + 16 * (wc & 1) + 4 * fq, i0 = 16 * (wc & 1) + 4 * fq;
                const LAS float* bl = (const LAS float*)es - 256 * pn;
                const f32x4 b1v = *(const LAS f32x4*)(bl + Lb), b2v = *(const LAS f32x4*)(bl + Lb + 32);
                const float sc = (pn <= 7) ? QSCALE : 1.0f;
                bf16_t* dst = (bf16_t*)(ws + (pn <= 7 ? WS_QB : WS_KB)); const int nh = (pn <= 7) ? 8 : 2; const int cl = Lb - (pn <= 7 ? C_QB : C_KB);
#pragma unroll
                for (int ai = 0; ai < 2; ++ai) {
                    f32x4 cs0a[4], cs1a[4];
#pragma unroll
                    for (int m = 0; m < 4; ++m) { const int pos = (row0 + ai * 128 + m * 16) & (SEQ - 1);
                        cs0a[m] = *(const f32x4*)(rope + (size_t)(pos * 32 + i0) * 2); cs1a[m] = *(const f32x4*)(rope + (size_t)(pos * 32 + i0) * 2 + 4); }
                    asm volatile("" ::: "memory");
#pragma unroll
                    for (int m = 0; m < 4; ++m) {
                        const int row = row0 + ai * 128 + m * 16;
                        const f32x4 cs0 = cs0a[m], cs1 = cs1a[m];
                        const f32x4 x1 = acc[ai][bj][m][0] + b1v, x2 = acc[ai][bj][m][1] + b2v;
                        const float c[4] = {cs0.x, cs0.z, cs1.x, cs1.z}, s[4] = {cs0.y, cs0.w, cs1.y, cs1.w};
                        float o1[4], o2[4];
#pragma unroll
                        for (int e = 0; e < 4; ++e) { o1[e] = (x1[e] * c[e] - x2[e] * s[e]) * sc; o2[e] = (x2[e] * c[e] + x1[e] * s[e]) * sc; }
                        bf16_t* rp_ = dst + hm_off(row, nh, cl >> 6, cl & 63);
                        u32x2 w1; w1.x = pk2(o1[0], o1[1]); w1.y = pk2(o1[2], o1[3]); *(u32x2*)rp_ = w1;
                        u32x2 w2; w2.x = pk2(o2[0], o2[1]); w2.y = pk2(o2[2], o2[3]); *(u32x2*)(rp_ + 32) = w2;
                    }
                }
            } else {
                const int c0 = hb + 32 * wc + 8 * fq;
                const LAS float* bl = (const LAS float*)es - 256 * pn;
                const f32x4 b0 = *(const LAS f32x4*)(bl + c0), b1 = *(const LAS f32x4*)(bl + c0 + 4);
                const int mode = (pn <= 1) ? 1 : (pn >= 9 ? 2 : 0);
                bf16_t* dst; int nh = 8, cl;
                if (pn <= 1) { dst = (bf16_t*)(ws + WS_QA); cl = c0 - C_QA; }
                else if (pn <= 3) { dst = (bf16_t*)(ws + WS_KA); cl = c0 - C_KA; }
                else if (pn <= 5) { dst = (bf16_t*)(ws + WS_VA); cl = c0 - C_VA; }
                else if (pn == 8) { dst = (bf16_t*)(ws + WS_VB); cl = c0 - C_VB; nh = 2; }
                else { dst = (bf16_t*)(ws + WS_SG); cl = c0 - C_GA; }
#pragma unroll
                for (int ai = 0; ai < 2; ++ai)
#pragma unroll
                    for (int m = 0; m < 4; ++m) {
                        const int row = row0 + ai * 128 + m * 16;
                        f32x4 v0 = acc[ai][bj][m][0] + b0, v1 = acc[ai][bj][m][1] + b1;
                        if (mode == 1) { v0 = v0 * QSCALE; v1 = v1 * QSCALE; }
                        if (mode == 2) {
#pragma unroll
                            for (int e = 0; e < 4; ++e) { v0[e] = sigmoidf_(v0[e]); v1[e] = sigmoidf_(v1[e]); } }
                        u32x4 w; w.x = pk2(v0[0], v0[1]); w.y = pk2(v0[2], v0[3]); w.z = pk2(v1[0], v1[1]); w.w = pk2(v1[2], v1[3]);
                        bf16_t* p_ = (pn >= 9) ? dst + (size_t)row * 2048 + cl : dst + hm_off(row, nh, cl >> 6, cl & 63);
                        *(u32x4*)p_ = w;
                    }
            }
        }
        return true;
    }
};
struct EpiGate {
    bf16_t* SG; const float* bias;
    __device__ __forceinline__ void prefetch(const Unit& u, LAS unsigned char* es, int lane) const {
        const float* s = bias + C_GA + 128 * u.pn + (lane < 32 ? 4 * lane : 1024 + 4 * (lane - 32));
        __builtin_amdgcn_global_load_lds((const unsigned*)s, (LAS unsigned*)es, 16, 0, 0); }
    __device__ __forceinline__ bool operator()(f32x4 (&acc)[2][2][4][2], const Unit& u, int wr, int wc, int fr, int fq, const LAS unsigned char* es) const {
        const int row0 = u.pm * 256 + wr * 64 + fr, ch = 32 * wc + 8 * fq;
        const LAS float* bl = (const LAS float*)es + ch;
        f32x4 za_b[2], zb_b[2];
        za_b[0] = *(const LAS f32x4*)bl * -LOG2E; za_b[1] = *(const LAS f32x4*)(bl + 4) * -LOG2E; zb_b[0] = *(const LAS f32x4*)(bl + 128) * -LOG2E; zb_b[1] = *(const LAS f32x4*)(bl + 132) * -LOG2E;
#pragma unroll
        for (int ai = 0; ai < 2; ++ai)
#pragma unroll
            for (int m = 0; m < 4; ++m) {
                const int row = row0 + ai * 128 + m * 16;
                float rt[8], sb[8];
#pragma unroll
                for (int n = 0; n < 2; ++n) {
                    const f32x4 za = acc[ai][0][m][n] * (-F8_INV * LOG2E) + za_b[n], zb = acc[ai][1][m][n] * (-F8_INV * LOG2E) + zb_b[n];
#pragma unroll
                    for (int e = 0; e < 4; ++e) {
                        const float da = 1.0f + __builtin_amdgcn_exp2f(fminf(za[e], 60.0f)), db = 1.0f + __builtin_amdgcn_exp2f(fminf(zb[e], 60.0f));
                        const float r = __builtin_amdgcn_rcpf(da * db), sga = db * r;
                        sb[4 * n + e] = da * r; rt[4 * n + e] = db * sga;
                    }
                }
                u32x4 w; w.x = pk2(rt[0], rt[1]); w.y = pk2(rt[2], rt[3]); w.z = pk2(rt[4], rt[5]); w.w = pk2(rt[6], rt[7]);
                *(u32x4*)(SG + (size_t)row * 2048 + 128 * u.pn + ch) = w;
                w.x = pk2(sb[0], sb[1]); w.y = pk2(sb[2], sb[3]); w.z = pk2(sb[4], sb[5]); w.w = pk2(sb[6], sb[7]);
                *(u32x4*)(SG + (size_t)row * 2048 + 1024 + 128 * u.pn + ch) = w;
            }
        return true;
    }
};
struct EpiUp {
    const bf16_t* P; bf16_t* Mg;
    __device__ __forceinline__ void prefetch(const Unit&, LAS unsigned char*, int) const {}
    template <int PART>
    __device__ __forceinline__ void run(f32x4 (&acc)[2][2][4][2], const Unit& u, int wr, int wc, int fr, int fq) const {
        const int row0 = u.pm * 256 + wr * 64 + fr, cb = u.pn * 256 + 32 * wc + 8 * fq;
        const bf16_t* Pp = P + (PART ? 1024 : 0) + (size_t)row0 * 2048 + cb;
        u32x4 g[2][4][2];
#pragma unroll
        for (int ai = 0; ai < 2; ++ai)
#pragma unroll
            for (int m = 0; m < 4; ++m)
#pragma unroll
                for (int bj = 0; bj < 2; ++bj) g[ai][m][bj] = *(const u32x4*)(Pp + (size_t)(ai * 128 + m * 16) * 2048 + 128 * bj);
        __builtin_amdgcn_sched_barrier(0);
#pragma unroll
        for (int ai = 0; ai < 2; ++ai)
#pragma unroll
            for (int m = 0; m < 4; ++m)
#pragma unroll
                for (int bj = 0; bj < 2; ++bj) {
                    const u32x4 gb = g[ai][m][bj];
                    const float sb[8] = {bflo(gb.x), bfhi(gb.x), bflo(gb.y), bfhi(gb.y), bflo(gb.z), bfhi(gb.z), bflo(gb.w), bfhi(gb.w)};
                    if constexpr (PART == 0) {
#pragma unroll
                        for (int e = 0; e < 4; ++e) { acc[ai][bj][m][0][e] *= sb[e]; acc[ai][bj][m][1][e] *= sb[4 + e]; }
                    } else {
                        const f32x4 v0 = acc[ai][bj][m][0], v1 = acc[ai][bj][m][1];
                        u32x4 w; w.x = pk2(v0[0] * sb[0], v0[1] * sb[1]); w.y = pk2(v0[2] * sb[2], v0[3] * sb[3]); w.z = pk2(v1[0] * sb[4], v1[1] * sb[5]); w.w = pk2(v1[2] * sb[6], v1[3] * sb[7]);
                        *(u32x4*)(Mg + (size_t)(row0 + ai * 128 + m * 16) * D + cb + 128 * bj) = w;
                    }
                }
    }
    __device__ __forceinline__ bool operator()(f32x4 (&acc)[2][2][4][2], const Unit& u, int wr, int wc, int fr, int fq, const LAS unsigned char* es) const {
        if (u.part == 0) run<0>(acc, u, wr, wc, fr, fq); else run<1>(acc, u, wr, wc, fr, fq);
        return u.part != 0;
    }
};
struct EpiAo {
    bf16_t* AO;
    __device__ __forceinline__ void prefetch(const Unit&, LAS unsigned char*, int) const {}
    __device__ __forceinline__ bool operator()(f32x4 (&acc)[2][2][4][2], const Unit& u, int wr, int wc, int fr, int fq, const LAS unsigned char* es) const {
        const int row0 = u.pm * 256 + wr * 64 + fr, col0 = u.pn * 256 + wc * 32 + 8 * fq;
#pragma unroll
        for (int ai = 0; ai < 2; ++ai)
#pragma unroll
            for (int m = 0; m < 4; ++m) {
                bf16_t* rowp = AO + (size_t)(row0 + ai * 128 + m * 16) * D + col0;
#pragma unroll
                for (int bj = 0; bj < 2; ++bj) { const f32x4 v0 = acc[ai][bj][m][0], v1 = acc[ai][bj][m][1];
                    u32x4 w; w.x = pk2(v0[0], v0[1]); w.y = pk2(v0[2], v0[3]); w.z = pk2(v1[0], v1[1]); w.w = pk2(v1[2], v1[3]); *(u32x4*)(rowp + bj * 128) = w; }
            }
        return true;
    }
};
struct EpiMoe1 {
    const float* b1; unsigned char* H;
    __device__ __forceinline__ void prefetch(const Unit& u, LAS unsigned char* es, int lane) const {
        const float* s = b1 + (size_t)u.e * 2 * FF + 128 * u.pn + (lane < 32 ? 4 * lane : FF + 4 * (lane - 32));
        __builtin_amdgcn_global_load_lds((const unsigned*)s, (LAS unsigned*)es, 16, 0, 0); }
    __device__ __forceinline__ bool operator()(f32x4 (&acc)[2][2][4][2], const Unit& u, int wr, int wc, int fr, int fq, const LAS unsigned char* es) const {
        const int p0 = 32 * wc + 8 * fq;
        const LAS float* bg = (const LAS float*)es + p0;
        constexpr float KS = -1.702f * LOG2E, QC = F8_ACT / KS;
        f32x4 bz[2], bq[2];
        bz[0] = *(const LAS f32x4*)bg * KS; bz[1] = *(const LAS f32x4*)(bg + 4) * KS; bq[0] = *(const LAS f32x4*)(bg + 128) * QC + QC; bq[1] = *(const LAS f32x4*)(bg + 132) * QC + QC;
#pragma unroll
        for (int ai = 0; ai < 2; ++ai)
#pragma unroll
            for (int m = 0; m < 4; ++m) {
                const int rho = 128 * ai + 64 * wr + 16 * m + fr;
                float a8[8];
#pragma unroll
                for (int n = 0; n < 2; ++n) {
                    const f32x4 z4 = acc[ai][0][m][n] * (F8_INV * KS) + bz[n], q4 = acc[ai][1][m][n] * (F8_INV * QC) + bq[n];
#pragma unroll
                    for (int p = 0; p < 2; ++p) {
                        f32x2 z = {__builtin_amdgcn_fmed3f(z4[2 * p], 7.0f * KS, 40.0f), __builtin_amdgcn_fmed3f(z4[2 * p + 1], 7.0f * KS, 40.0f)};
                        f32x2 q = {__builtin_amdgcn_fmed3f(q4[2 * p], 8.0f * QC, -6.0f * QC), __builtin_amdgcn_fmed3f(q4[2 * p + 1], 8.0f * QC, -6.0f * QC)};
                        f32x2 d = {__builtin_amdgcn_exp2f(z.x), __builtin_amdgcn_exp2f(z.y)};
                        d = d + 1.0f;
                        const f32x2 nn = q * z; const float r = __builtin_amdgcn_rcpf(d.x * d.y);
                        const f32x2 o = nn * __builtin_shufflevector(d, d, 1, 0) * r;
                        a8[4 * n + 2 * p] = o.x; a8[4 * n + 2 * p + 1] = o.y;
                    }
                }
                u32x2 w; w.x = pk4_fp8(a8[0], a8[1], a8[2], a8[3]); w.y = pk4_fp8(a8[4], a8[5], a8[6], a8[7]);
                *(u32x2*)(H + (size_t)(u.pm * 256 + rho) * FF + 128 * u.pn + p0) = w;
            }
        return true;
    }
};
struct EpiMoe2 {
    const LAS int* cnt; const float* gwl; const float* b2; unsigned char* Y;
    __device__ __forceinline__ void prefetch(const Unit& u, LAS unsigned char* es, int lane) const {
        __builtin_amdgcn_global_load_lds((const unsigned*)(b2 + (size_t)u.e * D + 256 * u.pn + 4 * lane), (LAS unsigned*)es, 16, 0, 0);
        __builtin_amdgcn_global_load_lds((const unsigned*)(gwl + (size_t)u.e * LISTCAP + u.mt * 256 + 4 * lane), (LAS unsigned*)(es + 1024), 16, 0, 0); }
    __device__ __forceinline__ bool operator()(f32x4 (&acc)[2][2][4][2], const Unit& u, int wr, int wc, int fr, int fq, const LAS unsigned char* es) const {
        const int n_e = cnt[u.e]; const int cl = 64 * wc + 16 * fq;
        f32x4 bv[2][2];
#pragma unroll
        for (int bj = 0; bj < 2; ++bj)
#pragma unroll
            for (int n = 0; n < 2; ++n) bv[bj][n] = *(const LAS f32x4*)((const LAS float*)es + cl + 8 * bj + 4 * n);
        float gw[2][4];
#pragma unroll
        for (int ai = 0; ai < 2; ++ai)
#pragma unroll
            for (int m = 0; m < 4; ++m) gw[ai][m] = ((const LAS float*)(es + 1024))[128 * ai + 64 * wr + 16 * m + fr] * F8_Y;
#pragma unroll
        for (int ai = 0; ai < 2; ++ai)
#pragma unroll
            for (int m = 0; m < 4; ++m) {
                const int rho = 128 * ai + 64 * wr + 16 * m + fr;
                if (u.mt * 256 + rho < n_e) {
                    const float g_ = gw[ai][m];
                    u32x4 w;
#pragma unroll
                    for (int bj = 0; bj < 2; ++bj) {
                        const f32x4 v0 = (acc[ai][bj][m][0] * F8_INV + bv[bj][0]) * g_, v1 = (acc[ai][bj][m][1] * F8_INV + bv[bj][1]) * g_;
                        w[2 * bj] = pk4_fp8(v0[0], v0[1], v0[2], v0[3]); w[2 * bj + 1] = pk4_fp8(v1[0], v1[1], v1[2], v1[3]);
                    }
                    *(u32x4*)(Y + (size_t)(u.pm * 256 + rho) * D + u.pn * 256 + cl) = w;
                }
            }
        return true;
    }
};

__device__ __forceinline__ void ld64(const bf16_t* p, float (&f)[64]) {
#pragma unroll
    for (int i = 0; i < 8; ++i) { const u32x4 w = *((const u32x4*)p + i); f[8 * i] = bflo(w.x); f[8 * i + 1] = bfhi(w.x); f[8 * i + 2] = bflo(w.y); f[8 * i + 3] = bfhi(w.y); f[8 * i + 4] = bflo(w.z); f[8 * i + 5] = bfhi(w.z); f[8 * i + 6] = bflo(w.w); f[8 * i + 7] = bfhi(w.w); }
}
__device__ __forceinline__ float dot64(const bf16_t* p, const float (&q)[64]) {
    float s = 0.f;
#pragma unroll
    for (int i = 0; i < 8; ++i) { const u32x4 w = *((const u32x4*)p + i);
        s += q[8 * i] * bflo(w.x) + q[8 * i + 1] * bfhi(w.x) + q[8 * i + 2] * bflo(w.y) + q[8 * i + 3] * bfhi(w.y) + q[8 * i + 4] * bflo(w.z) + q[8 * i + 5] * bfhi(w.z) + q[8 * i + 6] * bflo(w.w) + q[8 * i + 7] * bfhi(w.w); }
    return s;
}
__device__ __forceinline__ void axpy64(const bf16_t* p, float a, float pw, float (&o)[64]) {
#pragma unroll
    for (int i = 0; i < 8; ++i) { const u32x4 w = *((const u32x4*)p + i);
        o[8 * i] = o[8 * i] * a + pw * bflo(w.x); o[8 * i + 1] = o[8 * i + 1] * a + pw * bfhi(w.x); o[8 * i + 2] = o[8 * i + 2] * a + pw * bflo(w.y); o[8 * i + 3] = o[8 * i + 3] * a + pw * bfhi(w.y);
        o[8 * i + 4] = o[8 * i + 4] * a + pw * bflo(w.z); o[8 * i + 5] = o[8 * i + 5] * a + pw * bfhi(w.z); o[8 * i + 6] = o[8 * i + 6] * a + pw * bflo(w.w); o[8 * i + 7] = o[8 * i + 7] * a + pw * bfhi(w.w); }
}
__device__ __forceinline__ void st64(bf16_t* p, const float (&o)[64], float inv) {
#pragma unroll
    for (int i = 0; i < 8; ++i) { u32x4 w; w.x = pk2(o[8 * i] * inv, o[8 * i + 1] * inv); w.y = pk2(o[8 * i + 2] * inv, o[8 * i + 3] * inv); w.z = pk2(o[8 * i + 4] * inv, o[8 * i + 5] * inv); w.w = pk2(o[8 * i + 6] * inv, o[8 * i + 7] * inv); *((u32x4*)p + i) = w; }
}
__device__ __forceinline__ void attn_naive(Frame& F, const Args& a) {
    const bf16_t* QA = (const bf16_t*)(F.ws + WS_QA); const bf16_t* KA = (const bf16_t*)(F.ws + WS_KA); const bf16_t* VA = (const bf16_t*)(F.ws + WS_VA);
    const bf16_t* QB = (const bf16_t*)(F.ws + WS_QB); const bf16_t* KB = (const bf16_t*)(F.ws + WS_KB); const bf16_t* VB = (const bf16_t*)(F.ws + WS_VB);
    bf16_t* OA = (bf16_t*)(F.ws + WS_OA); bf16_t* OB = (bf16_t*)(F.ws + WS_OB);
    const float* rpb = a.in[4]; const float* sinks = a.in[5];
    const int gt = F.vcu * NTHREADS + F.tid, NGT = F.G * NTHREADS;
    for (int it = gt; it < T * 16; it += NGT) {
        const int t = it >> 4, hh = it & 15; const int b = t >> 13, s = t & (SEQ - 1);
        float q[64], o[64];
#pragma unroll
        for (int d = 0; d < 64; ++d) o[d] = 0.f;
        if (hh < 8) {
            const int h = hh, r = s >> 6, c = s & 63; const int rs = min(max(r - 4, 0), 120), cs = min(max(c - 8, 0), 48);
            ld64(QA + hm_off(t, 8, h, 0), q);
            float m = -INFINITY, l = 0.f;
            for (int kr = 0; kr < 8; ++kr)
                for (int kc = 0; kc < 16; ++kc) {
                    const int kt = (b << 13) + ((rs + kr) << 6) + cs + kc;
                    float sc = dot64(KA + hm_off(kt, 8, h, 0), q) + rpb[h * 15 * 31 + (rs + kr - r + 7) * 31 + (cs + kc - c + 15)] * LOG2E;
                    const float mn = fmaxf(m, sc), al = __builtin_amdgcn_exp2f(m - mn), pw = __builtin_amdgcn_exp2f(sc - mn);
                    l = l * al + pw; axpy64(VA + hm_off(kt, 8, h, 0), al, pw, o); m = mn;
                }
            st64(OA + (size_t)t * 512 + h * 64, o, 1.0f / l);
        } else {
            const int hq = hh - 8, kvh = hq >> 2;
            ld64(QB + hm_off(t, 8, hq, 0), q);
            float m = sinks[hq] * LOG2E, l = 1.f;
            const int j0 = max(s - 128, 0), j1 = min(s + 128, SEQ - 1);
            for (int j = j0; j <= j1; ++j) {
                const int kt = (b << 13) + j;
                const float sc = dot64(KB + hm_off(kt, 2, kvh, 0), q);
                const float mn = fmaxf(m, sc), al = __builtin_amdgcn_exp2f(m - mn), pw = __builtin_amdgcn_exp2f(sc - mn);
                l = l * al + pw; axpy64(VB + hm_off(kt, 2, kvh, 0), al, pw, o); m = mn;
            }
            st64(OB + (size_t)t * 512 + hq * 64, o, 1.0f / l);
        }
    }
}


typedef short s16x4 __attribute__((ext_vector_type(4)));
typedef short v4i16_t __attribute__((ext_vector_type(4)));
#define MFMA16(a, b, c) __builtin_amdgcn_mfma_f32_16x16x32_bf16((a), (b), (c), 0, 0, 0)
__device__ __forceinline__ bf16x8 ldK(const LAS unsigned char* img, int key, int chunk) { return *(const LAS bf16x8*)(img + key * 128 + ((chunk ^ ((key >> 1) & 7)) << 4)); }
__device__ __forceinline__ s16x4 ldVt(const LAS unsigned char* img, int key, int dt, int p) {
    const LAS unsigned char* a = img + key * 128 + (((2 * dt + (p >> 1)) ^ (((key >> 1) & 3) << 1)) << 4) + (p & 1) * 8;
    return __builtin_bit_cast(s16x4, __builtin_amdgcn_ds_read_tr16_b64_v4i16((LAS v4i16_t*)a)); }
template <bool ISV> __device__ __forceinline__ void dma_piece(const bf16_t* grow0, LAS unsigned char* img, int k0, int lane) {
    const int key = k0 + (lane >> 3), slot = lane & 7;
    const int ss = ISV ? (slot ^ (((key >> 1) & 3) << 1)) : (slot ^ ((key >> 1) & 7));
    __builtin_amdgcn_global_load_lds((const unsigned*)((const char*)grow0 + (lane >> 3) * 128 + ss * 16), (LAS unsigned*)(img + k0 * 128), 16, 0, 0);
}
__device__ __forceinline__ float xmax16_32(float v) { v = fmaxf(v, __shfl_xor(v, 16)); return fmaxf(v, __shfl_xor(v, 32)); }
__device__ __forceinline__ float xsum16_32(float v) { v += __shfl_xor(v, 16); return v + __shfl_xor(v, 32); }
__device__ __forceinline__ bf16x8 pack8(const f32x4& a, const f32x4& b) { u32x4 w; w.x = pk2(a[0], a[1]); w.y = pk2(a[2], a[3]); w.z = pk2(b[0], b[1]); w.w = pk2(b[2], b[3]); return __builtin_bit_cast(bf16x8, w); }

__device__ __forceinline__ void na_phase(Frame& F, const Args& a) {
    const bf16_t* QA = (const bf16_t*)(F.ws + WS_QA); const bf16_t* KA = (const bf16_t*)(F.ws + WS_KA); const bf16_t* VA = (const bf16_t*)(F.ws + WS_VA);
    bf16_t* OA = (bf16_t*)(F.ws + WS_OA); const f32x4* BT = (const f32x4*)(F.ws + WS_BT);
    LAS unsigned char* imgK = F.lds; LAS unsigned char* imgV = F.lds + 9 * 8192;
    const int lane = F.lane, g = lane >> 4, ql = lane & 15, q4 = (lane & 15) >> 2, p4 = lane & 3;
    const int per = (2048 + F.G - 1) / F.G;
    int res_lo = -1000, res_bh = -1;
    u32x4 pf[4]; int pf_lo = 0, pf_cnt = 0;
    f32x4 bt[8][2]; int bt_key = -1;
    bf16x8 qf0, qf1, qn0, qn1; bool have_q = false;
    for (int i = 0; i < per; ++i) {
        const int u = F.vcu * per + i; if (u >= 2048) break;
        const int p = u & 63, h = (u >> 6) & 7, b = u >> 9, bh = b * 8 + h;
        const int R0 = min(max(2 * p - 4, 0), 120);
        const size_t rowbase = (size_t)bh * SEQ;
        if (res_bh != bh || res_lo != R0) {
            __syncthreads();
            for (int j = F.wave; j < 144; j += 8) {
                const int kr = j >> 4, isv = (j >> 3) & 1, pc = j & 7; const int slot = (R0 + kr) % 9;
                const size_t tok0 = rowbase + (R0 + kr) * 64 + pc * 8;
                if (isv) dma_piece<true>(VA + tok0 * 64, imgV + slot * 8192, pc * 8, lane); else dma_piece<false>(KA + tok0 * 64, imgK + slot * 8192, pc * 8, lane);
            }
            asm volatile("s_waitcnt vmcnt(0)" ::: "memory");
            __syncthreads();
            have_q = false;
        }
        res_bh = bh; res_lo = R0;
        const int r = 2 * p + (F.wave >> 2), gq = F.wave & 3, base = (gq == 0) ? 0 : (gq == 1) ? 8 : (gq == 2) ? 24 : 32;
        const int rs = min(max(r - 4, 0), 120), rs9 = rs % 9, dr0 = rs - r + 7;
        const size_t qrow = rowbase + r * 64 + 16 * gq + ql;
        if (!have_q) { qf0 = *(const bf16x8*)(QA + qrow * 64 + 8 * g); qf1 = *(const bf16x8*)(QA + qrow * 64 + 32 + 8 * g); }
        if (bt_key != h * 64 + dr0) {
            bt_key = h * 64 + dr0;
#pragma unroll
            for (int kr = 0; kr < 8; ++kr)
#pragma unroll
                for (int hf = 0; hf < 2; ++hf) bt[kr][hf] = BT[((((h * 4 + gq) * 15 + dr0 + kr) * 2 + hf) * 64) + lane];
        }
        const bool has_next = (i + 1 < per && u + 1 < 2048 && ((u + 1) >> 6) == (u >> 6));
        pf_cnt = 0;
        if (has_next) {
            const size_t qrow2 = qrow + 128;
            qn0 = *(const bf16x8*)(QA + qrow2 * 64 + 8 * g); qn1 = *(const bf16x8*)(QA + qrow2 * 64 + 32 + 8 * g);
            const int nR0 = min(max(2 * (p + 1) - 4, 0), 120); pf_lo = max(nR0, R0 + 9); pf_cnt = nR0 + 9 - pf_lo;
#pragma unroll
            for (int jj = 0; jj < 4; ++jj) {
                const int j = F.wave + 8 * jj, rowsel = j >> 4, isv = (j >> 3) & 1, pc = j & 7;
                if (rowsel < pf_cnt) {
                    const int key = pc * 8 + (lane >> 3), s16 = lane & 7; const int ss = isv ? (s16 ^ (((key >> 1) & 3) << 1)) : (s16 ^ ((key >> 1) & 7));
                    const bf16_t* src = (isv ? VA : KA) + (rowbase + (size_t)(pf_lo + rowsel) * 64 + key) * 64 + ss * 8;
                    pf[jj] = *(const u32x4*)src;
                }
            }
        }
        f32x4 S[8][2];
#pragma unroll
        for (int kr = 0; kr < 8; ++kr) {
            const int sl = (rs9 + kr >= 9) ? rs9 + kr - 9 : rs9 + kr; const LAS unsigned char* ik = imgK + sl * 8192;
#pragma unroll
            for (int hf = 0; hf < 2; ++hf) {
                const int key = base + 16 * hf + ql;
                f32x4 s = MFMA16(ldK(ik, key, g), qf0, bt[kr][hf]); s = MFMA16(ldK(ik, key, 4 + g), qf1, s); S[kr][hf] = s;
            }
        }
        float m = -INFINITY;
#pragma unroll
        for (int kr = 0; kr < 8; ++kr)
#pragma unroll
            for (int hf = 0; hf < 2; ++hf) { m = fmaxf(fmaxf(m, S[kr][hf][0]), S[kr][hf][1]); m = fmaxf(fmaxf(m, S[kr][hf][2]), S[kr][hf][3]); }
        m = xmax16_32(m);
#pragma unroll
        for (int kr = 0; kr < 8; ++kr)
#pragma unroll
            for (int hf = 0; hf < 2; ++hf)
#pragma unroll
                for (int e = 0; e < 4; ++e) S[kr][hf][e] = __builtin_amdgcn_exp2f(S[kr][hf][e] - m);
        f32x4 o[4], osum = {0.f, 0.f, 0.f, 0.f};
        const bf16x8 ones8 = {0x3F80, 0x3F80, 0x3F80, 0x3F80, 0x3F80, 0x3F80, 0x3F80, 0x3F80};
#pragma unroll
        for (int dt = 0; dt < 4; ++dt) o[dt] = (f32x4){0.f, 0.f, 0.f, 0.f};
#pragma unroll
        for (int kr = 0; kr < 8; ++kr) {
            const int sl = (rs9 + kr >= 9) ? rs9 + kr - 9 : rs9 + kr;
            const bf16x8 pp = pack8(S[kr][0], S[kr][1]); const LAS unsigned char* iv = imgV + sl * 8192;
            const int ka = base + 4 * g + q4;
#pragma unroll
            for (int dt = 0; dt < 4; ++dt) {
                const s16x4 va = ldVt(iv, ka, dt, p4), vb = ldVt(iv, ka + 16, dt, p4);
                const bf16x8 vf = {va[0], va[1], va[2], va[3], vb[0], vb[1], vb[2], vb[3]};
                o[dt] = MFMA16(vf, pp, o[dt]);
            }
            osum = MFMA16(ones8, pp, osum);
        }
        const float inv = 1.0f / osum[0];
        bf16_t* op = OA + ((size_t)b * SEQ + r * 64 + 16 * gq + ql) * 512 + h * 64 + 4 * g;
#pragma unroll
        for (int dt = 0; dt < 4; ++dt) { u32x2 w; w.x = pk2(o[dt][0] * inv, o[dt][1] * inv); w.y = pk2(o[dt][2] * inv, o[dt][3] * inv); *(u32x2*)(op + 16 * dt) = w; }
        if (pf_cnt > 0) {
            __syncthreads();
#pragma unroll
            for (int jj = 0; jj < 4; ++jj) {
                const int j = F.wave + 8 * jj, rowsel = j >> 4, isv = (j >> 3) & 1, pc = j & 7;
                if (rowsel < pf_cnt) { const int slot = (pf_lo + rowsel) % 9; *(LAS u32x4*)((isv ? imgV : imgK) + slot * 8192 + pc * 1024 + lane * 16) = pf[jj]; }
            }
            res_lo = pf_lo + pf_cnt - 9;
            __syncthreads();
        }
        if (has_next) { qf0 = qn0; qf1 = qn1; have_q = true; } else have_q = false;
    }
    __syncthreads();
}

__device__ __forceinline__ void swa_phase(Frame& F, const Args& a) {
    const bf16_t* QB = (const bf16_t*)(F.ws + WS_QB); const bf16_t* KB = (const bf16_t*)(F.ws + WS_KB); const bf16_t* VB = (const bf16_t*)(F.ws + WS_VB);
    bf16_t* OB = (bf16_t*)(F.ws + WS_OB); const float* sinks = a.in[5];
    LAS unsigned char* imgK = F.lds; LAS unsigned char* imgV = F.lds + 65536;
    const int lane = F.lane, g = lane >> 4, ql = lane & 15, q4 = (lane & 15) >> 2, p4 = lane & 3;
    f32x4 mlo, mhi;
#pragma unroll
    for (int e = 0; e < 4; ++e) { mlo[e] = (4 * g + e >= ql) ? 0.f : -INFINITY; mhi[e] = (4 * g + e <= ql) ? 0.f : -INFINITY; }
    const int per = (512 + F.G - 1) / F.G;
    int res_bk = -1, res_hi = -1000;
#define SWA_LOAD_BLOCK(bk, blk) do { const int slot_ = ((blk) + 1) & 3; const bool ok_ = (blk) >= 0 && (blk) < SEQ / 128; \
        for (int j = F.wave; j < 32; j += 8) { const int isv = j >> 4, pc = j & 15; \
            if (ok_) { const size_t tok0 = (size_t)(bk) * SEQ + (blk) * 128 + pc * 8; \
                if (isv) dma_piece<true>(VB + tok0 * 64, imgV + slot_ * 16384, pc * 8, lane); else dma_piece<false>(KB + tok0 * 64, imgK + slot_ * 16384, pc * 8, lane); } \
            else if (isv) { *(LAS u32x4*)(imgV + slot_ * 16384 + pc * 1024 + lane * 16) = (u32x4){0u, 0u, 0u, 0u}; } } } while (0)
    for (int i = 0; i < per; ++i) {
        const int u = F.vcu * per + i; if (u >= 512) break;
        const int n = u & 63, kvh = (u >> 6) & 1, b = u >> 7, bk = b * 2 + kvh;
        if (res_bk != bk || res_hi != n + 1) {
            __syncthreads();
            const bool keep2 = (res_bk == bk && res_hi == n);
            if (!keep2) { SWA_LOAD_BLOCK(bk, n - 1); SWA_LOAD_BLOCK(bk, n); }
            SWA_LOAD_BLOCK(bk, n + 1);
        }
        asm volatile("s_waitcnt vmcnt(0)" ::: "memory");
        __syncthreads();
        res_bk = bk; res_hi = n + 1;
        if (i + 1 < per && u + 1 < 512 && ((u + 1) >> 6) == (u >> 6)) { SWA_LOAD_BLOCK(bk, n + 2); res_hi = n + 2; }
        const int hq = 4 * kvh + (F.wave >> 1), half = F.wave & 1;
        const float sink2 = sinks[hq] * LOG2E;
        const bf16_t* qbase = QB + ((size_t)(b * 8 + hq) * SEQ + 128 * n + 64 * half + ql) * 64 + 8 * g;
        bf16x8 qc0 = *(const bf16x8*)qbase, qc1 = *(const bf16x8*)(qbase + 32);
        const int kswz0 = (g ^ ((ql >> 1) & 7)) << 4, kswz1 = ((4 + g) ^ ((ql >> 1) & 7)) << 4;
        const int vk0 = 4 * g + q4; int vterm[4];
#pragma unroll
        for (int dt = 0; dt < 4; ++dt) vterm[dt] = (((2 * dt + (p4 >> 1)) ^ (((vk0 >> 1) & 3) << 1)) << 4) + (p4 & 1) * 8;
#pragma unroll 1
        for (int sub = 0; sub < 4; ++sub) {
            const int qrel0 = 64 * half + 16 * sub, qpos0 = 128 * n + qrel0;
            const bf16x8 qf0 = qc0, qf1 = qc1;
            if (sub < 3) { qc0 = *(const bf16x8*)(qbase + (sub + 1) * 1024); qc1 = *(const bf16x8*)(qbase + (sub + 1) * 1024 + 32); }
            const int kpos = 128 * n + qrel0 + ql, vpos = 128 * n + qrel0 + vk0;
            f32x4 S[17];
            bf16x8 kA[4][2], kB[4][2];
#define SW_KLD(buf, j, t) do { const LAS unsigned char* p_ = imgK + (((kpos + 16 * (t)) & 511) << 7); buf[j][0] = *(const LAS bf16x8*)(p_ + kswz0); buf[j][1] = *(const LAS bf16x8*)(p_ + kswz1); } while (0)
#define SW_KMM(buf, j, t) do { const f32x4 c_ = ((t) == 0) ? mlo : ((t) == 16) ? mhi : (f32x4){0.f, 0.f, 0.f, 0.f}; f32x4 s_ = MFMA16(buf[j][0], qf0, c_); s_ = MFMA16(buf[j][1], qf1, s_); \
                S[t] = s_; } while (0)
            SW_KLD(kA, 0, 0); SW_KLD(kA, 1, 1); SW_KLD(kA, 2, 2); SW_KLD(kA, 3, 3);
            SW_KLD(kB, 0, 4); SW_KLD(kB, 1, 5); SW_KLD(kB, 2, 6); SW_KLD(kB, 3, 7); __builtin_amdgcn_sched_barrier(0);
            SW_KMM(kA, 0, 0); SW_KMM(kA, 1, 1); SW_KMM(kA, 2, 2); SW_KMM(kA, 3, 3); __builtin_amdgcn_sched_barrier(0);
            SW_KLD(kA, 0, 8); SW_KLD(kA, 1, 9); SW_KLD(kA, 2, 10); SW_KLD(kA, 3, 11); __builtin_amdgcn_sched_barrier(0);
            SW_KMM(kB, 0, 4); SW_KMM(kB, 1, 5); SW_KMM(kB, 2, 6); SW_KMM(kB, 3, 7); __builtin_amdgcn_sched_barrier(0);
            SW_KLD(kB, 0, 12); SW_KLD(kB, 1, 13); SW_KLD(kB, 2, 14); SW_KLD(kB, 3, 15); __builtin_amdgcn_sched_barrier(0);
            SW_KMM(kA, 0, 8); SW_KMM(kA, 1, 9); SW_KMM(kA, 2, 10); SW_KMM(kA, 3, 11); __builtin_amdgcn_sched_barrier(0);
            SW_KLD(kA, 0, 16); __builtin_amdgcn_sched_barrier(0);
            SW_KMM(kB, 0, 12); SW_KMM(kB, 1, 13); SW_KMM(kB, 2, 14); SW_KMM(kB, 3, 15); __builtin_amdgcn_sched_barrier(0);
            SW_KMM(kA, 0, 16);
#undef SW_KLD
#undef SW_KMM
            if (n == 0 || n == SEQ / 128 - 1) {
#pragma unroll
                for (int t = 0; t < 17; ++t) { const int kp_ = qpos0 - 128 + 16 * t; if (kp_ < 0 || kp_ >= SEQ) S[t] = (f32x4){-INFINITY, -INFINITY, -INFINITY, -INFINITY}; }
            }
            float m = -INFINITY;
#pragma unroll
            for (int t = 0; t < 17; ++t) { m = fmaxf(fmaxf(m, S[t][0]), S[t][1]); m = fmaxf(fmaxf(m, S[t][2]), S[t][3]); }
            m = fmaxf(xmax16_32(m), sink2);
#pragma unroll
            for (int t = 0; t < 17; ++t)
#pragma unroll
                for (int e = 0; e < 4; ++e) S[t][e] = __builtin_amdgcn_exp2f(S[t][e] - m);
            f32x4 o[4], osum = {0.f, 0.f, 0.f, 0.f};
#pragma unroll
            for (int dt = 0; dt < 4; ++dt) o[dt] = (f32x4){0.f, 0.f, 0.f, 0.f};
            const f32x4 zero4 = {0.f, 0.f, 0.f, 0.f};
            const bf16x8 ones8 = {0x3F80, 0x3F80, 0x3F80, 0x3F80, 0x3F80, 0x3F80, 0x3F80, 0x3F80};
            s16x4 vA[4][2], vB[4][2];
#define SW_VLD(buf, ks) do { const int ta_ = 2 * (ks), tb_ = (2 * (ks) + 1 < 17) ? 2 * (ks) + 1 : 2 * (ks); \
                const LAS unsigned char* pa_ = imgV + (((vpos + 16 * ta_) & 511) << 7); const LAS unsigned char* pb_ = imgV + (((vpos + 16 * tb_) & 511) << 7); \
                _Pragma("unroll") for (int dt = 0; dt < 4; ++dt) { \
                    buf[dt][0] = __builtin_bit_cast(s16x4, __builtin_amdgcn_ds_read_tr16_b64_v4i16((LAS v4i16_t*)(pa_ + vterm[dt]))); \
                    buf[dt][1] = __builtin_bit_cast(s16x4, __builtin_amdgcn_ds_read_tr16_b64_v4i16((LAS v4i16_t*)(pb_ + vterm[dt]))); } } while (0)
#define SW_VMM(buf, ks) do { const bf16x8 pp_ = pack8(S[2 * (ks)], (2 * (ks) + 1 < 17) ? S[(2 * (ks) + 1 < 17) ? 2 * (ks) + 1 : 0] : zero4); \
                _Pragma("unroll") for (int dt = 0; dt < 4; ++dt) { const bf16x8 vf_ = {buf[dt][0][0], buf[dt][0][1], buf[dt][0][2], buf[dt][0][3], buf[dt][1][0], buf[dt][1][1], buf[dt][1][2], buf[dt][1][3]}; \
                    o[dt] = MFMA16(vf_, pp_, o[dt]); } osum = MFMA16(ones8, pp_, osum); } while (0)
            SW_VLD(vA, 0); SW_VLD(vB, 1); __builtin_amdgcn_sched_barrier(0);
            SW_VMM(vA, 0); __builtin_amdgcn_sched_barrier(0); SW_VLD(vA, 2); __builtin_amdgcn_sched_barrier(0);
            SW_VMM(vB, 1); __builtin_amdgcn_sched_barrier(0); SW_VLD(vB, 3); __builtin_amdgcn_sched_barrier(0);
            SW_VMM(vA, 2); __builtin_amdgcn_sched_barrier(0); SW_VLD(vA, 4); __builtin_amdgcn_sched_barrier(0);
            SW_VMM(vB, 3); __builtin_amdgcn_sched_barrier(0); SW_VLD(vB, 5); __builtin_amdgcn_sched_barrier(0);
            SW_VMM(vA, 4); __builtin_amdgcn_sched_barrier(0); SW_VLD(vA, 6); __builtin_amdgcn_sched_barrier(0);
            SW_VMM(vB, 5); __builtin_amdgcn_sched_barrier(0); SW_VLD(vB, 7); __builtin_amdgcn_sched_barrier(0);
            SW_VMM(vA, 6); __builtin_amdgcn_sched_barrier(0); SW_VLD(vA, 8); __builtin_amdgcn_sched_barrier(0);
            SW_VMM(vB, 7); __builtin_amdgcn_sched_barrier(0);
            SW_VMM(vA, 8);
#undef SW_VLD
#undef SW_VMM
            const float inv = 1.0f / (osum[0] + __builtin_amdgcn_exp2f(sink2 - m));
            bf16_t* op = OB + ((size_t)b * SEQ + qpos0 + ql) * 512 + hq * 64 + 4 * g;
#pragma unroll
            for (int dt = 0; dt < 4; ++dt) { u32x2 w; w.x = pk2(o[dt][0] * inv, o[dt][1] * inv); w.y = pk2(o[dt][2] * inv, o[dt][3] * inv); *(u32x2*)(op + 16 * dt) = w; }
        }
    }
#undef SWA_LOAD_BLOCK
    asm volatile("s_waitcnt vmcnt(0)" ::: "memory");
    __syncthreads();
}

__device__ __forceinline__ void router_phase(Frame& F, const Args& a) {
    const float* x = a.in[0]; bf16_t* AO = (bf16_t*)(F.ws + WS_AO); const float* g2 = a.in[9]; const float* wr_ = a.in[10]; const float* br = a.in[11];
    unsigned char* H2N = (unsigned char*)(F.ws + WS_H2N); float* gwl = (float*)(F.ws + WS_GWL); int* list = (int*)(F.ws + WS_LIST); int* inv = (int*)(F.ws + WS_INV);
    unsigned* counts = (unsigned*)(F.ws + WS_CTL) + CW_CNT;
    LAS float* wL = (LAS float*)F.lds;
    LAS float* lgs = (LAS float*)(F.lds + RING_BYTES) + F.wave * 512;
    LAS int* sel = (LAS int*)(F.lds + SEL_OFF); LAS float* selg = (LAS float*)(F.lds + SELG_OFF);
    {
        f32x4 wv[16]; float gk[16];
#pragma unroll
        for (int j = 0; j < 16; ++j) { const int i4 = F.tid + NTHREADS * j; wv[j] = *((const f32x4*)wr_ + i4); gk[j] = g2[i4 >> 3]; }
#pragma unroll
        for (int j = 0; j < 16; ++j) { const int i = 4 * (F.tid + NTHREADS * j), k = i >> 5, e = i & 31;
#pragma unroll
            for (int c = 0; c < 4; ++c) wL[k * 32 + 2 * ((e + c) & 15) + ((e + c) >> 4)] = wv[j][c] * gk[j]; }
    }
    __syncthreads();
    const int lane = F.lane, ti = lane & 15, q = lane >> 4;
    for (int ch = blockIdx.x; ch < T / 128; ch += F.G) {
        const int t0 = ch * 128 + F.wave * 16;
        const float* xrow = x + (size_t)(t0 + ti) * D + 4 * q; bf16_t* arow = AO + (size_t)(t0 + ti) * D + 4 * q;
        f32x4 acc0 = {0.f, 0.f, 0.f, 0.f}, acc1 = {0.f, 0.f, 0.f, 0.f}; float ss = 0.f;
#pragma unroll 4
        for (int s = 0; s < 64; ++s) {
            f32x4 v = *(const f32x4*)(xrow + 16 * s); const u32x2 w = *(const u32x2*)(arow + 16 * s);
            v.x += bflo(w.x); v.y += bfhi(w.x); v.z += bflo(w.y); v.w += bfhi(w.y);
            { u32x2 xb; xb.x = pk2(v.x, v.y); xb.y = pk2(v.z, v.w); *(u32x2*)(arow + 16 * s) = xb; }
            ss += (v.x * v.x + v.y * v.y) + (v.z * v.z + v.w * v.w);
            const LAS float* wp = wL + (16 * s + 4 * q) * 32 + 2 * ti;
#pragma unroll
            for (int u = 0; u < 4; ++u) {
                const f32x2 b = *(const LAS f32x2*)(wp + 32 * u);
                acc0 = __builtin_amdgcn_mfma_f32_16x16x4f32(v[u], b.x, acc0, 0, 0, 0);
                acc1 = __builtin_amdgcn_mfma_f32_16x16x4f32(v[u], b.y, acc1, 0, 0, 0);
            }
        }
        ss += __shfl_xor(ss, 16); ss += __shfl_xor(ss, 32);
        const float rstd = 1.0f / sqrtf(ss * (1.f / D) + RMS_EPS);
#pragma unroll
        for (int r = 0; r < 4; ++r) { lgs[(4 * q + r) * 32 + ti] = acc0[r]; lgs[(4 * q + r) * 32 + 16 + ti] = acc1[r]; }
        asm volatile("s_waitcnt lgkmcnt(0)" ::: "memory");
        if (lane < 16) {
            float lg[32];
#pragma unroll
            for (int e4 = 0; e4 < 8; ++e4) { const f32x4 v4 = *(const LAS f32x4*)(lgs + lane * 32 + 4 * e4); const f32x4 b4 = *(const f32x4*)(br + 4 * e4);
                lg[4 * e4] = v4.x * rstd + b4.x; lg[4 * e4 + 1] = v4.y * rstd + b4.y; lg[4 * e4 + 2] = v4.z * rstd + b4.z; lg[4 * e4 + 3] = v4.w * rstd + b4.w; }
            float tv[4]; int tix[4];
#pragma unroll
            for (int k = 0; k < 4; ++k) {
                float best = -INFINITY; int bi = 0;
#pragma unroll
                for (int e = 0; e < 32; ++e) if (lg[e] > best) { best = lg[e]; bi = e; }
#pragma unroll
                for (int e = 0; e < 32; ++e) lg[e] = (e == bi) ? -INFINITY : lg[e];
                tv[k] = best; tix[k] = bi;
            }
            const float e1 = __expf(tv[1] - tv[0]), e2 = __expf(tv[2] - tv[0]), e3 = __expf(tv[3] - tv[0]);
            const float inv = 1.0f / (1.0f + e1 + e2 + e3);
            const int rloc = F.wave * 16 + lane;
            sel[rloc * 4 + 0] = tix[0]; sel[rloc * 4 + 1] = tix[1]; sel[rloc * 4 + 2] = tix[2]; sel[rloc * 4 + 3] = tix[3];
            selg[rloc * 4 + 0] = inv; selg[rloc * 4 + 1] = e1 * inv; selg[rloc * 4 + 2] = e2 * inv; selg[rloc * 4 + 3] = e3 * inv;
        }
#pragma unroll 4
        for (int r = 0; r < 16; ++r) {
            const float rq = __shfl(rstd, r) * F8_ACT; const int t = t0 + r;
            const u32x4* ar = (const u32x4*)(AO + (size_t)t * D) + 2 * lane;
            const u32x4 wa = ar[0], wb = ar[1];
            u32x4 o; o.x = pk4_fp8(bflo(wa.x) * rq, bfhi(wa.x) * rq, bflo(wa.y) * rq, bfhi(wa.y) * rq); o.y = pk4_fp8(bflo(wa.z) * rq, bfhi(wa.z) * rq, bflo(wa.w) * rq, bfhi(wa.w) * rq);
            o.z = pk4_fp8(bflo(wb.x) * rq, bfhi(wb.x) * rq, bflo(wb.y) * rq, bfhi(wb.y) * rq); o.w = pk4_fp8(bflo(wb.z) * rq, bfhi(wb.z) * rq, bflo(wb.w) * rq, bfhi(wb.w) * rq);
            *((u32x4*)(H2N + (size_t)t * D) + lane) = o;
        }
        LAS int* lcnt = (LAS int*)(F.lds + TS_OFF) + 96; LAS int* lbase = lcnt + 32;
        if (F.tid < 32) lcnt[F.tid] = 0;
        __syncthreads();
        const int myj = F.tid, mye = sel[myj];
        const int mypos = __hip_atomic_fetch_add(lcnt + mye, 1, __ATOMIC_RELAXED, __HIP_MEMORY_SCOPE_WORKGROUP);
        __syncthreads();
        if (F.tid < 32) { const int c = lcnt[F.tid]; lbase[F.tid] = c > 0 ? (int)__hip_atomic_fetch_add(counts + F.tid, (unsigned)c, RLX_AGENT) : 0; }
        __syncthreads();
        { const int idx = lbase[mye] + mypos, slot = mye * LISTCAP + idx, tk = (ch * 128 + (myj >> 2)) * 4 + (myj & 3); list[slot] = tk; gwl[slot] = selg[myj]; inv[tk] = (mye << 16) | idx; }
        __syncthreads();
    }
}

__device__ __forceinline__ void moe_tables(Frame& F) {
    LAS int* ts = (LAS int*)(F.lds + TS_OFF); LAS int* cn = ts + 40;
    unsigned* counts = (unsigned*)(F.ws + WS_CTL) + CW_CNT;
    if (F.tid < 32) cn[F.tid] = (int)__hip_atomic_load(counts + F.tid, RLX_AGENT);
    __syncthreads();
    if (F.tid == 0) { int s = 0; for (int e = 0; e < 32; ++e) { ts[e] = s; s += (cn[e] + 255) >> 8; } ts[32] = s; ts[33] = 0x7fffffff; }
    __syncthreads();
    { LAS unsigned char* t2e = F.lds + T2E_OFF; const int total = ts[32];
      for (int m = F.tid; m < total; m += NTHREADS) { int e = 0; while (ts[e + 1] <= m) ++e; t2e[m] = (unsigned char)e; } }
    __syncthreads();
}

__device__ __forceinline__ void combine_phase(Frame& F, const Args& a) {
    moe_tables(F);
    const LAS int* ts = (const LAS int*)(F.lds + TS_OFF);
    float* out = a.out; const float* x = a.in[0]; const float* fg = a.in[16]; const unsigned char* Y = (const unsigned char*)(F.ws + WS_YTK); const bf16_t* AO = (const bf16_t*)(F.ws + WS_AO);
    const int* inv = (const int*)(F.ws + WS_INV);
    const int gw = F.vcu * NWAVES + F.wave, NGW = F.G * NWAVES;
    f32x4 gv[4];
#pragma unroll
    for (int j = 0; j < 4; ++j) gv[j] = *((const f32x4*)fg + F.lane + 64 * j);
    const int ntok = (T - gw + NGW - 1) / NGW;
    for (int i0 = 0; i0 < ntok; i0 += 16) {
        const int ti_ = i0 + (F.lane >> 2); int invv = 0;
        if (ti_ < ntok) invv = __hip_atomic_load(inv + 4 * (size_t)(gw + ti_ * NGW) + (F.lane & 3), RLX_AGENT);
        const int rowv = ts[(invv >> 16) & 31] * 256 + (invv & 0xffff);
        const int nloc = min(16, ntok - i0);
#define CB_LOAD(AV, YV, i_) do { const int t_ = gw + (i0 + (i_)) * NGW; int row_[4]; \
            _Pragma("unroll") for (int k = 0; k < 4; ++k) row_[k] = __builtin_amdgcn_readlane(rowv, 4 * (i_) + k); \
            _Pragma("unroll") for (int j = 0; j < 4; ++j) { AV[j] = *((const u32x2*)(AO + (size_t)t_ * D) + F.lane + 64 * j); \
                _Pragma("unroll") for (int k = 0; k < 4; ++k) YV[k][j] = *((const unsigned*)(Y + (size_t)row_[k] * D) + F.lane + 64 * j); } } while (0)
#define CB_PROC(AV, YV, i_) do { const int t_ = gw + (i0 + (i_)) * NGW; f32x4 v[4]; float ss = 0.f; \
            _Pragma("unroll") for (int j = 0; j < 4; ++j) { f32x4 ysum = {0.f, 0.f, 0.f, 0.f}; \
                _Pragma("unroll") for (int k = 0; k < 4; ++k) { const f32x2 lo2 = __builtin_amdgcn_cvt_pk_f32_fp8((int)YV[k][j], false), hi2 = __builtin_amdgcn_cvt_pk_f32_fp8((int)YV[k][j], true); \
                    ysum.x += lo2.x; ysum.y += lo2.y; ysum.z += hi2.x; ysum.w += hi2.y; } \
                v[j] = ysum * F8_YINV; v[j].x += bflo(AV[j].x); v[j].y += bfhi(AV[j].x); v[j].z += bflo(AV[j].y); v[j].w += bfhi(AV[j].y); \
                ss += (v[j].x * v[j].x + v[j].y * v[j].y) + (v[j].z * v[j].z + v[j].w * v[j].w); } \
            const float rstd = 1.0f / sqrtf(wave_sum(ss) * (1.f / D) + RMS_EPS); f32x4* orow = (f32x4*)(out + (size_t)t_ * D) + F.lane; \
            _Pragma("unroll") for (int j = 0; j < 4; ++j) orow[64 * j] = v[j] * rstd * gv[j]; } while (0)
        u32x2 avA[4], avB[4]; unsigned yvA[4][4], yvB[4][4];
        CB_LOAD(avA, yvA, 0);
#pragma unroll 1
        for (int i = 0; i < nloc; i += 2) {
            if (i + 1 < nloc) CB_LOAD(avB, yvB, i + 1);
            CB_PROC(avA, yvA, i);
            if (i + 2 < nloc) CB_LOAD(avA, yvA, i + 2);
            if (i + 1 < nloc) CB_PROC(avB, yvB, i + 1);
        }
#undef CB_LOAD
#undef CB_PROC
    }
}

constexpr int N_PHASES = 9;
#ifndef PROBE_PHASE
#define PROBE_PHASE -1
#endif
#ifndef PROBE_REPS
#define PROBE_REPS 2
#endif
template <int k> __device__ __forceinline__ void run_phase(Frame& F0, const Args& args) {
    Frame F = F0; { int t_ = threadIdx.x; asm volatile("" : "+v"(t_)); F.tid = t_; F.lane = t_ & 63; F.wave = __builtin_amdgcn_readfirstlane(t_ >> 6); }
    if constexpr (k == 0) { p0_prologue(F, args); }
    else if constexpr (k == 1) {
        { DenseSched S; S.so.init(T, C_GA, F.G, (int)blockIdx.x); S.A = (const char*)(F.ws + WS_H1); S.lda = D * 2; S.Bt = (const char*)(F.ws + WS_WIN); S.K = 2 * D;
          EpiInProj E{F.ws, args.in[3], (const float*)(F.ws + WS_ROPE)};
          pg8::gemm_phase<true, true, false>(F.lds, 2 * D, S, E); }
        { DenseSched S; S.so.init(T, 2048, F.G, (int)blockIdx.x); if (F.G == 256) S.so.tail_lo = 128; S.A = (const char*)(F.ws + WS_H1Q); S.lda = D; S.Bt = (const char*)(F.ws + WS_WING8); S.K = D;
          EpiGate E{(bf16_t*)(F.ws + WS_SG), args.in[3]};
          pg8::gemm_phase<true, true, true>(F.lds, D, S, E); }
    } else if constexpr (k == 2) {
#if ATTN_NAIVE
        attn_naive(F, args);
#else
        na_phase(F, args); swa_phase(F, args);
#if PROBE_ATTN == 1
        na_phase(F, args); na_phase(F, args);
#elif PROBE_ATTN == 2
        swa_phase(F, args); swa_phase(F, args);
#endif
#endif
    } else if constexpr (k == 3) {
        UpSched S; S.so.init(T, D, F.G, (int)blockIdx.x); S.OA = (const char*)(F.ws + WS_OA); S.OB = (const char*)(F.ws + WS_OB); S.Wa = (const char*)(F.ws + WS_WA); S.Wb = (const char*)(F.ws + WS_WB);
        EpiUp E{(const bf16_t*)(F.ws + WS_SG), (bf16_t*)(F.ws + WS_MERGED)};
        pg8::gemm_phase<true, true, false>(F.lds, 2 * 512, S, E);
    } else if constexpr (k == 4) {
        DenseSched S; S.so.init(T, D, F.G, (int)blockIdx.x); S.A = (const char*)(F.ws + WS_MERGED); S.lda = D * 2; S.Bt = (const char*)(F.ws + WS_WOUT); S.K = 2 * D;
        EpiAo E{(bf16_t*)(F.ws + WS_AO)};
        pg8::gemm_phase<true, true, false>(F.lds, 2 * D, S, E);
    } else if constexpr (k == 5) { router_phase(F, args); }
    else if constexpr (k == 6) {
        moe_tables(F);
        const LAS int* ts = (const LAS int*)(F.lds + TS_OFF);
        MoeSched<true> S; S.tstart = ts; S.cnt = ts + 40; S.t2e = (const LAS unsigned char*)(F.lds + T2E_OFF); S.G = F.G; S.vcu = F.vcu; S.log_mt = 2; S.total = ts[32];
        S.A = (const char*)(F.ws + WS_H2N); S.list = (const int*)(F.ws + WS_LIST); S.Bt = (const char*)(F.ws + WS_W1); S.b_estride = (size_t)2 * FF * D; S.K = D;
        EpiMoe1 E{args.in[13], (unsigned char*)(F.ws + WS_HACT)};
        pg8::gemm_phase<true, true, true>(F.lds, D, S, E);
    } else if constexpr (k == 7) {
        moe_tables(F);
        const LAS int* ts = (const LAS int*)(F.lds + TS_OFF);
        MoeSched<false> S; S.tstart = ts; S.cnt = ts + 40; S.t2e = (const LAS unsigned char*)(F.lds + T2E_OFF); S.G = F.G; S.vcu = F.vcu; S.log_mt = 3; S.total = ts[32];
        S.A = (const char*)(F.ws + WS_HACT); S.list = (const int*)(F.ws + WS_LIST); S.Bt = (const char*)(F.ws + WS_W2); S.b_estride = (size_t)D * FF; S.K = FF;
        EpiMoe2 E{ts + 40, (const float*)(F.ws + WS_GWL), args.in[15], (unsigned char*)(F.ws + WS_YTK)};
        pg8::gemm_phase<true, true, true>(F.lds, FF, S, E);
    } else if constexpr (k == 8) { combine_phase(F, args); }
}
__global__ void __launch_bounds__(NTHREADS, 2) fwd_kernel(Args args) {
    extern __shared__ __attribute__((aligned(16))) unsigned char lds_raw[];
    Frame F;
    F.lds = (LAS unsigned char*)lds_raw;
    F.tid = threadIdx.x; F.lane = F.tid & 63; F.wave = __builtin_amdgcn_readfirstlane(F.tid >> 6);
    F.G = gridDim.x; { const int bx = blockIdx.x; F.vcu = (F.G % 8 == 0) ? (bx % 8) * (F.G / 8) + bx / 8 : bx; }
    F.ws = args.ws;
    volatile LAS unsigned* MISC = (volatile LAS unsigned*)(F.lds + MISC_OFF);
    for (int u = F.tid; u < 256; u += NTHREADS) MISC[u] = 0u;
    __syncthreads();
    unsigned* ctl = (unsigned*)(F.ws + WS_CTL);
    XcdBarrier bar; bar.bar = ctl + CW_BAR + args.li * XCD_BAR_WORDS; bar.x = 0; bar.st = nullptr;
    const int lo = args.ph_lo, hi = args.ph_hi;
    if (hi - lo > 1) bar = xcd_barrier_post(ctl + CW_BAR + args.li * XCD_BAR_WORDS, MISC + 8);
#define PHASE(k) do { if (lo <= (k) && (k) < hi) { run_phase<k>(F, args); if ((k) + 1 < hi) xcd_barrier(bar); } } while (0)
    PHASE(0); PHASE(1); PHASE(2); PHASE(3); PHASE(4); PHASE(5); PHASE(6); PHASE(7); PHASE(8);
#undef PHASE
}

extern "C" void kernel_launch(void* const* d_in, const int* in_sizes, int n_in, void* d_out, int out_size, void* d_ws, size_t ws_size, hipStream_t stream) {
    static int grid = 0;
    if (grid == 0) {
        if (n_in != 17 || in_sizes[0] != T * D || out_size != T * D || ws_size < WS_END) { fprintf(stderr, "kernel_launch: unexpected shapes (n_in %d, in0 %d, out %d, ws %zu); nothing launched\n", n_in, n_in > 0 ? in_sizes[0] : -1, out_size, ws_size); grid = -1; return; }
        int dev = 0, cus = 0, per_cu = 0;
        if (hipGetDevice(&dev) != hipSuccess || hipDeviceGetAttribute(&cus, hipDeviceAttributeMultiprocessorCount, dev) != hipSuccess) { grid = -1; return; }
        if (hipFuncSetAttribute((const void*)fwd_kernel, hipFuncAttributeMaxDynamicSharedMemorySize, LDS_BYTES) != hipSuccess) { fprintf(stderr, "kernel_launch: hipFuncSetAttribute failed\n"); grid = -1; return; }
        if (hipOccupancyMaxActiveBlocksPerMultiprocessor(&per_cu, (const void*)fwd_kernel, NTHREADS, LDS_BYTES) != hipSuccess || per_cu < 1) { fprintf(stderr, "kernel_launch: occupancy query reports %d blocks per CU\n", per_cu); per_cu = 1; }
        (void)hipGetLastError();
        grid = cus;
    }
    if (grid < 0) return;
    (void)hipMemsetAsync((char*)d_ws + WS_CTL, 0, CTL_ZERO_BYTES, stream);
    Args a{};
    for (int i = 0; i < 17; ++i) a.in[i] = (const float*)d_in[i];
    a.out = (float*)d_out; a.ws = (unsigned char*)d_ws;
    void* kargs[] = {&a};
#if MK_SPLIT
    for (int p = 0; p < N_PHASES; ++p) {
        a.ph_lo = p; a.ph_hi = p + 1; a.li = 0;
        hipLaunchKernelGGL(fwd_kernel, dim3(grid), dim3(NTHREADS), LDS_BYTES, stream, a);
    }
#elif PROBE_PHASE >= 0
    {
        int li = 0;
        a.ph_lo = 0; a.ph_hi = PROBE_PHASE + 1; a.li = li++;
        (void)hipLaunchCooperativeKernel((const void*)fwd_kernel, dim3(grid), dim3(NTHREADS), kargs, LDS_BYTES, stream);
        for (int r = 0; r < PROBE_REPS; ++r) { a.ph_lo = PROBE_PHASE; a.ph_hi = PROBE_PHASE + 1; a.li = li++;
            if (PROBE_PHASE == 5) (void)hipMemsetAsync((char*)d_ws + WS_CTL + CW_CNT * 4, 0, 128, stream);
            (void)hipLaunchCooperativeKernel((const void*)fwd_kernel, dim3(grid), dim3(NTHREADS), kargs, LDS_BYTES, stream); }
        if (PROBE_PHASE + 1 < N_PHASES) { a.ph_lo = PROBE_PHASE + 1; a.ph_hi = N_PHASES; a.li = li++;
            (void)hipLaunchCooperativeKernel((const void*)fwd_kernel, dim3(grid), dim3(NTHREADS), kargs, LDS_BYTES, stream); }
    }
#else
    a.ph_lo = 0; a.ph_hi = N_PHASES; a.li = 0;
    hipError_t e = hipLaunchCooperativeKernel((const void*)fwd_kernel, dim3(grid), dim3(NTHREADS), kargs, LDS_BYTES, stream);
    if (e != hipSuccess) fprintf(stderr, "kernel_launch: cooperative launch failed: %s (grid %d)\n", hipGetErrorString(e), grid);
#endif
}
```

```cpp
#include <hip/hip_runtime.h>
#include <cstdio>
#include <cstdint>

#ifndef PROBE_ATTN
#define PROBE_ATTN 0
#endif
#ifndef ATTN_NAIVE
#define ATTN_NAIVE 0
#endif
#ifndef MK_SPLIT
#define MK_SPLIT 0
#endif

#define LAS __attribute__((address_space(3)))
#define GAS __attribute__((address_space(1)))
typedef unsigned short bf16_t;
typedef short bf16x8 __attribute__((ext_vector_type(8)));
typedef float f32x4 __attribute__((ext_vector_type(4)));
typedef float f32x2 __attribute__((ext_vector_type(2)));
typedef unsigned u32x4 __attribute__((ext_vector_type(4)));
typedef unsigned u32x2 __attribute__((ext_vector_type(2)));
typedef __bf16 bf16x2_t __attribute__((ext_vector_type(2)));

constexpr int NB = 4, SEQ = 8192, T = NB * SEQ, D = 1024, DIN = 4352;
constexpr int NEXP = 32, FF = 1024, LISTCAP = 32768;
constexpr float RMS_EPS = 1e-5f;
constexpr float LOG2E = 1.4426950408889634f;
constexpr float QSCALE = 0.125f * LOG2E;
constexpr int C_QA = 0, C_KA = 512, C_VA = 1024, C_QB = 1536, C_KB = 2048, C_VB = 2176, C_GA = 2304, C_GB = 3328;

constexpr size_t MiB = 1u << 20;
constexpr size_t WS_CTL = 0, CTL_ZERO_BYTES = 1 * MiB;
constexpr size_t WS_ROPE = 1 * MiB;
constexpr size_t WS_BT = 3 * MiB;
constexpr size_t WS_WIN = 4 * MiB;
constexpr size_t WS_WA = 13 * MiB, WS_WB = 14 * MiB, WS_WOUT = 15 * MiB;
constexpr size_t WS_W2 = 17 * MiB;
constexpr size_t WS_GWL = 744 * MiB;
constexpr size_t WS_LIST = 83 * MiB;
constexpr size_t WS_AO = 88 * MiB;
constexpr size_t WS_PROJ = 152 * MiB;
constexpr size_t WS_QA = WS_PROJ, WS_KA = WS_PROJ + 32 * MiB, WS_VA = WS_PROJ + 64 * MiB, WS_QB = WS_PROJ + 96 * MiB;
constexpr size_t WS_KB = WS_PROJ + 128 * MiB, WS_VB = WS_PROJ + 136 * MiB;
constexpr size_t WS_SG = WS_PROJ + 144 * MiB;
constexpr size_t WS_HACT = WS_PROJ;
constexpr size_t WS_W1 = 424 * MiB;
constexpr size_t WS_H1 = 552 * MiB;
constexpr size_t WS_H2N = WS_H1;
constexpr size_t WS_OA = 616 * MiB, WS_OB = 648 * MiB;
constexpr size_t WS_MERGED = 680 * MiB;
constexpr size_t WS_YTK = 424 * MiB;
constexpr size_t WS_H1Q = 680 * MiB;
constexpr size_t WS_WING8 = 50 * MiB;
constexpr size_t WS_INV = 748 * MiB;
constexpr size_t WS_END = 749 * MiB;
constexpr int CW_CNT = 64;
constexpr int CW_BAR = 4096;

constexpr int RING_BYTES = 131072;
constexpr int ATT_BYTES = 147456;
constexpr int MISC_OFF = ATT_BYTES;
constexpr int SEL_OFF = MISC_OFF + 1024;
constexpr int SELG_OFF = SEL_OFF + 2048;
constexpr int TS_OFF = SELG_OFF + 2048;
constexpr int T2E_OFF = TS_OFF + 1536;
constexpr int LDS_BYTES = 155648;
constexpr int NWAVES = 8, NTHREADS = 512;

#define RLX_AGENT __ATOMIC_RELAXED, __HIP_MEMORY_SCOPE_AGENT

__device__ __forceinline__ unsigned f2bf(float f) { unsigned u = __builtin_bit_cast(unsigned, f); return (u + 0x7fffu + ((u >> 16) & 1u)) >> 16; }
__device__ __forceinline__ unsigned pk2(float lo, float hi) { f32x2 v = {lo, hi}; bf16x2_t b = __builtin_convertvector(v, bf16x2_t); return __builtin_bit_cast(unsigned, b); }
constexpr float F8_ACT = 4.0f, F8_W = 128.0f, F8_INV = 1.0f / 512.0f, F8_Y = 32.0f, F8_YINV = 1.0f / 32.0f;
__device__ __forceinline__ unsigned pk4_fp8(float a, float b, float c, float d) { int w = 0; w = __builtin_amdgcn_cvt_pk_fp8_f32(a, b, w, false); w = __builtin_amdgcn_cvt_pk_fp8_f32(c, d, w, true); return (unsigned)w; }
__device__ __forceinline__ float bflo(unsigned w) { return __uint_as_float(w << 16); }
__device__ __forceinline__ float bfhi(unsigned w) { return __uint_as_float(w & 0xffff0000u); }
__device__ __forceinline__ float sigmoidf_(float x) { return __builtin_amdgcn_rcpf(1.0f + __builtin_amdgcn_exp2f(-x * LOG2E)); }
__device__ __forceinline__ const char* uniform_ptr(const char* p) {
    const unsigned long long v = (unsigned long long)p;
    const unsigned lo = __builtin_amdgcn_readfirstlane((unsigned)v), hi = __builtin_amdgcn_readfirstlane((unsigned)(v >> 32));
    return (const char*)(((unsigned long long)hi << 32) | lo);
}
__device__ __forceinline__ float wave_sum(float v) {
#pragma unroll
    for (int o = 1; o < 64; o <<= 1) v += __shfl_xor(v, o);
    return v;
}

namespace pg8 {
constexpr int BM = 256, BK = 64, HALF = 128, HTB = HALF * BK * 2, STAGE_BYTES = 8 * HTB, NXCD = 8, WGM = 8;
__host__ __device__ __forceinline__ int lds_byte(int r, int c) { const int st = (r >> 4) * 2 + (c >> 5), rr = r & 15, cc = c & 31, ob = rr * 64 + cc * 2; return st * 1024 + (ob ^ (((ob >> 9) & 1) << 5)); }
__host__ __device__ __forceinline__ void stage_rc(int b, int& R, int& C) { const int st = b / 1024, sb = b % 1024, swz = sb ^ (((sb >> 9) & 1) << 5); R = (st >> 1) * 16 + swz / 64; C = (st & 1) * 32 + (swz % 64) / 2; }
__host__ __device__ __forceinline__ int perm32(int rho) { const int n = rho >> 4, i = rho & 15; return 8 * (i >> 2) + 4 * n + (i & 3); }

struct Unit { int pm, pn, e, mt, part; };

struct StaticOrder {
    int nM, nN, nwg, G, c, tail_lo;
    __device__ void init(int M, int N, int G_, int c_) { nM = M / BM; nN = N / BM; nwg = nM * nN; G = G_; c = c_; tail_lo = -1; }
    __device__ bool next(int i, Unit& u) const {
        long L = (long)i * G + c;
        if (tail_lo >= 0 && i >= 3) { if (c < tail_lo || i >= 5) return false; L = 3L * G + 2 * (c - tail_lo) + (i - 3); }
        if (L >= nwg) return false;
        int wgid = (int)L; { const int q = nwg / NXCD, r = nwg % NXCD, xcd = wgid % NXCD, off = wgid / NXCD; wgid = (xcd < r ? xcd * (q + 1) : r * (q + 1) + (xcd - r) * q) + off; }
        const int nig = WGM * nN, gid = wgid / nig, fm = gid * WGM, gsz = (nM - fm) < WGM ? (nM - fm) : WGM;
        u.pm = fm + ((wgid % nig) % gsz); u.pn = (wgid % nig) / gsz; u.e = 0; u.mt = 0; u.part = 0; return true;
    }
};

typedef int v8i32_t __attribute__((ext_vector_type(8)));
typedef int v4i32_t __attribute__((ext_vector_type(4)));
__device__ __forceinline__ v8i32_t cat8(const bf16x8& a, const bf16x8& b) { const v4i32_t x = __builtin_bit_cast(v4i32_t, a), y = __builtin_bit_cast(v4i32_t, b); return __builtin_shufflevector(x, y, 0, 1, 2, 3, 4, 5, 6, 7); }
template <bool PERM, bool ALIGN_EPI, bool FP8, class Sched, class Epi>
__device__ __forceinline__ void gemm_phase(LAS unsigned char* lds, const int KB, const Sched& S, const Epi& E) {
    const int tid = threadIdx.x, wid = __builtin_amdgcn_readfirstlane(tid >> 6), lane = tid & 63, wr = wid >> 2, wc = wid & 3, fr = lane & 15, fq = lane >> 4;
    const int nt = KB / 128;
    int R[2], C2[2]; unsigned voffB[2];
#pragma unroll
    for (int i = 0; i < 2; ++i) { int r_, c_; stage_rc(tid * 16 + i * 8192, r_, c_); R[i] = r_; C2[i] = c_ * 2; const int Rb = PERM ? ((r_ & ~31) + perm32(r_ & 31)) : r_; voffB[i] = (unsigned)(Rb * KB + c_ * 2); }
    const size_t kstep = (size_t)(BK * 2);
    const size_t hstepB = (size_t)HALF * KB;
    const unsigned ldsw = (unsigned)wid * 1024u;
    const int aoff = lds_byte(wr * 64 + fr, fq * 8), boff = lds_byte(wc * 32 + fr, fq * 8);
#define PG8_SA(b, h) (((b) * 2 + (h)) * HTB)
#define PG8_SB(b, h) ((4 + (b) * 2 + (h)) * HTB)
#define PG8_STAGE_B(bufoff, gbase) do { _Pragma("unroll") for (int _i = 0; _i < 2; ++_i) \
        __builtin_amdgcn_global_load_lds((const unsigned*)((const char*)(gbase) + voffB[_i]), (LAS unsigned*)(lds + (bufoff) + ldsw + _i * 8192), 16, 0, 0); } while (0)
#define PG8_STAGE_A(bufoff, gbase, o0, o1) do { \
        __builtin_amdgcn_global_load_lds((const unsigned*)((const char*)(gbase) + (o0)), (LAS unsigned*)(lds + (bufoff) + ldsw), 16, 0, 0); \
        __builtin_amdgcn_global_load_lds((const unsigned*)((const char*)(gbase) + (o1)), (LAS unsigned*)(lds + (bufoff) + ldsw + 8192), 16, 0, 0); } while (0)
#define PG8_LDA(dst, b, h) do { _Pragma("unroll") for (int m = 0; m < 4; ++m) { const LAS unsigned char* p_ = lds + PG8_SA(b, h) + aoff + m * 2048; \
        dst[m] = __builtin_shufflevector(*(const LAS v4i32_t*)p_, *(const LAS v4i32_t*)(p_ + 1024), 0, 1, 2, 3, 4, 5, 6, 7); } } while (0)
#define PG8_LDB(dst, b, h) do { _Pragma("unroll") for (int n = 0; n < 2; ++n) { const LAS unsigned char* p_ = lds + PG8_SB(b, h) + boff + n * 2048; \
        dst[n] = __builtin_shufflevector(*(const LAS v4i32_t*)p_, *(const LAS v4i32_t*)(p_ + 1024), 0, 1, 2, 3, 4, 5, 6, 7); } } while (0)
#define PG8_LO(v) __builtin_bit_cast(bf16x8, __builtin_shufflevector(v, v, 0, 1, 2, 3))
#define PG8_HI(v) __builtin_bit_cast(bf16x8, __builtin_shufflevector(v, v, 4, 5, 6, 7))
#define PG8_MMA(ai, bj, At, Bt) do { __builtin_amdgcn_s_setprio(1); _Pragma("unroll") for (int m = 0; m < 4; ++m) _Pragma("unroll") for (int n = 0; n < 2; ++n) { \
        if constexpr (FP8) asm volatile("v_mfma_scale_f32_16x16x128_f8f6f4 %0, %1, %2, %0, %3, %3 op_sel_hi:[0,0,0]" : "+v"(acc[ai][bj][m][n]) : "v"(Bt[n]), "v"(At[m]), "v"(one_scale)); \
        else { acc[ai][bj][m][n] = __builtin_amdgcn_mfma_f32_16x16x32_bf16(PG8_LO(Bt[n]), PG8_LO(At[m]), acc[ai][bj][m][n], 0, 0, 0); \
               acc[ai][bj][m][n] = __builtin_amdgcn_mfma_f32_16x16x32_bf16(PG8_HI(Bt[n]), PG8_HI(At[m]), acc[ai][bj][m][n], 0, 0, 0); } } \
        __builtin_amdgcn_s_setprio(0); } while (0)
#define PG8_WAIT_V(n) asm volatile("s_waitcnt vmcnt(" #n ")" ::: "memory")
#define PG8_WAIT_L(n) asm volatile("s_waitcnt lgkmcnt(" #n ")" ::: "memory")
#define PG8_BAR __builtin_amdgcn_s_barrier()
#define PG8_SCHED __builtin_amdgcn_sched_barrier(0)
    Unit cur, nxt; int ui = 0;
    if (!S.next(0, cur)) return;
    f32x4 acc[2][2][4][2];
#pragma unroll
    for (int a = 0; a < 2; ++a)
#pragma unroll
        for (int b = 0; b < 2; ++b)
#pragma unroll
            for (int m = 0; m < 4; ++m)
#pragma unroll
                for (int n = 0; n < 2; ++n) acc[a][b][m][n] = (f32x4){0.f, 0.f, 0.f, 0.f};
    v8i32_t At[4], B0[2], B1[2];
    const int one_scale = 0x7f7f7f7f;
    const char* cA = S.a_base(cur); const char* cB = S.b_base(cur);
    LAS unsigned char* const eslot0 = lds + STAGE_BYTES;
    if (wid == 0) E.prefetch(cur, eslot0, lane);
    if constexpr (Sched::GATHER) { if (wid == 0) S.rows_prefetch(cur, eslot0 + 2048, lane); asm volatile("s_waitcnt vmcnt(0)" ::: "memory"); __syncthreads(); }
    unsigned oA00 = S.a_off(cur, R[0], eslot0 + 2048) + C2[0], oA01 = S.a_off(cur, R[1], eslot0 + 2048) + C2[1], oA10 = S.a_off(cur, HALF + R[0], eslot0 + 2048) + C2[0], oA11 = S.a_off(cur, HALF + R[1], eslot0 + 2048) + C2[1];
    PG8_STAGE_B(PG8_SB(0, 0), cB); PG8_STAGE_B(PG8_SB(0, 1), cB + hstepB); PG8_STAGE_A(PG8_SA(0, 0), cA, oA00, oA01); PG8_STAGE_A(PG8_SA(0, 1), cA, oA10, oA11);
    if (wr == 1) PG8_BAR;
    PG8_WAIT_V(2); PG8_BAR;
    PG8_STAGE_B(PG8_SB(1, 0), cB + kstep); PG8_STAGE_A(PG8_SA(1, 0), cA + kstep, oA00, oA01); PG8_STAGE_B(PG8_SB(1, 1), cB + hstepB + kstep);
    PG8_WAIT_V(6); PG8_BAR;
    for (;;) {
        const bool has_next = S.next(ui + 1, nxt);
        const char* nA = has_next ? S.a_base(nxt) : cA; const char* nB = has_next ? S.b_base(nxt) : cB;
        LAS unsigned char* const nrows = eslot0 + ((ui + 1) & 1) * 4096 + 2048;
        if constexpr (Sched::GATHER) { if (has_next && wid == 0) S.rows_prefetch(nxt, nrows, lane); }
        for (int t = 0; t < nt; t += 2) {
            const bool last = (t == nt - 2);
            const char* a1 = cA + (size_t)(t + 1) * kstep;
            const char* a2 = last ? nA : cA + (size_t)(t + 2) * kstep; const char* b2 = last ? nB : cB + (size_t)(t + 2) * kstep;
            const char* a3 = a2 + kstep; const char* b3 = b2 + kstep;
            unsigned p00 = oA00, p01 = oA01;
            if (last && has_next) { p00 = S.a_off(nxt, R[0], nrows) + C2[0]; p01 = S.a_off(nxt, R[1], nrows) + C2[1]; }
            PG8_LDB(B0, 0, 0); PG8_LDB(B1, 0, 1); PG8_SCHED; PG8_LDA(At, 0, 0); PG8_STAGE_A(PG8_SA(1, 1), a1, oA10, oA11);
            PG8_WAIT_V(8); PG8_WAIT_L(0); PG8_BAR; PG8_MMA(0, 0, At, B0); PG8_MMA(0, 1, At, B1); PG8_BAR; PG8_SCHED;
            unsigned p10 = oA10, p11 = oA11;
            if (last && has_next) { p10 = S.a_off(nxt, HALF + R[0], nrows) + C2[0]; p11 = S.a_off(nxt, HALF + R[1], nrows) + C2[1]; }
            PG8_LDA(At, 0, 1); PG8_STAGE_B(PG8_SB(0, 0), b2); PG8_STAGE_B(PG8_SB(0, 1), b2 + hstepB); PG8_STAGE_A(PG8_SA(0, 0), a2, p00, p01);
            PG8_WAIT_V(8); PG8_WAIT_L(0); PG8_BAR; PG8_MMA(1, 0, At, B0); PG8_MMA(1, 1, At, B1); PG8_BAR; PG8_SCHED;
            PG8_LDB(B0, 1, 0); PG8_LDB(B1, 1, 1); PG8_SCHED; PG8_LDA(At, 1, 0); PG8_STAGE_A(PG8_SA(0, 1), a2, p10, p11);
            PG8_WAIT_V(8); PG8_WAIT_L(0); PG8_BAR; PG8_MMA(0, 0, At, B0); PG8_MMA(0, 1, At, B1); PG8_BAR; PG8_SCHED;
            PG8_LDA(At, 1, 1); PG8_STAGE_B(PG8_SB(1, 0), b3); PG8_STAGE_B(PG8_SB(1, 1), b3 + hstepB); PG8_STAGE_A(PG8_SA(1, 0), a3, p00, p01);
            PG8_WAIT_V(8); PG8_WAIT_L(0); PG8_BAR; PG8_MMA(1, 0, At, B0); PG8_MMA(1, 1, At, B1); PG8_BAR; PG8_SCHED;
            if (last) { oA00 = p00; oA01 = p01; oA10 = p10; oA11 = p11; }
        }
        if constexpr (ALIGN_EPI) { if (wr == 0) PG8_BAR; }
        if constexpr (FP8) asm volatile("s_nop 15\n\ts_nop 7" ::: "memory");
        const bool zero = E(acc, cur, wr, wc, fr, fq, eslot0 + (ui & 1) * 4096);
        if (!has_next) break;
        if (zero) {
#pragma unroll
            for (int a = 0; a < 2; ++a)
#pragma unroll
                for (int b = 0; b < 2; ++b)
#pragma unroll
                    for (int m = 0; m < 4; ++m)
#pragma unroll
                        for (int n = 0; n < 2; ++n) acc[a][b][m][n] = (f32x4){0.f, 0.f, 0.f, 0.f};
        }
        cur = nxt; cA = nA; cB = nB; ++ui;
        if (wid == 0) E.prefetch(cur, eslot0 + (ui & 1) * 4096, lane);
        if constexpr (ALIGN_EPI) { if (wr == 1) PG8_BAR; }
    }
    PG8_WAIT_V(0);
    if constexpr (!ALIGN_EPI) { if (wr == 0) PG8_BAR; }
    PG8_BAR;
#undef PG8_SA
#undef PG8_SB
#undef PG8_STAGE_A
#undef PG8_STAGE_B
#undef PG8_LDA
#undef PG8_LDB
#undef PG8_MMA
#undef PG8_LO
#undef PG8_HI
#undef PG8_WAIT_V
#undef PG8_WAIT_L
#undef PG8_BAR
#undef PG8_SCHED
}
}
using pg8::Unit;

#define XB_TMO      128
#define XB_XCNT(j)  (256  + 64 * (j))
#define XB_XSUB(j)  (1280 + 64 * (j))
#define XB_XGEN(j)  (2304 + 64 * (j))
#define XB_TOP      3328
#define XB_TOPGEN   3392
#define XCD_BAR_WORDS 3456
#define XB_SPIN_CAP (1u << 18)
__device__ __forceinline__ unsigned xb_ld(unsigned* p)              { return __hip_atomic_load(p, __ATOMIC_RELAXED, __HIP_MEMORY_SCOPE_AGENT); }
__device__ __forceinline__ unsigned xb_add(unsigned* p, unsigned v) { return __hip_atomic_fetch_add(p, v, __ATOMIC_RELAXED, __HIP_MEMORY_SCOPE_AGENT); }
__device__ __forceinline__ unsigned xb_xcc_id() { return (unsigned)__builtin_amdgcn_s_getreg((3 << 11) | 20) & 0xFu; }
#define XB_SPIN(cond, bar) do { unsigned _sp = 0; while (cond) { __builtin_amdgcn_s_sleep(1); \
    if ((++_sp & 255u) == 0u) { if (xb_ld(&(bar)[XB_TMO])) break; if (_sp > XB_SPIN_CAP) { atomicAdd(&(bar)[XB_TMO], 1u); break; } } } } while (0)
struct XcdBarrier { unsigned* bar; unsigned x; volatile LAS unsigned* st; };
__device__ __forceinline__ XcdBarrier xcd_barrier_post(unsigned* bar, volatile LAS unsigned* st) {
    XcdBarrier b; b.bar = bar; b.x = xb_xcc_id(); b.st = st;
    if (threadIdx.x == 0) (void)xb_add(&bar[XB_XCNT(b.x)], 1u);
    return b;
}
__device__ __forceinline__ void xcd_barrier_complete(unsigned* bar, unsigned x, unsigned& nloc, unsigned& nx) {
    const unsigned G = gridDim.x * gridDim.y * gridDim.z;
    unsigned sum, cnt, mine, sp = 0u;
    for (;;) {
        sum = 0u; cnt = 0u; mine = 0u;
#pragma unroll
        for (unsigned j = 0; j < 16; ++j) { const unsigned c = xb_ld(&bar[XB_XCNT(j)]); sum += c; cnt += (c > 0u) ? 1u : 0u; mine = (j == x) ? c : mine; }
        if (sum == G) break;
        __builtin_amdgcn_s_sleep(1);
        if ((++sp & 255u) == 0u) { if (xb_ld(&bar[XB_TMO])) break; if (sp > XB_SPIN_CAP) { atomicAdd(&bar[XB_TMO], 1u); break; } }
    }
    nloc = mine > 0u ? mine : 1u; nx = cnt > 0u ? cnt : 1u;
}
__device__ __forceinline__ void xcd_barrier(const XcdBarrier& b) {
    asm volatile("s_waitcnt vmcnt(0)" ::: "memory");
    __syncthreads();
    if (threadIdx.x == 0) {
        unsigned* bar = b.bar;
        __builtin_amdgcn_s_waitcnt(0);
        unsigned nloc = b.st[0], nx = b.st[1];
        if (nloc == 0u) { xcd_barrier_complete(bar, b.x, nloc, nx); b.st[0] = nloc; b.st[1] = nx; }
        const unsigned old = xb_add(&bar[XB_XSUB(b.x)], 1u);
        const unsigned gen = old / nloc;
        if (old + 1u == (gen + 1u) * nloc) {
            __builtin_amdgcn_fence(__ATOMIC_RELEASE, "agent");
            asm volatile("s_waitcnt vmcnt(0)" ::: "memory");
            const unsigned og = xb_add(&bar[XB_TOP], 1u);
            const unsigned tg = og / nx;
            if (og + 1u == (tg + 1u) * nx) xb_add(&bar[XB_TOPGEN], 1u);
            else XB_SPIN(xb_ld(&bar[XB_TOPGEN]) == tg, bar);
            __builtin_amdgcn_fence(__ATOMIC_ACQUIRE, "agent");
            xb_add(&bar[XB_XGEN(b.x)], 1u);
            asm volatile("s_waitcnt vmcnt(0)" ::: "memory");
        } else {
            XB_SPIN(xb_ld(&bar[XB_XGEN(b.x)]) == gen, bar);
            __builtin_amdgcn_fence(__ATOMIC_ACQUIRE, "agent");
            asm volatile("s_waitcnt vmcnt(0)" ::: "memory");
        }
    }
    __syncthreads();
}

struct Args { const float* in[17]; float* out; unsigned char* ws; int ph_lo, ph_hi, li, pad; };
struct Frame {
    LAS unsigned char* lds;
    int tid, lane, wave, G, vcu;
    unsigned char* ws;
};

struct MapId { __device__ __forceinline__ int operator()(int n) const { return n; } };
struct MapWin { __device__ __forceinline__ int operator()(int n) const {
    const int tile = n >> 8, bj = (n >> 7) & 1;
    if (tile == 6 || tile == 7 || (tile == 8 && bj == 0)) {
        const int hb = n & ~127, p = n & 127, wc = p >> 5, fq = (p >> 3) & 3, nn = (p >> 2) & 1, e = p & 3;
        return hb + 64 * (wc >> 1) + 32 * nn + 16 * (wc & 1) + 4 * fq + e;
    }
    return n; } };
struct MapGate { __device__ __forceinline__ int operator()(int n) const { return C_GA + 1024 * ((n >> 7) & 1) + 128 * (n >> 8) + (n & 127); } };
struct MapY16 { __device__ __forceinline__ int operator()(int n) const { const int p = n & 255, bj = p >> 7, wc = (p >> 5) & 3, fq = (p >> 3) & 3, j = p & 7; return (n & ~255) + 64 * wc + 16 * fq + 8 * bj + j; } };
struct MapW1 { __device__ __forceinline__ int operator()(int n) const { const int pn = n >> 8, r = n & 255; return 1024 * (r >> 7) + 128 * pn + (r & 127); } };

template <class Map>
__device__ __forceinline__ void p0_transpose_item(const float* W, int K, int N, bf16_t* WT, LAS float* scr, int item, int lane, const Map& map, const float* kscale, int ncols = 0) {
    const int nblk = (ncols ? ncols : N) / 64, kb = item / nblk, nb = item % nblk, k0 = 64 * kb, n0 = 64 * nb;
    const int srcc = map(n0 + 4 * (lane & 15));
    f32x4 v[16];
#pragma unroll
    for (int i = 0; i < 16; ++i) v[i] = *(const f32x4*)(W + (size_t)(k0 + 4 * i + (lane >> 4)) * N + srcc);
    if (kscale) {
#pragma unroll
        for (int i = 0; i < 16; ++i) v[i] = v[i] * kscale[k0 + 4 * i + (lane >> 4)];
    }
#pragma unroll
    for (int i = 0; i < 16; ++i) *(LAS f32x4*)(scr + (4 * i + (lane >> 4)) * 68 + 4 * (lane & 15)) = v[i];
    asm volatile("s_waitcnt lgkmcnt(0)" ::: "memory");
    const int kc = lane & 7, ngl = lane >> 3;
#pragma unroll
    for (int pp = 0; pp < 2; ++pp) {
        const int ng = 8 * pp + ngl; f32x4 r[8];
#pragma unroll
        for (int j = 0; j < 8; ++j) r[j] = *(const LAS f32x4*)(scr + (8 * kc + j) * 68 + 4 * ng);
#pragma unroll
        for (int e = 0; e < 4; ++e) { u32x4 o; o.x = pk2(r[0][e], r[1][e]); o.y = pk2(r[2][e], r[3][e]); o.z = pk2(r[4][e], r[5][e]); o.w = pk2(r[6][e], r[7][e]);
            *(u32x4*)(WT + (size_t)(n0 + 4 * ng + e) * K + k0 + 8 * kc) = o; }
    }
    asm volatile("s_waitcnt lgkmcnt(0)" ::: "memory");
}

template <class Map>
__device__ __forceinline__ void p0_transpose_item_fp8(const float* W, int K, int N, unsigned char* WT, LAS float* scr, int item, int lane, const Map& map, const float* kscale, float scale, int pitch = 0) {
    if (pitch == 0) pitch = N;
    const int nblk = N / 32, kb = item / nblk, nb = item % nblk, k0 = 128 * kb, n0 = 32 * nb;
    const int srcc = map(n0 + 4 * (lane & 7));
    f32x4 v[16];
#pragma unroll
    for (int i = 0; i < 16; ++i) v[i] = *(const f32x4*)(W + (size_t)(k0 + 8 * i + (lane >> 3)) * pitch + srcc);
#pragma unroll
    for (int i = 0; i < 16; ++i) v[i] = v[i] * (kscale ? kscale[k0 + 8 * i + (lane >> 3)] * scale : scale);
#pragma unroll
    for (int i = 0; i < 16; ++i) *(LAS f32x4*)(scr + (8 * i + (lane >> 3)) * 36 + 4 * (lane & 7)) = v[i];
    asm volatile("s_waitcnt lgkmcnt(0)" ::: "memory");
    const int kc = lane & 15, ngl = lane >> 4;
#pragma unroll
    for (int pp = 0; pp < 2; ++pp) {
        const int ng = 4 * pp + ngl; f32x4 r[8];
#pragma unroll
        for (int j = 0; j < 8; ++j) r[j] = *(const LAS f32x4*)(scr + (8 * kc + j) * 36 + 4 * ng);
#pragma unroll
        for (int e = 0; e < 4; ++e) { u32x2 o; o.x = pk4_fp8(r[0][e], r[1][e], r[2][e], r[3][e]); o.y = pk4_fp8(r[4][e], r[5][e], r[6][e], r[7][e]);
            *(u32x2*)(WT + (size_t)(n0 + 4 * ng + e) * K + k0 + 8 * kc) = o; }
    }
    asm volatile("s_waitcnt lgkmcnt(0)" ::: "memory");
}

struct F8Item { const float* W; unsigned char* WT; int K, N, k0, n0, srcc; f32x4 ks0, ks1; };
template <class Map> __device__ __forceinline__ void f8_item_load(F8Item& I, const float* W, int K, int N, unsigned char* WT, int item, int lane, const Map& map, const float* kscale, f32x4 (&v)[16]) {
    const int nblk = N / 32, kb = item / nblk, nb = item % nblk;
    I.W = W; I.WT = WT; I.K = K; I.N = N; I.k0 = 128 * kb; I.n0 = 32 * nb; I.srcc = map(I.n0 + 4 * (lane & 7));
    if (kscale) { const float* kp = kscale + I.k0 + 8 * (lane & 15); I.ks0 = *(const f32x4*)kp; I.ks1 = *(const f32x4*)(kp + 4); }
    else { I.ks0 = (f32x4){1.f, 1.f, 1.f, 1.f}; I.ks1 = I.ks0; }
#pragma unroll
    for (int i = 0; i < 16; ++i) v[i] = *(const f32x4*)(W + (size_t)(I.k0 + 8 * i + (lane >> 3)) * N + I.srcc);
}
__device__ __forceinline__ void f8_item_finish(const F8Item& I, LAS float* scr, int lane, f32x4 (&v)[16], float scale) {
#pragma unroll
    for (int i = 0; i < 16; ++i) *(LAS f32x4*)(scr + (8 * i + (lane >> 3)) * 36 + 4 * (lane & 7)) = v[i];
    asm volatile("s_waitcnt lgkmcnt(0)" ::: "memory");
    const int kc = lane & 15, ngl = lane >> 4;
    const f32x4 s0 = I.ks0 * scale, s1 = I.ks1 * scale;
#pragma unroll
    for (int pp = 0; pp < 2; ++pp) {
        const int ng = 4 * pp + ngl; f32x4 r[8];
#pragma unroll
        for (int j = 0; j < 8; ++j) r[j] = *(const LAS f32x4*)(scr + (8 * kc + j) * 36 + 4 * ng) * (j < 4 ? s0[j] : s1[j - 4]);
#pragma unroll
        for (int e = 0; e < 4; ++e) { u32x2 o; o.x = pk4_fp8(r[0][e], r[1][e], r[2][e], r[3][e]); o.y = pk4_fp8(r[4][e], r[5][e], r[6][e], r[7][e]);
            *(u32x2*)(I.WT + (size_t)(I.n0 + 4 * ng + e) * I.K + I.k0 + 8 * kc) = o; }
    }
    asm volatile("s_waitcnt lgkmcnt(0)" ::: "memory");
}

__device__ __forceinline__ void p0_prologue(Frame& F, const Args& a) {
    LAS float* scr = (LAS float*)(F.lds + F.wave * 18432);
    const int gw = F.vcu * NWAVES + F.wave, NGW = F.G * NWAVES;
    const float* w_in = a.in[2]; const float* w_up_a = a.in[6]; const float* w_up_b = a.in[7]; const float* w_out = a.in[8];
    const float* w1 = a.in[12]; const float* w2 = a.in[14]; const float* g2 = a.in[9];
    bf16_t* Win_t = (bf16_t*)(F.ws + WS_WIN); bf16_t* Wa_t = (bf16_t*)(F.ws + WS_WA); bf16_t* Wb_t = (bf16_t*)(F.ws + WS_WB); bf16_t* Wout_t = (bf16_t*)(F.ws + WS_WOUT);
    unsigned char* W1_t = (unsigned char*)(F.ws + WS_W1); unsigned char* W2_t = (unsigned char*)(F.ws + WS_W2);
    constexpr int I_IN = (D / 64) * (C_GA / 64), I_G8 = (D / 128) * (2048 / 32), I_UP = (512 / 64) * (D / 64), I_OUT = (D / 64) * (D / 64), I_W1 = (D / 128) * (2 * FF / 32), I_W2 = (FF / 128) * (D / 32);
        constexpr int NSMALL = I_IN + I_G8 + 2 * I_UP + I_OUT, NEXPERT = NEXP * (I_W1 + I_W2);
    for (int it = gw; it < NSMALL; it += NGW) {
        int r = it;
        if (r < I_IN) { p0_transpose_item(w_in, D, DIN, Win_t, scr, r, F.lane, MapWin(), nullptr, C_GA); continue; } r -= I_IN;
        if (r < I_G8) { p0_transpose_item_fp8(w_in, D, 2048, (unsigned char*)(F.ws + WS_WING8), scr, r, F.lane, MapGate(), nullptr, F8_W, DIN); continue; } r -= I_G8;
        if (r < I_UP) { p0_transpose_item(w_up_a, 512, D, Wa_t, scr, r, F.lane, MapId(), nullptr); continue; } r -= I_UP;
        if (r < I_UP) { p0_transpose_item(w_up_b, 512, D, Wb_t, scr, r, F.lane, MapId(), nullptr); continue; } r -= I_UP;
        p0_transpose_item(w_out, D, D, Wout_t, scr, r, F.lane, MapId(), nullptr);
    }
#define F8_LOAD(I_, V_, r_) do { const int rr_ = (r_); const bool w1_ = rr_ < NEXP * I_W1; const int r2_ = w1_ ? rr_ : rr_ - NEXP * I_W1; \
        const int e_ = w1_ ? r2_ / I_W1 : r2_ / I_W2, q_ = w1_ ? r2_ % I_W1 : r2_ % I_W2, N_ = w1_ ? 2 * FF : D, nblk_ = N_ / 32, kb_ = q_ / nblk_, nb_ = q_ % nblk_; \
        I_.W = w1_ ? w1 + (size_t)e_ * D * 2 * FF : w2 + (size_t)e_ * FF * D; I_.WT = w1_ ? W1_t + (size_t)e_ * 2 * FF * D : W2_t + (size_t)e_ * D * FF; \
        I_.K = D; I_.N = N_; I_.k0 = 128 * kb_; I_.n0 = 32 * nb_; { const int n_ = I_.n0 + 4 * (F.lane & 7); I_.srcc = w1_ ? MapW1()(n_) : MapY16()(n_); } \
        { const float* kp_ = g2 + I_.k0 + 8 * (F.lane & 15); const f32x4 k0_ = *(const f32x4*)kp_, k1_ = *(const f32x4*)(kp_ + 4); const f32x4 one_ = {1.f, 1.f, 1.f, 1.f}; \
          I_.ks0 = w1_ ? k0_ : one_; I_.ks1 = w1_ ? k1_ : one_; } \
        _Pragma("unroll") for (int i_ = 0; i_ < 16; ++i_) V_[i_] = *(const f32x4*)(I_.W + (size_t)(I_.k0 + 8 * i_ + (F.lane >> 3)) * N_ + I_.srcc); } while (0)
    {
        static_assert(D == FF && (NEXP * ((D / 128) * (2 * FF / 32) + (FF / 128) * (D / 32))) % 16 == 0, "expert items: K = 1024 for both weight sets, item count a multiple of the waves per block");
        F8Item IA, IB; f32x4 va[16], vb[16];
        constexpr int NPAIR = NEXPERT / 2;
        int r = gw;
        if (r < NPAIR) {
            F8_LOAD(IA, va, 2 * r);
#pragma unroll 1
            for (;;) {
                __builtin_amdgcn_s_barrier(); F8_LOAD(IB, vb, 2 * r + 1);
                f8_item_finish(IA, scr, F.lane, va, F8_W);
                const bool hn = r + NGW < NPAIR; __builtin_amdgcn_s_barrier(); F8_LOAD(IA, va, hn ? 2 * (r + NGW) : 2 * r + 1);
                f8_item_finish(IB, scr, F.lane, vb, F8_W);
                if (!hn) break;
                r += NGW;
            }
        }
    }
#undef F8_LOAD
    const float* x = a.in[0]; const float* g1 = a.in[1]; bf16_t* H1 = (bf16_t*)(F.ws + WS_H1);
    f32x4 gv[4];
#pragma unroll
    for (int j = 0; j < 4; ++j) gv[j] = *((const f32x4*)g1 + F.lane + 64 * j);
    for (int m = 2 * gw; m < T; m += 2 * NGW) {
        const f32x4* xr = (const f32x4*)(x + (size_t)m * D) + F.lane;
        f32x4 v[2][4]; float s[2] = {0.f, 0.f};
#pragma unroll
        for (int q = 0; q < 2; ++q)
#pragma unroll
            for (int j = 0; j < 4; ++j) v[q][j] = xr[q * 256 + 64 * j];
#pragma unroll
        for (int q = 0; q < 2; ++q)
#pragma unroll
            for (int j = 0; j < 4; ++j) s[q] += (v[q][j].x * v[q][j].x + v[q][j].y * v[q][j].y) + (v[q][j].z * v[q][j].z + v[q][j].w * v[q][j].w);
#pragma unroll
        for (int q = 0; q < 2; ++q) {
            const float rstd = 1.0f / sqrtf(wave_sum(s[q]) * (1.f / D) + RMS_EPS);
            u32x2* o8 = (u32x2*)(H1 + (size_t)(m + q) * D) + F.lane; unsigned* o4 = (unsigned*)(F.ws + WS_H1Q + (size_t)(m + q) * D) + F.lane;
#pragma unroll
            for (int j = 0; j < 4; ++j) { const f32x4 hv = v[q][j] * rstd * gv[j]; u32x2 w; w.x = pk2(hv.x, hv.y); w.y = pk2(hv.z, hv.w); o8[64 * j] = w;
                o4[64 * j] = pk4_fp8(hv.x * F8_ACT, hv.y * F8_ACT, hv.z * F8_ACT, hv.w * F8_ACT); }
        }
    }
    float* rope = (float*)(F.ws + WS_ROPE);
    for (int idx = (F.vcu * NTHREADS + F.tid); idx < SEQ * 32; idx += F.G * NTHREADS) {
        const int pos = idx >> 5, i = idx & 31;
        const float invf = (float)exp2(-(double)i * (13.287712379549449 / 32.0));
        const float ang = (float)pos * invf;
        double rev = (double)ang * 0.15915494309189535; rev -= floor(rev);
        const float rv = (float)rev;
        rope[2 * idx] = __builtin_amdgcn_cosf(rv); rope[2 * idx + 1] = __builtin_amdgcn_sinf(rv);
    }
    float* bt = (float*)(F.ws + WS_BT); const float* rpb = a.in[4];
    for (int idx = (F.vcu * NTHREADS + F.tid); idx < 8 * 4 * 15 * 2 * 64 * 4; idx += F.G * NTHREADS) {
        const int reg = idx & 3, ln = (idx >> 2) & 63, hf = (idx >> 8) & 1; int rest = idx >> 9; const int dr = rest % 15; rest /= 15; const int gq = rest & 3, h = rest >> 2;
        const int c = 16 * gq + (ln & 15), base = (gq == 0) ? 0 : (gq == 1) ? 8 : (gq == 2) ? 24 : 32, kc = base + 16 * hf + 4 * (ln >> 4) + reg;
        const int cs = min(max(c - 8, 0), 48);
        bt[idx] = (kc >= cs && kc < cs + 16) ? rpb[h * 465 + dr * 31 + (kc - c + 15)] * LOG2E : -INFINITY;
    }
}

struct DenseSched {
    pg8::StaticOrder so; const char* A; unsigned lda; const char* Bt; int K;
    __device__ __forceinline__ bool next(int i, Unit& u) const { return so.next(i, u); }
    __device__ __forceinline__ const char* a_base(const Unit& u) const { return A + (size_t)u.pm * 256 * lda; }
    static constexpr bool GATHER = false;
    __device__ __forceinline__ unsigned a_off(const Unit&, int rho, const LAS unsigned char*) const { return (unsigned)rho * lda; }
    __device__ __forceinline__ const char* b_base(const Unit& u) const { return Bt + (size_t)u.pn * 256 * K; }
};
struct UpSched {
    pg8::StaticOrder so; const char* OA; const char* OB; const char* Wa; const char* Wb;
    __device__ __forceinline__ bool next(int i, Unit& u) const { const bool ok = so.next(i >> 1, u); u.part = i & 1; return ok; }
    __device__ __forceinline__ const char* a_base(const Unit& u) const { return (u.part ? OB : OA) + (size_t)u.pm * 256 * 1024; }
    static constexpr bool GATHER = false;
    __device__ __forceinline__ unsigned a_off(const Unit&, int rho, const LAS unsigned char*) const { return (unsigned)rho * 1024u; }
    __device__ __forceinline__ const char* b_base(const Unit& u) const { return (u.part ? Wb : Wa) + (size_t)u.pn * 256 * 512 * 2; }
};
template <bool GATHER_> struct MoeSched {
    static constexpr bool GATHER = GATHER_;
    const LAS int* tstart; const LAS int* cnt; const LAS unsigned char* t2e; int G, vcu, log_mt, total;
    const char* A; const int* list; const char* Bt; size_t b_estride; int K;
    __device__ __forceinline__ bool next(int i, Unit& u) const {
        const int L = i * G + vcu; const int blk = L >> 5, w = L & 31;
        const int mtg = (blk << log_mt) + (w & ((1 << log_mt) - 1)), pn = w >> log_mt;
        if (mtg >= total) return false;
        const int e = t2e[mtg];
        u.e = __builtin_amdgcn_readfirstlane(e); u.pm = __builtin_amdgcn_readfirstlane(mtg); u.mt = __builtin_amdgcn_readfirstlane(mtg - tstart[e]); u.pn = __builtin_amdgcn_readfirstlane(pn); u.part = 0; return true;
    }
    __device__ __forceinline__ const char* a_base(const Unit& u) const { return GATHER ? A : A + (size_t)u.pm * 256 * 1024; }
    __device__ __forceinline__ void rows_prefetch(const Unit& u, LAS unsigned char* dst, int lane) const {
        __builtin_amdgcn_global_load_lds((const unsigned*)(list + (size_t)u.e * LISTCAP + u.mt * 256 + 4 * lane), (LAS unsigned*)dst, 16, 0, 0); }
    __device__ __forceinline__ unsigned a_off(const Unit& u, int rho, const LAS unsigned char* rows) const {
        if (!GATHER) return (unsigned)rho * 1024u;
        const int tk = ((const LAS int*)rows)[rho];
        return (u.mt * 256 + rho < cnt[u.e]) ? (unsigned)(tk >> 2) * 1024u : 0u;
    }
    __device__ __forceinline__ const char* b_base(const Unit& u) const { return Bt + (size_t)u.e * b_estride + (size_t)u.pn * 256 * K; }
};

__device__ __forceinline__ size_t hm_off(int t, int nh, int h, int d) { return ((size_t)((t >> 13) * nh + h) * SEQ + (t & (SEQ - 1))) * 64 + d; }
struct EpiInProj {
    unsigned char* ws; const float* bias; const float* rope;
    __device__ __forceinline__ void prefetch(const Unit& u, LAS unsigned char* es, int lane) const {
        __builtin_amdgcn_global_load_lds((const unsigned*)(bias + 256 * u.pn + 4 * lane), (LAS unsigned*)es, 16, 0, 0); }
    __device__ __forceinline__ bool operator()(f32x4 (&acc)[2][2][4][2], const Unit& u, int wr, int wc, int fr, int fq, const LAS unsigned char* es) const {
        const int pn = u.pn; const int row0 = u.pm * 256 + wr * 64 + fr;
#pragma unroll
        for (int bj = 0; bj < 2; ++bj) {
            const bool rp = (pn == 6 || pn == 7 || (pn == 8 && bj == 0));
            const int hb = 256 * pn + 128 * bj;
            if (rp) {
                const int Lb = hb + 64 * (wc >> 1) + 16 * (wc & 1) + 4 * fq, i0 = 16 * (wc & 1) + 4 * fq;
                const LAS float* bl = (const LAS float*)es - 256 * pn;
                const f32x4 b1v = *(const LAS f32x4*)(bl + Lb), b2v = *(const LAS f32x4*)(bl + Lb + 32);
                const float sc = (pn <= 7) ? QSCALE : 1.0f;
                bf16_t* dst = (bf16_t*)(ws + (pn <= 7 ? WS_QB : WS_KB)); const int nh = (pn <= 7) ? 8 : 2; const int cl = Lb - (pn <= 7 ? C_QB : C_KB);
#pragma unroll
                for (int ai = 0; ai < 2; ++ai) {
                    f32x4 cs0a[4], cs1a[4];
#pragma unroll
                    for (int m = 0; m < 4; ++m) { const int pos = (row0 + ai * 128 + m * 16) & (SEQ - 1);
                        cs0a[m] = *(const f32x4*)(rope + (size_t)(pos * 32 + i0) * 2); cs1a[m] = *(const f32x4*)(rope + (size_t)(pos * 32 + i0) * 2 + 4); }
                    asm volatile("" ::: "memory");
#pragma unroll
                    for (int m = 0; m < 4; ++m) {
                        const int row = row0 + ai * 128 + m * 16;
                        const f32x4 cs0 = cs0a[m], cs1 = cs1a[m];
                        const f32x4 x1 = acc[ai][bj][m][0] + b1v, x2 = acc[ai][bj][m][1] + b2v;
                        const float c[4] = {cs0.x, cs0.z, cs1.x, cs1.z}, s[4] = {cs0.y, cs0.w, cs1.y, cs1.w};
                        float o1[4], o2[4];
#pragma unroll
                        for (int e = 0; e < 4; ++e) { o1[e] = (x1[e] * c[e] - x2[e] * s[e]) * sc; o2[e] = (x2[e] * c[e] + x1[e] * s[e]) * sc; }
                        bf16_t* rp_ = dst + hm_off(row, nh, cl >> 6, cl & 63);
                        u32x2 w1; w1.x = pk2(o1[0], o1[1]); w1.y = pk2(o1[2], o1[3]); *(u32x2*)rp_ = w1;
                        u32x2 w2; w2.x = pk2(o2[0], o2[1]); w2.y = pk2(o2[2], o2[3]); *(u32x2*)(rp_ + 32) = w2;
                    }
                }
            } else {
                const int c0 = hb + 32 * wc + 8 * fq;
                const LAS float* bl = (const LAS float*)es - 256 * pn;
                const f32x4 b0 = *(const LAS f32x4*)(bl + c0), b1 = *(const LAS f32x4*)(bl + c0 + 4);
                const int mode = (pn <= 1) ? 1 : (pn >= 9 ? 2 : 0);
                bf16_t* dst; int nh = 8, cl;
                if (pn <= 1) { dst = (bf16_t*)(ws + WS_QA); cl = c0 - C_QA; }
                else if (pn <= 3) { dst = (bf16_t*)(ws + WS_KA); cl = c0 - C_KA; }
                else if (pn <= 5) { dst = (bf16_t*)(ws + WS_VA); cl = c0 - C_VA; }
                else if (pn == 8) { dst = (bf16_t*)(ws + WS_VB); cl = c0 - C_VB; nh = 2; }
                else { dst = (bf16_t*)(ws + WS_SG); cl = c0 - C_GA; }
#pragma unroll
                for (int ai = 0; ai < 2; ++ai)
#pragma unroll
                    for (int m = 0; m < 4; ++m) {
                        const int row = row0 + ai * 128 + m * 16;
                        f32x4 v0 = acc[ai][bj][m][0] + b0, v1 = acc[ai][bj][m][1] + b1;
                        if (mode == 1) { v0 = v0 * QSCALE; v1 = v1 * QSCALE; }
                        if (mode == 2) {
#pragma unroll
                            for (int e = 0; e < 4; ++e) { v0[e] = sigmoidf_(v0[e]); v1[e] = sigmoidf_(v1[e]); } }
                        u32x4 w; w.x = pk2(v0[0], v0[1]); w.y = pk2(v0[2], v0[3]); w.z = pk2(v1[0], v1[1]); w.w = pk2(v1[2], v1[3]);
                        bf16_t* p_ = (pn >= 9) ? dst + (size_t)row * 2048 + cl : dst + hm_off(row, nh, cl >> 6, cl & 63);
                        *(u32x4*)p_ = w;
                    }
            }
        }
        return true;
    }
};
struct EpiGate {
    bf16_t* SG; const float* bias;
    __device__ __forceinline__ void prefetch(const Unit& u, LAS unsigned char* es, int lane) const {
        const float* s = bias + C_GA + 128 * u.pn + (lane < 32 ? 4 * lane : 1024 + 4 * (lane - 32));
        __builtin_amdgcn_global_load_lds((const unsigned*)s, (LAS unsigned*)es, 16, 0, 0); }
    __device__ __forceinline__ bool operator()(f32x4 (&acc)[2][2][4][2], const Unit& u, int wr, int wc, int fr, int fq, const LAS unsigned char* es) const {
        const int row0 = u.pm * 256 + wr * 64 + fr, ch = 32 * wc + 8 * fq;
        const LAS float* bl = (const LAS float*)es + ch;
        f32x4 za_b[2], zb_b[2];
        za_b[0] = *(const LAS f32x4*)bl * -LOG2E; za_b[1] = *(const LAS f32x4*)(bl + 4) * -LOG2E; zb_b[0] = *(const LAS f32x4*)(bl + 128) * -LOG2E; zb_b[1] = *(const LAS f32x4*)(bl + 132) * -LOG2E;
#pragma unroll
        for (int ai = 0; ai < 2; ++ai)
#pragma unroll
            for (int m = 0; m < 4; ++m) {
                const int row = row0 + ai * 128 + m * 16;
                float rt[8], sb[8];
#pragma unroll
                for (int n = 0; n < 2; ++n) {
                    const f32x4 za = acc[ai][0][m][n] * (-F8_INV * LOG2E) + za_b[n], zb = acc[ai][1][m][n] * (-F8_INV * LOG2E) + zb_b[n];
#pragma unroll
                    for (int e = 0; e < 4; ++e) {
                        const float da = 1.0f + __builtin_amdgcn_exp2f(fminf(za[e], 60.0f)), db = 1.0f + __builtin_amdgcn_exp2f(fminf(zb[e], 60.0f));
                        const float r = __builtin_amdgcn_rcpf(da * db), sga = db * r;
                        sb[4 * n + e] = da * r; rt[4 * n + e] = db * sga;
                    }
                }
                u32x4 w; w.x = pk2(rt[0], rt[1]); w.y = pk2(rt[2], rt[3]); w.z = pk2(rt[4], rt[5]); w.w = pk2(rt[6], rt[7]);
                *(u32x4*)(SG + (size_t)row * 2048 + 128 * u.pn + ch) = w;
                w.x = pk2(sb[0], sb[1]); w.y = pk2(sb[2], sb[3]); w.z = pk2(sb[4], sb[5]); w.w = pk2(sb[6], sb[7]);
                *(u32x4*)(SG + (size_t)row * 2048 + 1024 + 128 * u.pn + ch) = w;
            }
        return true;
    }
};
struct EpiUp {
    const bf16_t* P; bf16_t* Mg;
    __device__ __forceinline__ void prefetch(const Unit&, LAS unsigned char*, int) const {}
    template <int PART>
    __device__ __forceinline__ void run(f32x4 (&acc)[2][2][4][2], const Unit& u, int wr, int wc, int fr, int fq) const {
        const int row0 = u.pm * 256 + wr * 64 + fr, cb = u.pn * 256 + 32 * wc + 8 * fq;
        const bf16_t* Pp = P + (PART ? 1024 : 0) + (size_t)row0 * 2048 + cb;
        u32x4 g[2][4][2];
#pragma unroll
        for (int ai = 0; ai < 2; ++ai)
#pragma unroll
            for (int m = 0; m < 4; ++m)
#pragma unroll
                for (int bj = 0; bj < 2; ++bj) g[ai][m][bj] = *(const u32x4*)(Pp + (size_t)(ai * 128 + m * 16) * 2048 + 128 * bj);
        __builtin_amdgcn_sched_barrier(0);
#pragma unroll
        for (int ai = 0; ai < 2; ++ai)
#pragma unroll
            for (int m = 0; m < 4; ++m)
#pragma unroll
                for (int bj = 0; bj < 2; ++bj) {
                    const u32x4 gb = g[ai][m][bj];
                    const float sb[8] = {bflo(gb.x), bfhi(gb.x), bflo(gb.y), bfhi(gb.y), bflo(gb.z), bfhi(gb.z), bflo(gb.w), bfhi(gb.w)};
                    if constexpr (PART == 0) {
#pragma unroll
                        for (int e = 0; e < 4; ++e) { acc[ai][bj][m][0][e] *= sb[e]; acc[ai][bj][m][1][e] *= sb[4 + e]; }
                    } else {
                        const f32x4 v0 = acc[ai][bj][m][0], v1 = acc[ai][bj][m][1];
                        u32x4 w; w.x = pk2(v0[0] * sb[0], v0[1] * sb[1]); w.y = pk2(v0[2] * sb[2], v0[3] * sb[3]); w.z = pk2(v1[0] * sb[4], v1[1] * sb[5]); w.w = pk2(v1[2] * sb[6], v1[3] * sb[7]);
                        *(u32x4*)(Mg + (size_t)(row0 + ai * 128 + m * 16) * D + cb + 128 * bj) = w;
                    }
                }
    }
    __device__ __forceinline__ bool operator()(f32x4 (&acc)[2][2][4][2], const Unit& u, int wr, int wc, int fr, int fq, const LAS unsigned char* es) const {
        if (u.part == 0) run<0>(acc, u, wr, wc, fr, fq); else run<1>(acc, u, wr, wc, fr, fq);
        return u.part != 0;
    }
};
struct EpiAo {
    bf16_t* AO;
    __device__ __forceinline__ void prefetch(const Unit&, LAS unsigned char*, int) const {}
    __device__ __forceinline__ bool operator()(f32x4 (&acc)[2][2][4][2], const Unit& u, int wr, int wc, int fr, int fq, const LAS unsigned char* es) const {
        const int row0 = u.pm * 256 + wr * 64 + fr, col0 = u.pn * 256 + wc * 32 + 8 * fq;
#pragma unroll
        for (int ai = 0; ai < 2; ++ai)
#pragma unroll
            for (int m = 0; m < 4; ++m) {
                bf16_t* rowp = AO + (size_t)(row0 + ai * 128 + m * 16) * D + col0;
#pragma unroll
                for (int bj = 0; bj < 2; ++bj) { const f32x4 v0 = acc[ai][bj][m][0], v1 = acc[ai][bj][m][1];
                    u32x4 w; w.x = pk2(v0[0], v0[1]); w.y = pk2(v0[2], v0[3]); w.z = pk2(v1[0], v1[1]); w.w = pk2(v1[2], v1[3]); *(u32x4*)(rowp + bj * 128) = w; }
            }
        return true;
    }
};
struct EpiMoe1 {
    const float* b1; unsigned char* H;
    __device__ __forceinline__ void prefetch(const Unit& u, LAS unsigned char* es, int lane) const {
        const float* s = b1 + (size_t)u.e * 2 * FF + 128 * u.pn + (lane < 32 ? 4 * lane : FF + 4 * (lane - 32));
        __builtin_amdgcn_global_load_lds((const unsigned*)s, (LAS unsigned*)es, 16, 0, 0); }
    __device__ __forceinline__ bool operator()(f32x4 (&acc)[2][2][4][2], const Unit& u, int wr, int wc, int fr, int fq, const LAS unsigned char* es) const {
        const int p0 = 32 * wc + 8 * fq;
        const LAS float* bg = (const LAS float*)es + p0;
        constexpr float KS = -1.702f * LOG2E, QC = F8_ACT / KS;
        f32x4 bz[2], bq[2];
        bz[0] = *(const LAS f32x4*)bg * KS; bz[1] = *(const LAS f32x4*)(bg + 4) * KS; bq[0] = *(const LAS f32x4*)(bg + 128) * QC + QC; bq[1] = *(const LAS f32x4*)(bg + 132) * QC + QC;
#pragma unroll
        for (int ai = 0; ai < 2; ++ai)
#pragma unroll
            for (int m = 0; m < 4; ++m) {
                const int rho = 128 * ai + 64 * wr + 16 * m + fr;
                float a8[8];
#pragma unroll
                for (int n = 0; n < 2; ++n) {
                    const f32x4 z4 = acc[ai][0][m][n] * (F8_INV * KS) + bz[n], q4 = acc[ai][1][m][n] * (F8_INV * QC) + bq[n];
#pragma unroll
                    for (int p = 0; p < 2; ++p) {
                        f32x2 z = {__builtin_amdgcn_fmed3f(z4[2 * p], 7.0f * KS, 40.0f), __builtin_amdgcn_fmed3f(z4[2 * p + 1], 7.0f * KS, 40.0f)};
                        f32x2 q = {__builtin_amdgcn_fmed3f(q4[2 * p], 8.0f * QC, -6.0f * QC), __builtin_amdgcn_fmed3f(q4[2 * p + 1], 8.0f * QC, -6.0f * QC)};
                        f32x2 d = {__builtin_amdgcn_exp2f(z.x), __builtin_amdgcn_exp2f(z.y)};
                        d = d + 1.0f;
                        const f32x2 nn = q * z; const float r = __builtin_amdgcn_rcpf(d.x * d.y);
                        const f32x2 o = nn * __builtin_shufflevector(d, d, 1, 0) * r;
                        a8[4 * n + 2 * p] = o.x; a8[4 * n + 2 * p + 1] = o.y;
                    }
                }
                u32x2 w; w.x = pk4_fp8(a8[0], a8[1], a8[2], a8[3]); w.y = pk4_fp8(a8[4], a8[5], a8[6], a8[7]);
                *(u32x2*)(H + (size_t)(u.pm * 256 + rho) * FF + 128 * u.pn + p0) = w;
            }
        return true;
    }
};
struct EpiMoe2 {
    const LAS int* cnt; const float* gwl; const float* b2; unsigned char* Y;
    __device__ __forceinline__ void prefetch(const Unit& u, LAS unsigned char* es, int lane) const {
        __builtin_amdgcn_global_load_lds((const unsigned*)(b2 + (size_t)u.e * D + 256 * u.pn + 4 * lane), (LAS unsigned*)es, 16, 0, 0);
        __builtin_amdgcn_global_load_lds((const unsigned*)(gwl + (size_t)u.e * LISTCAP + u.mt * 256 + 4 * lane), (LAS unsigned*)(es + 1024), 16, 0, 0); }
    __device__ __forceinline__ bool operator()(f32x4 (&acc)[2][2][4][2], const Unit& u, int wr, int wc, int fr, int fq, const LAS unsigned char* es) const {
        const int n_e = cnt[u.e]; const int cl = 64 * wc + 16 * fq;
        f32x4 bv[2][2];
#pragma unroll
        for (int bj = 0; bj < 2; ++bj)
#pragma unroll
            for (int n = 0; n < 2; ++n) bv[bj][n] = *(const LAS f32x4*)((const LAS float*)es + cl + 8 * bj + 4 * n);
        float gw[2][4];
#pragma unroll
        for (int ai = 0; ai < 2; ++ai)
#pragma unroll
            for (int m = 0; m < 4; ++m) gw[ai][m] = ((const LAS float*)(es + 1024))[128 * ai + 64 * wr + 16 * m + fr] * F8_Y;
#pragma unroll
        for (int ai = 0; ai < 2; ++ai)
#pragma unroll
            for (int m = 0; m < 4; ++m) {
                const int rho = 128 * ai + 64 * wr + 16 * m + fr;
                if (u.mt * 256 + rho < n_e) {
                    const float g_ = gw[ai][m];
                    u32x4 w;
#pragma unroll
                    for (int bj = 0; bj < 2; ++bj) {
                        const f32x4 v0 = (acc[ai][bj][m][0] * F8_INV + bv[bj][0]) * g_, v1 = (acc[ai][bj][m][1] * F8_INV + bv[bj][1]) * g_;
                        w[2 * bj] = pk4_fp8(v0[0], v0[1], v0[2], v0[3]); w[2 * bj + 1] = pk4_fp8(v1[0], v1[1], v1[2], v1[3]);
                    }
                    *(u32x4*)(Y + (size_t)(u.pm * 256 + rho) * D + u.pn * 256 + cl) = w;
                }
            }
        return true;
    }
};

__device__ __forceinline__ void ld64(const bf16_t* p, float (&f)[64]) {
#pragma unroll
    for (int i = 0; i < 8; ++i) { const u32x4 w = *((const u32x4*)p + i); f[8 * i] = bflo(w.x); f[8 * i + 1] = bfhi(w.x); f[8 * i + 2] = bflo(w.y); f[8 * i + 3] = bfhi(w.y); f[8 * i + 4] = bflo(w.z); f[8 * i + 5] = bfhi(w.z); f[8 * i + 6] = bflo(w.w); f[8 * i + 7] = bfhi(w.w); }
}
__device__ __forceinline__ float dot64(const bf16_t* p, const float (&q)[64]) {
    float s = 0.f;
#pragma unroll
    for (int i = 0; i < 8; ++i) { const u32x4 w = *((const u32x4*)p + i);
        s += q[8 * i] * bflo(w.x) + q[8 * i + 1] * bfhi(w.x) + q[8 * i + 2] * bflo(w.y) + q[8 * i + 3] * bfhi(w.y) + q[8 * i + 4] * bflo(w.z) + q[8 * i + 5] * bfhi(w.z) + q[8 * i + 6] * bflo(w.w) + q[8 * i + 7] * bfhi(w.w); }
    return s;
}
__device__ __forceinline__ void axpy64(const bf16_t* p, float a, float pw, float (&o)[64]) {
#pragma unroll
    for (int i = 0; i < 8; ++i) { const u32x4 w = *((const u32x4*)p + i);
        o[8 * i] = o[8 * i] * a + pw * bflo(w.x); o[8 * i + 1] = o[8 * i + 1] * a + pw * bfhi(w.x); o[8 * i + 2] = o[8 * i + 2] * a + pw * bflo(w.y); o[8 * i + 3] = o[8 * i + 3] * a + pw * bfhi(w.y);
        o[8 * i + 4] = o[8 * i + 4] * a + pw * bflo(w.z); o[8 * i + 5] = o[8 * i + 5] * a + pw * bfhi(w.z); o[8 * i + 6] = o[8 * i + 6] * a + pw * bflo(w.w); o[8 * i + 7] = o[8 * i + 7] * a + pw * bfhi(w.w); }
}
__device__ __forceinline__ void st64(bf16_t* p, const float (&o)[64], float inv) {
#pragma unroll
    for (int i = 0; i < 8; ++i) { u32x4 w; w.x = pk2(o[8 * i] * inv, o[8 * i + 1] * inv); w.y = pk2(o[8 * i + 2] * inv, o[8 * i + 3] * inv); w.z = pk2(o[8 * i + 4] * inv, o[8 * i + 5] * inv); w.w = pk2(o[8 * i + 6] * inv, o[8 * i + 7] * inv); *((u32x4*)p + i) = w; }
}
__device__ __forceinline__ void attn_naive(Frame& F, const Args& a) {
    const bf16_t* QA = (const bf16_t*)(F.ws + WS_QA); const bf16_t* KA = (const bf16_t*)(F.ws + WS_KA); const bf16_t* VA = (const bf16_t*)(F.ws + WS_VA);
    const bf16_t* QB = (const bf16_t*)(F.ws + WS_QB); const bf16_t* KB = (const bf16_t*)(F.ws + WS_KB); const bf16_t* VB = (const bf16_t*)(F.ws + WS_VB);
    bf16_t* OA = (bf16_t*)(F.ws + WS_OA); bf16_t* OB = (bf16_t*)(F.ws + WS_OB);
    const float* rpb = a.in[4]; const float* sinks = a.in[5];
    const int gt = F.vcu * NTHREADS + F.tid, NGT = F.G * NTHREADS;
    for (int it = gt; it < T * 16; it += NGT) {
        const int t = it >> 4, hh = it & 15; const int b = t >> 13, s = t & (SEQ - 1);
        float q[64], o[64];
#pragma unroll
        for (int d = 0; d < 64; ++d) o[d] = 0.f;
        if (hh < 8) {
            const int h = hh, r = s >> 6, c = s & 63; const int rs = min(max(r - 4, 0), 120), cs = min(max(c - 8, 0), 48);
            ld64(QA + hm_off(t, 8, h, 0), q);
            float m = -INFINITY, l = 0.f;
            for (int kr = 0; kr < 8; ++kr)
                for (int kc = 0; kc < 16; ++kc) {
                    const int kt = (b << 13) + ((rs + kr) << 6) + cs + kc;
                    float sc = dot64(KA + hm_off(kt, 8, h, 0), q) + rpb[h * 15 * 31 + (rs + kr - r + 7) * 31 + (cs + kc - c + 15)] * LOG2E;
                    const float mn = fmaxf(m, sc), al = __builtin_amdgcn_exp2f(m - mn), pw = __builtin_amdgcn_exp2f(sc - mn);
                    l = l * al + pw; axpy64(VA + hm_off(kt, 8, h, 0), al, pw, o); m = mn;
                }
            st64(OA + (size_t)t * 512 + h * 64, o, 1.0f / l);
        } else {
            const int hq = hh - 8, kvh = hq >> 2;
            ld64(QB + hm_off(t, 8, hq, 0), q);
            float m = sinks[hq] * LOG2E, l = 1.f;
            const int j0 = max(s - 128, 0), j1 = min(s + 128, SEQ - 1);
            for (int j = j0; j <= j1; ++j) {
                const int kt = (b << 13) + j;
                const float sc = dot64(KB + hm_off(kt, 2, kvh, 0), q);
                const float mn = fmaxf(m, sc), al = __builtin_amdgcn_exp2f(m - mn), pw = __builtin_amdgcn_exp2f(sc - mn);
                l = l * al + pw; axpy64(VB + hm_off(kt, 2, kvh, 0), al, pw, o); m = mn;
            }
            st64(OB + (size_t)t * 512 + hq * 64, o, 1.0f / l);
        }
    }
}


typedef short s16x4 __attribute__((ext_vector_type(4)));
typedef short v4i16_t __attribute__((ext_vector_type(4)));
#define MFMA16(a, b, c) __builtin_amdgcn_mfma_f32_16x16x32_bf16((a), (b), (c), 0, 0, 0)
__device__ __forceinline__ bf16x8 ldK(const LAS unsigned char* img, int key, int chunk) { return *(const LAS bf16x8*)(img + key * 128 + ((chunk ^ ((key >> 1) & 7)) << 4)); }
__device__ __forceinline__ s16x4 ldVt(const LAS unsigned char* img, int key, int dt, int p) {
    const LAS unsigned char* a = img + key * 128 + (((2 * dt + (p >> 1)) ^ (((key >> 1) & 3) << 1)) << 4) + (p & 1) * 8;
    return __builtin_bit_cast(s16x4, __builtin_amdgcn_ds_read_tr16_b64_v4i16((LAS v4i16_t*)a)); }
template <bool ISV> __device__ __forceinline__ void dma_piece(const bf16_t* grow0, LAS unsigned char* img, int k0, int lane) {
    const int key = k0 + (lane >> 3), slot = lane & 7;
    const int ss = ISV ? (slot ^ (((key >> 1) & 3) << 1)) : (slot ^ ((key >> 1) & 7));
    __builtin_amdgcn_global_load_lds((const unsigned*)((const char*)grow0 + (lane >> 3) * 128 + ss * 16), (LAS unsigned*)(img + k0 * 128), 16, 0, 0);
}
__device__ __forceinline__ float xmax16_32(float v) { v = fmaxf(v, __shfl_xor(v, 16)); return fmaxf(v, __shfl_xor(v, 32)); }
__device__ __forceinline__ float xsum16_32(float v) { v += __shfl_xor(v, 16); return v + __shfl_xor(v, 32); }
__device__ __forceinline__ bf16x8 pack8(const f32x4& a, const f32x4& b) { u32x4 w; w.x = pk2(a[0], a[1]); w.y = pk2(a[2], a[3]); w.z = pk2(b[0], b[1]); w.w = pk2(b[2], b[3]); return __builtin_bit_cast(bf16x8, w); }

__device__ __forceinline__ void na_phase(Frame& F, const Args& a) {
    const bf16_t* QA = (const bf16_t*)(F.ws + WS_QA); const bf16_t* KA = (const bf16_t*)(F.ws + WS_KA); const bf16_t* VA = (const bf16_t*)(F.ws + WS_VA);
    bf16_t* OA = (bf16_t*)(F.ws + WS_OA); const f32x4* BT = (const f32x4*)(F.ws + WS_BT);
    LAS unsigned char* imgK = F.lds; LAS unsigned char* imgV = F.lds + 9 * 8192;
    const int lane = F.lane, g = lane >> 4, ql = lane & 15, q4 = (lane & 15) >> 2, p4 = lane & 3;
    const int per = (2048 + F.G - 1) / F.G;
    int res_lo = -1000, res_bh = -1;
    u32x4 pf[4]; int pf_lo = 0, pf_cnt = 0;
    f32x4 bt[8][2]; int bt_key = -1;
    bf16x8 qf0, qf1, qn0, qn1; bool have_q = false;
    for (int i = 0; i < per; ++i) {
        const int u = F.vcu * per + i; if (u >= 2048) break;
        const int p = u & 63, h = (u >> 6) & 7, b = u >> 9, bh = b * 8 + h;
        const int R0 = min(max(2 * p - 4, 0), 120);
        const size_t rowbase = (size_t)bh * SEQ;
        if (res_bh != bh || res_lo != R0) {
            __syncthreads();
            for (int j = F.wave; j < 144; j += 8) {
                const int kr = j >> 4, isv = (j >> 3) & 1, pc = j & 7; const int slot = (R0 + kr) % 9;
                const size_t tok0 = rowbase + (R0 + kr) * 64 + pc * 8;
                if (isv) dma_piece<true>(VA + tok0 * 64, imgV + slot * 8192, pc * 8, lane); else dma_piece<false>(KA + tok0 * 64, imgK + slot * 8192, pc * 8, lane);
            }
            asm volatile("s_waitcnt vmcnt(0)" ::: "memory");
            __syncthreads();
            have_q = false;
        }
        res_bh = bh; res_lo = R0;
        const int r = 2 * p + (F.wave >> 2), gq = F.wave & 3, base = (gq == 0) ? 0 : (gq == 1) ? 8 : (gq == 2) ? 24 : 32;
        const int rs = min(max(r - 4, 0), 120), rs9 = rs % 9, dr0 = rs - r + 7;
        const size_t qrow = rowbase + r * 64 + 16 * gq + ql;
        if (!have_q) { qf0 = *(const bf16x8*)(QA + qrow * 64 + 8 * g); qf1 = *(const bf16x8*)(QA + qrow * 64 + 32 + 8 * g); }
        if (bt_key != h * 64 + dr0) {
            bt_key = h * 64 + dr0;
#pragma unroll
            for (int kr = 0; kr < 8; ++kr)
#pragma unroll
                for (int hf = 0; hf < 2; ++hf) bt[kr][hf] = BT[((((h * 4 + gq) * 15 + dr0 + kr) * 2 + hf) * 64) + lane];
        }
        const bool has_next = (i + 1 < per && u + 1 < 2048 && ((u + 1) >> 6) == (u >> 6));
        pf_cnt = 0;
        if (has_next) {
            const size_t qrow2 = qrow + 128;
            qn0 = *(const bf16x8*)(QA + qrow2 * 64 + 8 * g); qn1 = *(const bf16x8*)(QA + qrow2 * 64 + 32 + 8 * g);
            const int nR0 = min(max(2 * (p + 1) - 4, 0), 120); pf_lo = max(nR0, R0 + 9); pf_cnt = nR0 + 9 - pf_lo;
#pragma unroll
            for (int jj = 0; jj < 4; ++jj) {
                const int j = F.wave + 8 * jj, rowsel = j >> 4, isv = (j >> 3) & 1, pc = j & 7;
                if (rowsel < pf_cnt) {
                    const int key = pc * 8 + (lane >> 3), s16 = lane & 7; const int ss = isv ? (s16 ^ (((key >> 1) & 3) << 1)) : (s16 ^ ((key >> 1) & 7));
                    const bf16_t* src = (isv ? VA : KA) + (rowbase + (size_t)(pf_lo + rowsel) * 64 + key) * 64 + ss * 8;
                    pf[jj] = *(const u32x4*)src;
                }
            }
        }
        f32x4 S[8][2];
#pragma unroll
        for (int kr = 0; kr < 8; ++kr) {
            const int sl = (rs9 + kr >= 9) ? rs9 + kr - 9 : rs9 + kr; const LAS unsigned char* ik = imgK + sl * 8192;
#pragma unroll
            for (int hf = 0; hf < 2; ++hf) {
                const int key = base + 16 * hf + ql;
                f32x4 s = MFMA16(ldK(ik, key, g), qf0, bt[kr][hf]); s = MFMA16(ldK(ik, key, 4 + g), qf1, s); S[kr][hf] = s;
            }
        }
        float m = -INFINITY;
#pragma unroll
        for (int kr = 0; kr < 8; ++kr)
#pragma unroll
            for (int hf = 0; hf < 2; ++hf) { m = fmaxf(fmaxf(m, S[kr][hf][0]), S[kr][hf][1]); m = fmaxf(fmaxf(m, S[kr][hf][2]), S[kr][hf][3]); }
        m = xmax16_32(m);
#pragma unroll
        for (int kr = 0; kr < 8; ++kr)
#pragma unroll
            for (int hf = 0; hf < 2; ++hf)
#pragma unroll
                for (int e = 0; e < 4; ++e) S[kr][hf][e] = __builtin_amdgcn_exp2f(S[kr][hf][e] - m);
        f32x4 o[4], osum = {0.f, 0.f, 0.f, 0.f};
        const bf16x8 ones8 = {0x3F80, 0x3F80, 0x3F80, 0x3F80, 0x3F80, 0x3F80, 0x3F80, 0x3F80};
#pragma unroll
        for (int dt = 0; dt < 4; ++dt) o[dt] = (f32x4){0.f, 0.f, 0.f, 0.f};
#pragma unroll
        for (int kr = 0; kr < 8; ++kr) {
            const int sl = (rs9 + kr >= 9) ? rs9 + kr - 9 : rs9 + kr;
            const bf16x8 pp = pack8(S[kr][0], S[kr][1]); const LAS unsigned char* iv = imgV + sl * 8192;
            const int ka = base + 4 * g + q4;
#pragma unroll
            for (int dt = 0; dt < 4; ++dt) {
                const s16x4 va = ldVt(iv, ka, dt, p4), vb = ldVt(iv, ka + 16, dt, p4);
                const bf16x8 vf = {va[0], va[1], va[2], va[3], vb[0], vb[1], vb[2], vb[3]};
                o[dt] = MFMA16(vf, pp, o[dt]);
            }
            osum = MFMA16(ones8, pp, osum);
        }
        const float inv = 1.0f / osum[0];
        bf16_t* op = OA + ((size_t)b * SEQ + r * 64 + 16 * gq + ql) * 512 + h * 64 + 4 * g;
#pragma unroll
        for (int dt = 0; dt < 4; ++dt) { u32x2 w; w.x = pk2(o[dt][0] * inv, o[dt][1] * inv); w.y = pk2(o[dt][2] * inv, o[dt][3] * inv); *(u32x2*)(op + 16 * dt) = w; }
        if (pf_cnt > 0) {
            __syncthreads();
#pragma unroll
            for (int jj = 0; jj < 4; ++jj) {
                const int j = F.wave + 8 * jj, rowsel = j >> 4, isv = (j >> 3) & 1, pc = j & 7;
                if (rowsel < pf_cnt) { const int slot = (pf_lo + rowsel) % 9; *(LAS u32x4*)((isv ? imgV : imgK) + slot * 8192 + pc * 1024 + lane * 16) = pf[jj]; }
            }
            res_lo = pf_lo + pf_cnt - 9;
            __syncthreads();
        }
        if (has_next) { qf0 = qn0; qf1 = qn1; have_q = true; } else have_q = false;
    }
    __syncthreads();
}

__device__ __forceinline__ void swa_phase(Frame& F, const Args& a) {
    const bf16_t* QB = (const bf16_t*)(F.ws + WS_QB); const bf16_t* KB = (const bf16_t*)(F.ws + WS_KB); const bf16_t* VB = (const bf16_t*)(F.ws + WS_VB);
    bf16_t* OB = (bf16_t*)(F.ws + WS_OB); const float* sinks = a.in[5];
    LAS unsigned char* imgK = F.lds; LAS unsigned char* imgV = F.lds + 65536;
    const int lane = F.lane, g = lane >> 4, ql = lane & 15, q4 = (lane & 15) >> 2, p4 = lane & 3;
    f32x4 mlo, mhi;
#pragma unroll
    for (int e = 0; e < 4; ++e) { mlo[e] = (4 * g + e >= ql) ? 0.f : -INFINITY; mhi[e] = (4 * g + e <= ql) ? 0.f : -INFINITY; }
    const int per = (512 + F.G - 1) / F.G;
    int res_bk = -1, res_hi = -1000;
#define SWA_LOAD_BLOCK(bk, blk) do { const int slot_ = ((blk) + 1) & 3; const bool ok_ = (blk) >= 0 && (blk) < SEQ / 128; \
        for (int j = F.wave; j < 32; j += 8) { const int isv = j >> 4, pc = j & 15; \
            if (ok_) { const size_t tok0 = (size_t)(bk) * SEQ + (blk) * 128 + pc * 8; \
                if (isv) dma_piece<true>(VB + tok0 * 64, imgV + slot_ * 16384, pc * 8, lane); else dma_piece<false>(KB + tok0 * 64, imgK + slot_ * 16384, pc * 8, lane); } \
            else if (isv) { *(LAS u32x4*)(imgV + slot_ * 16384 + pc * 1024 + lane * 16) = (u32x4){0u, 0u, 0u, 0u}; } } } while (0)
    for (int i = 0; i < per; ++i) {
        const int u = F.vcu * per + i; if (u >= 512) break;
        const int n = u & 63, kvh = (u >> 6) & 1, b = u >> 7, bk = b * 2 + kvh;
        if (res_bk != bk || res_hi != n + 1) {
            __syncthreads();
            const bool keep2 = (res_bk == bk && res_hi == n);
            if (!keep2) { SWA_LOAD_BLOCK(bk, n - 1); SWA_LOAD_BLOCK(bk, n); }
            SWA_LOAD_BLOCK(bk, n + 1);
        }
        asm volatile("s_waitcnt vmcnt(0)" ::: "memory");
        __syncthreads();
        res_bk = bk; res_hi = n + 1;
        if (i + 1 < per && u + 1 < 512 && ((u + 1) >> 6) == (u >> 6)) { SWA_LOAD_BLOCK(bk, n + 2); res_hi = n + 2; }
        const int hq = 4 * kvh + (F.wave >> 1), half = F.wave & 1;
        const float sink2 = sinks[hq] * LOG2E;
        const bf16_t* qbase = QB + ((size_t)(b * 8 + hq) * SEQ + 128 * n + 64 * half + ql) * 64 + 8 * g;
        bf16x8 qc0 = *(const bf16x8*)qbase, qc1 = *(const bf16x8*)(qbase + 32);
        const int kswz0 = (g ^ ((ql >> 1) & 7)) << 4, kswz1 = ((4 + g) ^ ((ql >> 1) & 7)) << 4;
        const int vk0 = 4 * g + q4; int vterm[4];
#pragma unroll
        for (int dt = 0; dt < 4; ++dt) vterm[dt] = (((2 * dt + (p4 >> 1)) ^ (((vk0 >> 1) & 3) << 1)) << 4) + (p4 & 1) * 8;
#pragma unroll 1
        for (int sub = 0; sub < 4; ++sub) {
            const int qrel0 = 64 * half + 16 * sub, qpos0 = 128 * n + qrel0;
            const bf16x8 qf0 = qc0, qf1 = qc1;
            if (sub < 3) { qc0 = *(const bf16x8*)(qbase + (sub + 1) * 1024); qc1 = *(const bf16x8*)(qbase + (sub + 1) * 1024 + 32); }
            const int kpos = 128 * n + qrel0 + ql, vpos = 128 * n + qrel0 + vk0;
            f32x4 S[17];
            bf16x8 kA[4][2], kB[4][2];
#define SW_KLD(buf, j, t) do { const LAS unsigned char* p_ = imgK + (((kpos + 16 * (t)) & 511) << 7); buf[j][0] = *(const LAS bf16x8*)(p_ + kswz0); buf[j][1] = *(const LAS bf16x8*)(p_ + kswz1); } while (0)
#define SW_KMM(buf, j, t) do { const f32x4 c_ = ((t) == 0) ? mlo : ((t) == 16) ? mhi : (f32x4){0.f, 0.f, 0.f, 0.f}; f32x4 s_ = MFMA16(buf[j][0], qf0, c_); s_ = MFMA16(buf[j][1], qf1, s_); \
                S[t] = s_; } while (0)
            SW_KLD(kA, 0, 0); SW_KLD(kA, 1, 1); SW_KLD(kA, 2, 2); SW_KLD(kA, 3, 3);
            SW_KLD(kB, 0, 4); SW_KLD(kB, 1, 5); SW_KLD(kB, 2, 6); SW_KLD(kB, 3, 7); __builtin_amdgcn_sched_barrier(0);
            SW_KMM(kA, 0, 0); SW_KMM(kA, 1, 1); SW_KMM(kA, 2, 2); SW_KMM(kA, 3, 3); __builtin_amdgcn_sched_barrier(0);
            SW_KLD(kA, 0, 8); SW_KLD(kA, 1, 9); SW_KLD(kA, 2, 10); SW_KLD(kA, 3, 11); __builtin_amdgcn_sched_barrier(0);
            SW_KMM(kB, 0, 4); SW_KMM(kB, 1, 5); SW_KMM(kB, 2, 6); SW_KMM(kB, 3, 7); __builtin_amdgcn_sched_barrier(0);
            SW_KLD(kB, 0, 12); SW_KLD(kB, 1, 13); SW_KLD(kB, 2, 14); SW_KLD(kB, 3, 15); __builtin_amdgcn_sched_barrier(0);
            SW_KMM(kA, 0, 8); SW_KMM(kA, 1, 9); SW_KMM(kA, 2, 10); SW_KMM(kA, 3, 11); __builtin_amdgcn_sched_barrier(0);
            SW_KLD(kA, 0, 16); __builtin_amdgcn_sched_barrier(0);
            SW_KMM(kB, 0, 12); SW_KMM(kB, 1, 13); SW_KMM(kB, 2, 14); SW_KMM(kB, 3, 15); __builtin_amdgcn_sched_barrier(0);
            SW_KMM(kA, 0, 16);
#undef SW_KLD
#undef SW_KMM
            if (n == 0 || n == SEQ / 128 - 1) {
#pragma unroll
                for (int t = 0; t < 17; ++t) { const int kp_ = qpos0 - 128 + 16 * t; if (kp_ < 0 || kp_ >= SEQ) S[t] = (f32x4){-INFINITY, -INFINITY, -INFINITY, -INFINITY}; }
            }
            float m = -INFINITY;
#pragma unroll
            for (int t = 0; t < 17; ++t) { m = fmaxf(fmaxf(m, S[t][0]), S[t][1]); m = fmaxf(fmaxf(m, S[t][2]), S[t][3]); }
            m = fmaxf(xmax16_32(m), sink2);
#pragma unroll
            for (int t = 0; t < 17; ++t)
#pragma unroll
                for (int e = 0; e < 4; ++e) S[t][e] = __builtin_amdgcn_exp2f(S[t][e] - m);
            f32x4 o[4], osum = {0.f, 0.f, 0.f, 0.f};
#pragma unroll
            for (int dt = 0; dt < 4; ++dt) o[dt] = (f32x4){0.f, 0.f, 0.f, 0.f};
            const f32x4 zero4 = {0.f, 0.f, 0.f, 0.f};
            const bf16x8 ones8 = {0x3F80, 0x3F80, 0x3F80, 0x3F80, 0x3F80, 0x3F80, 0x3F80, 0x3F80};
            s16x4 vA[4][2], vB[4][2];
#define SW_VLD(buf, ks) do { const int ta_ = 2 * (ks), tb_ = (2 * (ks) + 1 < 17) ? 2 * (ks) + 1 : 2 * (ks); \
                const LAS unsigned char* pa_ = imgV + (((vpos + 16 * ta_) & 511) << 7); const LAS unsigned char* pb_ = imgV + (((vpos + 16 * tb_) & 511) << 7); \
                _Pragma("unroll") for (int dt = 0; dt < 4; ++dt) { \
                    buf[dt][0] = __builtin_bit_cast(s16x4, __builtin_amdgcn_ds_read_tr16_b64_v4i16((LAS v4i16_t*)(pa_ + vterm[dt]))); \
                    buf[dt][1] = __builtin_bit_cast(s16x4, __builtin_amdgcn_ds_read_tr16_b64_v4i16((LAS v4i16_t*)(pb_ + vterm[dt]))); } } while (0)
#define SW_VMM(buf, ks) do { const bf16x8 pp_ = pack8(S[2 * (ks)], (2 * (ks) + 1 < 17) ? S[(2 * (ks) + 1 < 17) ? 2 * (ks) + 1 : 0] : zero4); \
                _Pragma("unroll") for (int dt = 0; dt < 4; ++dt) { const bf16x8 vf_ = {buf[dt][0][0], buf[dt][0][1], buf[dt][0][2], buf[dt][0][3], buf[dt][1][0], buf[dt][1][1], buf[dt][1][2], buf[dt][1][3]}; \
                    o[dt] = MFMA16(vf_, pp_, o[dt]); } osum = MFMA16(ones8, pp_, osum); } while (0)
            SW_VLD(vA, 0); SW_VLD(vB, 1); __builtin_amdgcn_sched_barrier(0);
            SW_VMM(vA, 0); __builtin_amdgcn_sched_barrier(0); SW_VLD(vA, 2); __builtin_amdgcn_sched_barrier(0);
            SW_VMM(vB, 1); __builtin_amdgcn_sched_barrier(0); SW_VLD(vB, 3); __builtin_amdgcn_sched_barrier(0);
            SW_VMM(vA, 2); __builtin_amdgcn_sched_barrier(0); SW_VLD(vA, 4); __builtin_amdgcn_sched_barrier(0);
            SW_VMM(vB, 3); __builtin_amdgcn_sched_barrier(0); SW_VLD(vB, 5); __builtin_amdgcn_sched_barrier(0);
            SW_VMM(vA, 4); __builtin_amdgcn_sched_barrier(0); SW_VLD(vA, 6); __builtin_amdgcn_sched_barrier(0);
            SW_VMM(vB, 5); __builtin_amdgcn_sched_barrier(0); SW_VLD(vB, 7); __builtin_amdgcn_sched_barrier(0);
            SW_VMM(vA, 6); __builtin_amdgcn_sched_barrier(0); SW_VLD(vA, 8); __builtin_amdgcn_sched_barrier(0);
            SW_VMM(vB, 7); __builtin_amdgcn_sched_barrier(0);
            SW_VMM(vA, 8);
#undef SW_VLD
#undef SW_VMM
            const float inv = 1.0f / (osum[0] + __builtin_amdgcn_exp2f(sink2 - m));
            bf16_t* op = OB + ((size_t)b * SEQ + qpos0 + ql) * 512 + hq * 64 + 4 * g;
#pragma unroll
            for (int dt = 0; dt < 4; ++dt) { u32x2 w; w.x = pk2(o[dt][0] * inv, o[dt][1] * inv); w.y = pk2(o[dt][2] * inv, o[dt][3] * inv); *(u32x2*)(op + 16 * dt) = w; }
        }
    }
#undef SWA_LOAD_BLOCK
    asm volatile("s_waitcnt vmcnt(0)" ::: "memory");
    __syncthreads();
}

__device__ __forceinline__ void router_phase(Frame& F, const Args& a) {
    const float* x = a.in[0]; bf16_t* AO = (bf16_t*)(F.ws + WS_AO); const float* g2 = a.in[9]; const float* wr_ = a.in[10]; const float* br = a.in[11];
    unsigned char* H2N = (unsigned char*)(F.ws + WS_H2N); float* gwl = (float*)(F.ws + WS_GWL); int* list = (int*)(F.ws + WS_LIST); int* inv = (int*)(F.ws + WS_INV);
    unsigned* counts = (unsigned*)(F.ws + WS_CTL) + CW_CNT;
    LAS float* wL = (LAS float*)F.lds;
    LAS float* lgs = (LAS float*)(F.lds + RING_BYTES) + F.wave * 512;
    LAS int* sel = (LAS int*)(F.lds + SEL_OFF); LAS float* selg = (LAS float*)(F.lds + SELG_OFF);
    {
        f32x4 wv[16]; float gk[16];
#pragma unroll
        for (int j = 0; j < 16; ++j) { const int i4 = F.tid + NTHREADS * j; wv[j] = *((const f32x4*)wr_ + i4); gk[j] = g2[i4 >> 3]; }
#pragma unroll
        for (int j = 0; j < 16; ++j) { const int i = 4 * (F.tid + NTHREADS * j), k = i >> 5, e = i & 31;
#pragma unroll
            for (int c = 0; c < 4; ++c) wL[k * 32 + 2 * ((e + c) & 15) + ((e + c) >> 4)] = wv[j][c] * gk[j]; }
    }
    __syncthreads();
    const int lane = F.lane, ti = lane & 15, q = lane >> 4;
    for (int ch = blockIdx.x; ch < T / 128; ch += F.G) {
        const int t0 = ch * 128 + F.wave * 16;
        const float* xrow = x + (size_t)(t0 + ti) * D + 4 * q; bf16_t* arow = AO + (size_t)(t0 + ti) * D + 4 * q;
        f32x4 acc0 = {0.f, 0.f, 0.f, 0.f}, acc1 = {0.f, 0.f, 0.f, 0.f}; float ss = 0.f;
#pragma unroll 4
        for (int s = 0; s < 64; ++s) {
            f32x4 v = *(const f32x4*)(xrow + 16 * s); const u32x2 w = *(const u32x2*)(arow + 16 * s);
            v.x += bflo(w.x); v.y += bfhi(w.x); v.z += bflo(w.y); v.w += bfhi(w.y);
            { u32x2 xb; xb.x = pk2(v.x, v.y); xb.y = pk2(v.z, v.w); *(u32x2*)(arow + 16 * s) = xb; }
            ss += (v.x * v.x + v.y * v.y) + (v.z * v.z + v.w * v.w);
            const LAS float* wp = wL + (16 * s + 4 * q) * 32 + 2 * ti;
#pragma unroll
            for (int u = 0; u < 4; ++u) {
                const f32x2 b = *(const LAS f32x2*)(wp + 32 * u);
                acc0 = __builtin_amdgcn_mfma_f32_16x16x4f32(v[u], b.x, acc0, 0, 0, 0);
                acc1 = __builtin_amdgcn_mfma_f32_16x16x4f32(v[u], b.y, acc1, 0, 0, 0);
            }
        }
        ss += __shfl_xor(ss, 16); ss += __shfl_xor(ss, 32);
        const float rstd = 1.0f / sqrtf(ss * (1.f / D) + RMS_EPS);
#pragma unroll
        for (int r = 0; r < 4; ++r) { lgs[(4 * q + r) * 32 + ti] = acc0[r]; lgs[(4 * q + r) * 32 + 16 + ti] = acc1[r]; }
        asm volatile("s_waitcnt lgkmcnt(0)" ::: "memory");
        if (lane < 16) {
            float lg[32];
#pragma unroll
            for (int e4 = 0; e4 < 8; ++e4) { const f32x4 v4 = *(const LAS f32x4*)(lgs + lane * 32 + 4 * e4); const f32x4 b4 = *(const f32x4*)(br + 4 * e4);
                lg[4 * e4] = v4.x * rstd + b4.x; lg[4 * e4 + 1] = v4.y * rstd + b4.y; lg[4 * e4 + 2] = v4.z * rstd + b4.z; lg[4 * e4 + 3] = v4.w * rstd + b4.w; }
            float tv[4]; int tix[4];
#pragma unroll
            for (int k = 0; k < 4; ++k) {
                float best = -INFINITY; int bi = 0;
#pragma unroll
                for (int e = 0; e < 32; ++e) if (lg[e] > best) { best = lg[e]; bi = e; }
#pragma unroll
                for (int e = 0; e < 32; ++e) lg[e] = (e == bi) ? -INFINITY : lg[e];
                tv[k] = best; tix[k] = bi;
            }
            const float e1 = __expf(tv[1] - tv[0]), e2 = __expf(tv[2] - tv[0]), e3 = __expf(tv[3] - tv[0]);
            const float inv = 1.0f / (1.0f + e1 + e2 + e3);
            const int rloc = F.wave * 16 + lane;
            sel[rloc * 4 + 0] = tix[0]; sel[rloc * 4 + 1] = tix[1]; sel[rloc * 4 + 2] = tix[2]; sel[rloc * 4 + 3] = tix[3];
            selg[rloc * 4 + 0] = inv; selg[rloc * 4 + 1] = e1 * inv; selg[rloc * 4 + 2] = e2 * inv; selg[rloc * 4 + 3] = e3 * inv;
        }
#pragma unroll 4
        for (int r = 0; r < 16; ++r) {
            const float rq = __shfl(rstd, r) * F8_ACT; const int t = t0 + r;
            const u32x4* ar = (const u32x4*)(AO + (size_t)t * D) + 2 * lane;
            const u32x4 wa = ar[0], wb = ar[1];
            u32x4 o; o.x = pk4_fp8(bflo(wa.x) * rq, bfhi(wa.x) * rq, bflo(wa.y) * rq, bfhi(wa.y) * rq); o.y = pk4_fp8(bflo(wa.z) * rq, bfhi(wa.z) * rq, bflo(wa.w) * rq, bfhi(wa.w) * rq);
            o.z = pk4_fp8(bflo(wb.x) * rq, bfhi(wb.x) * rq, bflo(wb.y) * rq, bfhi(wb.y) * rq); o.w = pk4_fp8(bflo(wb.z) * rq, bfhi(wb.z) * rq, bflo(wb.w) * rq, bfhi(wb.w) * rq);
            *((u32x4*)(H2N + (size_t)t * D) + lane) = o;
        }
        LAS int* lcnt = (LAS int*)(F.lds + TS_OFF) + 96; LAS int* lbase = lcnt + 32;
        if (F.tid < 32) lcnt[F.tid] = 0;
        __syncthreads();
        const int myj = F.tid, mye = sel[myj];
        const int mypos = __hip_atomic_fetch_add(lcnt + mye, 1, __ATOMIC_RELAXED, __HIP_MEMORY_SCOPE_WORKGROUP);
        __syncthreads();
        if (F.tid < 32) { const int c = lcnt[F.tid]; lbase[F.tid] = c > 0 ? (int)__hip_atomic_fetch_add(counts + F.tid, (unsigned)c, RLX_AGENT) : 0; }
        __syncthreads();
        { const int idx = lbase[mye] + mypos, slot = mye * LISTCAP + idx, tk = (ch * 128 + (myj >> 2)) * 4 + (myj & 3); list[slot] = tk; gwl[slot] = selg[myj]; inv[tk] = (mye << 16) | idx; }
        __syncthreads();
    }
}

__device__ __forceinline__ void moe_tables(Frame& F) {
    LAS int* ts = (LAS int*)(F.lds + TS_OFF); LAS int* cn = ts + 40;
    unsigned* counts = (unsigned*)(F.ws + WS_CTL) + CW_CNT;
    if (F.tid < 32) cn[F.tid] = (int)__hip_atomic_load(counts + F.tid, RLX_AGENT);
    __syncthreads();
    if (F.tid == 0) { int s = 0; for (int e = 0; e < 32; ++e) { ts[e] = s; s += (cn[e] + 255) >> 8; } ts[32] = s; ts[33] = 0x7fffffff; }
    __syncthreads();
    { LAS unsigned char* t2e = F.lds + T2E_OFF; const int total = ts[32];
      for (int m = F.tid; m < total; m += NTHREADS) { int e = 0; while (ts[e + 1] <= m) ++e; t2e[m] = (unsigned char)e; } }
    __syncthreads();
}

__device__ __forceinline__ void combine_phase(Frame& F, const Args& a) {
    moe_tables(F);
    const LAS int* ts = (const LAS int*)(F.lds + TS_OFF);
    float* out = a.out; const float* x = a.in[0]; const float* fg = a.in[16]; const unsigned char* Y = (const unsigned char*)(F.ws + WS_YTK); const bf16_t* AO = (const bf16_t*)(F.ws + WS_AO);
    const int* inv = (const int*)(F.ws + WS_INV);
    const int gw = F.vcu * NWAVES + F.wave, NGW = F.G * NWAVES;
    f32x4 gv[4];
#pragma unroll
    for (int j = 0; j < 4; ++j) gv[j] = *((const f32x4*)fg + F.lane + 64 * j);
    const int ntok = (T - gw + NGW - 1) / NGW;
    for (int i0 = 0; i0 < ntok; i0 += 16) {
        const int ti_ = i0 + (F.lane >> 2); int invv = 0;
        if (ti_ < ntok) invv = __hip_atomic_load(inv + 4 * (size_t)(gw + ti_ * NGW) + (F.lane & 3), RLX_AGENT);
        const int rowv = ts[(invv >> 16) & 31] * 256 + (invv & 0xffff);
        const int nloc = min(16, ntok - i0);
#define CB_LOAD(AV, YV, i_) do { const int t_ = gw + (i0 + (i_)) * NGW; int row_[4]; \
            _Pragma("unroll") for (int k = 0; k < 4; ++k) row_[k] = __builtin_amdgcn_readlane(rowv, 4 * (i_) + k); \
            _Pragma("unroll") for (int j = 0; j < 4; ++j) { AV[j] = *((const u32x2*)(AO + (size_t)t_ * D) + F.lane + 64 * j); \
                _Pragma("unroll") for (int k = 0; k < 4; ++k) YV[k][j] = *((const unsigned*)(Y + (size_t)row_[k] * D) + F.lane + 64 * j); } } while (0)
#define CB_PROC(AV, YV, i_) do { const int t_ = gw + (i0 + (i_)) * NGW; f32x4 v[4]; float ss = 0.f; \
            _Pragma("unroll") for (int j = 0; j < 4; ++j) { f32x4 ysum = {0.f, 0.f, 0.f, 0.f}; \
                _Pragma("unroll") for (int k = 0; k < 4; ++k) { const f32x2 lo2 = __builtin_amdgcn_cvt_pk_f32_fp8((int)YV[k][j], false), hi2 = __builtin_amdgcn_cvt_pk_f32_fp8((int)YV[k][j], true); \
                    ysum.x += lo2.x; ysum.y += lo2.y; ysum.z += hi2.x; ysum.w += hi2.y; } \
                v[j] = ysum * F8_YINV; v[j].x += bflo(AV[j].x); v[j].y += bfhi(AV[j].x); v[j].z += bflo(AV[j].y); v[j].w += bfhi(AV[j].y); \
                ss += (v[j].x * v[j].x + v[j].y * v[j].y) + (v[j].z * v[j].z + v[j].w * v[j].w); } \
            const float rstd = 1.0f / sqrtf(wave_sum(ss) * (1.f / D) + RMS_EPS); f32x4* orow = (f32x4*)(out + (size_t)t_ * D) + F.lane; \
            _Pragma("unroll") for (int j = 0; j < 4; ++j) orow[64 * j] = v[j] * rstd * gv[j]; } while (0)
        u32x2 avA[4], avB[4]; unsigned yvA[4][4], yvB[4][4];
        CB_LOAD(avA, yvA, 0);
#pragma unroll 1
        for (int i = 0; i < nloc; i += 2) {
            if (i + 1 < nloc) CB_LOAD(avB, yvB, i + 1);
            CB_PROC(avA, yvA, i);
            if (i + 2 < nloc) CB_LOAD(avA, yvA, i + 2);
            if (i + 1 < nloc) CB_PROC(avB, yvB, i + 1);
        }
#undef CB_LOAD
#undef CB_PROC
    }
}

constexpr int N_PHASES = 9;
#ifndef PROBE_PHASE
#define PROBE_PHASE -1
#endif
#ifndef PROBE_REPS
#define PROBE_REPS 2
#endif
template <int k> __device__ __forceinline__ void run_phase(Frame& F0, const Args& args) {
    Frame F = F0; { int t_ = threadIdx.x; asm volatile("" : "+v"(t_)); F.tid = t_; F.lane = t_ & 63; F.wave = __builtin_amdgcn_readfirstlane(t_ >> 6); }
    if constexpr (k == 0) { p0_prologue(F, args); }
    else if constexpr (k == 1) {
        { DenseSched S; S.so.init(T, C_GA, F.G, (int)blockIdx.x); S.A = (const char*)(F.ws + WS_H1); S.lda = D * 2; S.Bt = (const char*)(F.ws + WS_WIN); S.K = 2 * D;
          EpiInProj E{F.ws, args.in[3], (const float*)(F.ws + WS_ROPE)};
          pg8::gemm_phase<true, true, false>(F.lds, 2 * D, S, E); }
        { DenseSched S; S.so.init(T, 2048, F.G, (int)blockIdx.x); if (F.G == 256) S.so.tail_lo = 128; S.A = (const char*)(F.ws + WS_H1Q); S.lda = D; S.Bt = (const char*)(F.ws + WS_WING8); S.K = D;
          EpiGate E{(bf16_t*)(F.ws + WS_SG), args.in[3]};
          pg8::gemm_phase<true, true, true>(F.lds, D, S, E); }
    } else if constexpr (k == 2) {
#if ATTN_NAIVE
        attn_naive(F, args);
#else
        na_phase(F, args); swa_phase(F, args);
#if PROBE_ATTN == 1
        na_phase(F, args); na_phase(F, args);
#elif PROBE_ATTN == 2
        swa_phase(F, args); swa_phase(F, args);
#endif
#endif
    } else if constexpr (k == 3) {
        UpSched S; S.so.init(T, D, F.G, (int)blockIdx.x); S.OA = (const char*)(F.ws + WS_OA); S.OB = (const char*)(F.ws + WS_OB); S.Wa = (const char*)(F.ws + WS_WA); S.Wb = (const char*)(F.ws + WS_WB);
        EpiUp E{(const bf16_t*)(F.ws + WS_SG), (bf16_t*)(F.ws + WS_MERGED)};
        pg8::gemm_phase<true, true, false>(F.lds, 2 * 512, S, E);
    } else if constexpr (k == 4) {
        DenseSched S; S.so.init(T, D, F.G, (int)blockIdx.x); S.A = (const char*)(F.ws + WS_MERGED); S.lda = D * 2; S.Bt = (const char*)(F.ws + WS_WOUT); S.K = 2 * D;
        EpiAo E{(bf16_t*)(F.ws + WS_AO)};
        pg8::gemm_phase<true, true, false>(F.lds, 2 * D, S, E);
    } else if constexpr (k == 5) { router_phase(F, args); }
    else if constexpr (k == 6) {
        moe_tables(F);
        const LAS int* ts = (const LAS int*)(F.lds + TS_OFF);
        MoeSched<true> S; S.tstart = ts; S.cnt = ts + 40; S.t2e = (const LAS unsigned char*)(F.lds + T2E_OFF); S.G = F.G; S.vcu = F.vcu; S.log_mt = 2; S.total = ts[32];
        S.A = (const char*)(F.ws + WS_H2N); S.list = (const int*)(F.ws + WS_LIST); S.Bt = (const char*)(F.ws + WS_W1); S.b_estride = (size_t)2 * FF * D; S.K = D;
        EpiMoe1 E{args.in[13], (unsigned char*)(F.ws + WS_HACT)};
        pg8::gemm_phase<true, true, true>(F.lds, D, S, E);
    } else if constexpr (k == 7) {
        moe_tables(F);
        const LAS int* ts = (const LAS int*)(F.lds + TS_OFF);
        MoeSched<false> S; S.tstart = ts; S.cnt = ts + 40; S.t2e = (const LAS unsigned char*)(F.lds + T2E_OFF); S.G = F.G; S.vcu = F.vcu; S.log_mt = 3; S.total = ts[32];
        S.A = (const char*)(F.ws + WS_HACT); S.list = (const int*)(F.ws + WS_LIST); S.Bt = (const char*)(F.ws + WS_W2); S.b_estride = (size_t)D * FF; S.K = FF;
        EpiMoe2 E{ts + 40, (const float*)(F.ws + WS_GWL), args.in[15], (unsigned char*)(F.ws + WS_YTK)};
        pg8::gemm_phase<true, true, true>(F.lds, FF, S, E);
    } else if constexpr (k == 8) { combine_phase(F, args); }
}
__global__ void __launch_bounds__(NTHREADS, 2) fwd_kernel(Args args) {
    extern __shared__ __attribute__((aligned(16))) unsigned char lds_raw[];
    Frame F;
    F.lds = (LAS unsigned char*)lds_raw;
    F.tid = threadIdx.x; F.lane = F.tid & 63; F.wave = __builtin_amdgcn_readfirstlane(F.tid >> 6);
    F.G = gridDim.x; { const int bx = blockIdx.x; F.vcu = (F.G % 8 == 0) ? (bx % 8) * (F.G / 8) + bx / 8 : bx; }
    F.ws = args.ws;
    volatile LAS unsigned* MISC = (volatile LAS unsigned*)(F.lds + MISC_OFF);
    for (int u = F.tid; u < 256; u += NTHREADS) MISC[u] = 0u;
    __syncthreads();
    unsigned* ctl = (unsigned*)(F.ws + WS_CTL);
    XcdBarrier bar; bar.bar = ctl + CW_BAR + args.li * XCD_BAR_WORDS; bar.x = 0; bar.st = nullptr;
    const int lo = args.ph_lo, hi = args.ph_hi;
    if (hi - lo > 1) bar = xcd_barrier_post(ctl + CW_BAR + args.li * XCD_BAR_WORDS, MISC + 8);
#define PHASE(k) do { if (lo <= (k) && (k) < hi) { run_phase<k>(F, args); if ((k) + 1 < hi) xcd_barrier(bar); } } while (0)
    PHASE(0); PHASE(1); PHASE(2); PHASE(3); PHASE(4); PHASE(5); PHASE(6); PHASE(7); PHASE(8);
#undef PHASE
}

extern "C" void kernel_launch(void* const* d_in, const int* in_sizes, int n_in, void* d_out, int out_size, void* d_ws, size_t ws_size, hipStream_t stream) {
    static int grid = 0;
    if (grid == 0) {
        if (n_in != 17 || in_sizes[0] != T * D || out_size != T * D || ws_size < WS_END) { fprintf(stderr, "kernel_launch: unexpected shapes (n_in %d, in0 %d, out %d, ws %zu); nothing launched\n", n_in, n_in > 0 ? in_sizes[0] : -1, out_size, ws_size); grid = -1; return; }
        int dev = 0, cus = 0, per_cu = 0;
        if (hipGetDevice(&dev) != hipSuccess || hipDeviceGetAttribute(&cus, hipDeviceAttributeMultiprocessorCount, dev) != hipSuccess) { grid = -1; return; }
        if (hipFuncSetAttribute((const void*)fwd_kernel, hipFuncAttributeMaxDynamicSharedMemorySize, LDS_BYTES) != hipSuccess) { fprintf(stderr, "kernel_launch: hipFuncSetAttribute failed\n"); grid = -1; return; }
        if (hipOccupancyMaxActiveBlocksPerMultiprocessor(&per_cu, (const void*)fwd_kernel, NTHREADS, LDS_BYTES) != hipSuccess || per_cu < 1) { fprintf(stderr, "kernel_launch: occupancy query reports %d blocks per CU\n", per_cu); per_cu = 1; }
        (void)hipGetLastError();
        grid = cus;
    }
    if (grid < 0) return;
    (void)hipMemsetAsync((char*)d_ws + WS_CTL, 0, CTL_ZERO_BYTES, stream);
    Args a{};
    for (int i = 0; i < 17; ++i) a.in[i] = (const float*)d_in[i];
    a.out = (float*)d_out; a.ws = (unsigned char*)d_ws;
    void* kargs[] = {&a};
#if MK_SPLIT
    for (int p = 0; p < N_PHASES; ++p) {
        a.ph_lo = p; a.ph_hi = p + 1; a.li = 0;
        hipLaunchKernelGGL(fwd_kernel, dim3(grid), dim3(NTHREADS), LDS_BYTES, stream, a);
    }
#elif PROBE_PHASE >= 0
    {
        int li = 0;
        a.ph_lo = 0; a.ph_hi = PROBE_PHASE + 1; a.li = li++;
        (void)hipLaunchCooperativeKernel((const void*)fwd_kernel, dim3(grid), dim3(NTHREADS), kargs, LDS_BYTES, stream);
        for (int r = 0; r < PROBE_REPS; ++r) { a.ph_lo = PROBE_PHASE; a.ph_hi = PROBE_PHASE + 1; a.li = li++;
            if (PROBE_PHASE == 5) (void)hipMemsetAsync((char*)d_ws + WS_CTL + CW_CNT * 4, 0, 128, stream);
            (void)hipLaunchCooperativeKernel((const void*)fwd_kernel, dim3(grid), dim3(NTHREADS), kargs, LDS_BYTES, stream); }
        if (PROBE_PHASE + 1 < N_PHASES) { a.ph_lo = PROBE_PHASE + 1; a.ph_hi = N_PHASES; a.li = li++;
            (void)hipLaunchCooperativeKernel((const void*)fwd_kernel, dim3(grid), dim3(NTHREADS), kargs, LDS_BYTES, stream); }
    }
#else
    a.ph_lo = 0; a.ph_hi = N_PHASES; a.li = 0;
    hipError_t e = hipLaunchCooperativeKernel((const void*)fwd_kernel, dim3(grid), dim3(NTHREADS), kargs, LDS_BYTES, stream);
    if (e != hipSuccess) fprintf(stderr, "kernel_launch: cooperative launch failed: %s (grid %d)\n", hipGetErrorString(e), grid);
#endif
}
```

```cpp
#include <hip/hip_runtime.h>
#include <cstdio>
#include <cstdint>

#ifndef PROBE_ATTN
#define PROBE_ATTN 0
#endif
#ifndef ATTN_NAIVE
#define ATTN_NAIVE 0
#endif
#ifndef MK_SPLIT
#define MK_SPLIT 0
#endif

#define LAS __attribute__((address_space(3)))
#define GAS __attribute__((address_space(1)))
typedef unsigned short bf16_t;
typedef short bf16x8 __attribute__((ext_vector_type(8)));
typedef float f32x4 __attribute__((ext_vector_type(4)));
typedef float f32x2 __attribute__((ext_vector_type(2)));
typedef unsigned u32x4 __attribute__((ext_vector_type(4)));
typedef unsigned u32x2 __attribute__((ext_vector_type(2)));
typedef __bf16 bf16x2_t __attribute__((ext_vector_type(2)));

constexpr int NB = 4, SEQ = 8192, T = NB * SEQ, D = 1024, DIN = 4352;
constexpr int NEXP = 32, FF = 1024, LISTCAP = 32768;
constexpr float RMS_EPS = 1e-5f;
constexpr float LOG2E = 1.4426950408889634f;
constexpr float QSCALE = 0.125f * LOG2E;
constexpr int C_QA = 0, C_KA = 512, C_VA = 1024, C_QB = 1536, C_KB = 2048, C_VB = 2176, C_GA = 2304, C_GB = 3328;

constexpr size_t MiB = 1u << 20;
constexpr size_t WS_CTL = 0, CTL_ZERO_BYTES = 1 * MiB;
constexpr size_t WS_ROPE = 1 * MiB;
constexpr size_t WS_BT = 3 * MiB;
constexpr size_t WS_WIN = 4 * MiB;
constexpr size_t WS_WA = 13 * MiB, WS_WB = 14 * MiB, WS_WOUT = 15 * MiB;
constexpr size_t WS_W2 = 17 * MiB;
constexpr size_t WS_GWL = 744 * MiB;
constexpr size_t WS_LIST = 83 * MiB;
constexpr size_t WS_AO = 88 * MiB;
constexpr size_t WS_PROJ = 152 * MiB;
constexpr size_t WS_QA = WS_PROJ, WS_KA = WS_PROJ + 32 * MiB, WS_VA = WS_PROJ + 64 * MiB, WS_QB = WS_PROJ + 96 * MiB;
constexpr size_t WS_KB = WS_PROJ + 128 * MiB, WS_VB = WS_PROJ + 136 * MiB;
constexpr size_t WS_SG = WS_PROJ + 144 * MiB;
constexpr size_t WS_HACT = WS_PROJ;
constexpr size_t WS_W1 = 424 * MiB;
constexpr size_t WS_H1 = 552 * MiB;
constexpr size_t WS_H2N = WS_H1;
constexpr size_t WS_OA = 616 * MiB, WS_OB = 648 * MiB;
constexpr size_t WS_MERGED = 680 * MiB;
constexpr size_t WS_YTK = 424 * MiB;
constexpr size_t WS_H1Q = 680 * MiB;
constexpr size_t WS_WING8 = 50 * MiB;
constexpr size_t WS_INV = 748 * MiB;
constexpr size_t WS_END = 749 * MiB;
constexpr int CW_CNT = 64;
constexpr int CW_BAR = 4096;

constexpr int RING_BYTES = 131072;
constexpr int ATT_BYTES = 147456;
constexpr int MISC_OFF = ATT_BYTES;
constexpr int SEL_OFF = MISC_OFF + 1024;
constexpr int SELG_OFF = SEL_OFF + 2048;
constexpr int TS_OFF = SELG_OFF + 2048;
constexpr int T2E_OFF = TS_OFF + 1536;
constexpr int LDS_BYTES = 155648;
constexpr int NWAVES = 8, NTHREADS = 512;

#define RLX_AGENT __ATOMIC_RELAXED, __HIP_MEMORY_SCOPE_AGENT

__device__ __forceinline__ unsigned f2bf(float f) { unsigned u = __builtin_bit_cast(unsigned, f); return (u + 0x7fffu + ((u >> 16) & 1u)) >> 16; }
__device__ __forceinline__ unsigned pk2(float lo, float hi) { f32x2 v = {lo, hi}; bf16x2_t b = __builtin_convertvector(v, bf16x2_t); return __builtin_bit_cast(unsigned, b); }
constexpr float F8_ACT = 4.0f, F8_W = 128.0f, F8_INV = 1.0f / 512.0f, F8_Y = 32.0f, F8_YINV = 1.0f / 32.0f;
__device__ __forceinline__ unsigned pk4_fp8(float a, float b, float c, float d) { int w = 0; w = __builtin_amdgcn_cvt_pk_fp8_f32(a, b, w, false); w = __builtin_amdgcn_cvt_pk_fp8_f32(c, d, w, true); return (unsigned)w; }
__device__ __forceinline__ float bflo(unsigned w) { return __uint_as_float(w << 16); }
__device__ __forceinline__ float bfhi(unsigned w) { return __uint_as_float(w & 0xffff0000u); }
__device__ __forceinline__ float sigmoidf_(float x) { return __builtin_amdgcn_rcpf(1.0f + __builtin_amdgcn_exp2f(-x * LOG2E)); }
__device__ __forceinline__ const char* uniform_ptr(const char* p) {
    const unsigned long long v = (unsigned long long)p;
    const unsigned lo = __builtin_amdgcn_readfirstlane((unsigned)v), hi = __builtin_amdgcn_readfirstlane((unsigned)(v >> 32));
    return (const char*)(((unsigned long long)hi << 32) | lo);
}
__device__ __forceinline__ float wave_sum(float v) {
#pragma unroll
    for (int o = 1; o < 64; o <<= 1) v += __shfl_xor(v, o);
    return v;
}

namespace pg8 {
constexpr int BM = 256, BK = 64, HALF = 128, HTB = HALF * BK * 2, STAGE_BYTES = 8 * HTB, NXCD = 8, WGM = 8;
__host__ __device__ __forceinline__ int lds_byte(int r, int c) { const int st = (r >> 4) * 2 + (c >> 5), rr = r & 15, cc = c & 31, ob = rr * 64 + cc * 2; return st * 1024 + (ob ^ (((ob >> 9) & 1) << 5)); }
__host__ __device__ __forceinline__ void stage_rc(int b, int& R, int& C) { const int st = b / 1024, sb = b % 1024, swz = sb ^ (((sb >> 9) & 1) << 5); R = (st >> 1) * 16 + swz / 64; C = (st & 1) * 32 + (swz % 64) / 2; }
__host__ __device__ __forceinline__ int perm32(int rho) { const int n = rho >> 4, i = rho & 15; return 8 * (i >> 2) + 4 * n + (i & 3); }

struct Unit { int pm, pn, e, mt, part; };

struct StaticOrder {
    int nM, nN, nwg, G, c, tail_lo;
    __device__ void init(int M, int N, int G_, int c_) { nM = M / BM; nN = N / BM; nwg = nM * nN; G = G_; c = c_; tail_lo = -1; }
    __device__ bool next(int i, Unit& u) const {
        long L = (long)i * G + c;
        if (tail_lo >= 0 && i >= 3) { if (c < tail_lo || i >= 5) return false; L = 3L * G + 2 * (c - tail_lo) + (i - 3); }
        if (L >= nwg) return false;
        int wgid = (int)L; { const int q = nwg / NXCD, r = nwg % NXCD, xcd = wgid % NXCD, off = wgid / NXCD; wgid = (xcd < r ? xcd * (q + 1) : r * (q + 1) + (xcd - r) * q) + off; }
        const int nig = WGM * nN, gid = wgid / nig, fm = gid * WGM, gsz = (nM - fm) < WGM ? (nM - fm) : WGM;
        u.pm = fm + ((wgid % nig) % gsz); u.pn = (wgid % nig) / gsz; u.e = 0; u.mt = 0; u.part = 0; return true;
    }
};

typedef int v8i32_t __attribute__((ext_vector_type(8)));
typedef int v4i32_t __attribute__((ext_vector_type(4)));
__device__ __forceinline__ v8i32_t cat8(const bf16x8& a, const bf16x8& b) { const v4i32_t x = __builtin_bit_cast(v4i32_t, a), y = __builtin_bit_cast(v4i32_t, b); return __builtin_shufflevector(x, y, 0, 1, 2, 3, 4, 5, 6, 7); }
template <bool PERM, bool ALIGN_EPI, bool FP8, class Sched, class Epi>
__device__ __forceinline__ void gemm_phase(LAS unsigned char* lds, const int KB, const Sched& S, const Epi& E) {
    const int tid = threadIdx.x, wid = __builtin_amdgcn_readfirstlane(tid >> 6), lane = tid & 63, wr = wid >> 2, wc = wid & 3, fr = lane & 15, fq = lane >> 4;
    const int nt = KB / 128;
    int R[2], C2[2]; unsigned voffB[2];
#pragma unroll
    for (int i = 0; i < 2; ++i) { int r_, c_; stage_rc(tid * 16 + i * 8192, r_, c_); R[i] = r_; C2[i] = c_ * 2; const int Rb = PERM ? ((r_ & ~31) + perm32(r_ & 31)) : r_; voffB[i] = (unsigned)(Rb * KB + c_ * 2); }
    const size_t kstep = (size_t)(BK * 2);
    const size_t hstepB = (size_t)HALF * KB;
    const unsigned ldsw = (unsigned)wid * 1024u;
    const int aoff = lds_byte(wr * 64 + fr, fq * 8), boff = lds_byte(wc * 32 + fr, fq * 8);
#define PG8_SA(b, h) (((b) * 2 + (h)) * HTB)
#define PG8_SB(b, h) ((4 + (b) * 2 + (h)) * HTB)
#define PG8_STAGE_B(bufoff, gbase) do { _Pragma("unroll") for (int _i = 0; _i < 2; ++_i) \
        __builtin_amdgcn_global_load_lds((const unsigned*)((const char*)(gbase) + voffB[_i]), (LAS unsigned*)(lds + (bufoff) + ldsw + _i * 8192), 16, 0, 0); } while (0)
#define PG8_STAGE_A(bufoff, gbase, o0, o1) do { \
        __builtin_amdgcn_global_load_lds((const unsigned*)((const char*)(gbase) + (o0)), (LAS unsigned*)(lds + (bufoff) + ldsw), 16, 0, 0); \
        __builtin_amdgcn_global_load_lds((const unsigned*)((const char*)(gbase) + (o1)), (LAS unsigned*)(lds + (bufoff) + ldsw + 8192), 16, 0, 0); } while (0)
#define PG8_LDA(dst, b, h) do { _Pragma("unroll") for (int m = 0; m < 4; ++m) { const LAS unsigned char* p_ = lds + PG8_SA(b, h) + aoff + m * 2048; \
        dst[m] = __builtin_shufflevector(*(const LAS v4i32_t*)p_, *(const LAS v4i32_t*)(p_ + 1024), 0, 1, 2, 3, 4, 5, 6, 7); } } while (0)
#define PG8_LDB(dst, b, h) do { _Pragma("unroll") for (int n = 0; n < 2; ++n) { const LAS unsigned char* p_ = lds + PG8_SB(b, h) + boff + n * 2048; \
        dst[n] = __builtin_shufflevector(*(const LAS v4i32_t*)p_, *(const LAS v4i32_t*)(p_ + 1024), 0, 1, 2, 3, 4, 5, 6, 7); } } while (0)
#define PG8_LO(v) __builtin_bit_cast(bf16x8, __builtin_shufflevector(v, v, 0, 1, 2, 3))
#define PG8_HI(v) __builtin_bit_cast(bf16x8, __builtin_shufflevector(v, v, 4, 5, 6, 7))
#define PG8_MMA(ai, bj, At, Bt) do { __builtin_amdgcn_s_setprio(1); _Pragma("unroll") for (int m = 0; m < 4; ++m) _Pragma("unroll") for (int n = 0; n < 2; ++n) { \
        if constexpr (FP8) asm volatile("v_mfma_scale_f32_16x16x128_f8f6f4 %0, %1, %2, %0, %3, %3 op_sel_hi:[0,0,0]" : "+v"(acc[ai][bj][m][n]) : "v"(Bt[n]), "v"(At[m]), "v"(one_scale)); \
        else { acc[ai][bj][m][n] = __builtin_amdgcn_mfma_f32_16x16x32_bf16(PG8_LO(Bt[n]), PG8_LO(At[m]), acc[ai][bj][m][n], 0, 0, 0); \
               acc[ai][bj][m][n] = __builtin_amdgcn_mfma_f32_16x16x32_bf16(PG8_HI(Bt[n]), PG8_HI(At[m]), acc[ai][bj][m][n], 0, 0, 0); } } \
        __builtin_amdgcn_s_setprio(0); } while (0)
#define PG8_WAIT_V(n) asm volatile("s_waitcnt vmcnt(" #n ")" ::: "memory")
#define PG8_WAIT_L(n) asm volatile("s_waitcnt lgkmcnt(" #n ")" ::: "memory")
#define PG8_BAR __builtin_amdgcn_s_barrier()
#define PG8_SCHED __builtin_amdgcn_sched_barrier(0)
    Unit cur, nxt; int ui = 0;
    if (!S.next(0, cur)) return;
    f32x4 acc[2][2][4][2];
#pragma unroll
    for (int a = 0; a < 2; ++a)
#pragma unroll
        for (int b = 0; b < 2; ++b)
#pragma unroll
            for (int m = 0; m < 4; ++m)
#pragma unroll
                for (int n = 0; n < 2; ++n) acc[a][b][m][n] = (f32x4){0.f, 0.f, 0.f, 0.f};
    v8i32_t At[4], B0[2], B1[2];
    const int one_scale = 0x7f7f7f7f;
    const char* cA = S.a_base(cur); const char* cB = S.b_base(cur);
    LAS unsigned char* const eslot0 = lds + STAGE_BYTES;
    if (wid == 0) E.prefetch(cur, eslot0, lane);
    if constexpr (Sched::GATHER) { if (wid == 0) S.rows_prefetch(cur, eslot0 + 2048, lane); asm volatile("s_waitcnt vmcnt(0)" ::: "memory"); __syncthreads(); }
    unsigned oA00 = S.a_off(cur, R[0], eslot0 + 2048) + C2[0], oA01 = S.a_off(cur, R[1], eslot0 + 2048) + C2[1], oA10 = S.a_off(cur, HALF + R[0], eslot0 + 2048) + C2[0], oA11 = S.a_off(cur, HALF + R[1], eslot0 + 2048) + C2[1];
    PG8_STAGE_B(PG8_SB(0, 0), cB); PG8_STAGE_B(PG8_SB(0, 1), cB + hstepB); PG8_STAGE_A(PG8_SA(0, 0), cA, oA00, oA01); PG8_STAGE_A(PG8_SA(0, 1), cA, oA10, oA11);
    if (wr == 1) PG8_BAR;
    PG8_WAIT_V(2); PG8_BAR;
    PG8_STAGE_B(PG8_SB(1, 0), cB + kstep); PG8_STAGE_A(PG8_SA(1, 0), cA + kstep, oA00, oA01); PG8_STAGE_B(PG8_SB(1, 1), cB + hstepB + kstep);
    PG8_WAIT_V(6); PG8_BAR;
    for (;;) {
        const bool has_next = S.next(ui + 1, nxt);
        const char* nA = has_next ? S.a_base(nxt) : cA; const char* nB = has_next ? S.b_base(nxt) : cB;
        LAS unsigned char* const nrows = eslot0 + ((ui + 1) & 1) * 4096 + 2048;
        if constexpr (Sched::GATHER) { if (has_next && wid == 0) S.rows_prefetch(nxt, nrows, lane); }
        for (int t = 0; t < nt; t += 2) {
            const bool last = (t == nt - 2);
            const char* a1 = cA + (size_t)(t + 1) * kstep;
            const char* a2 = last ? nA : cA + (size_t)(t + 2) * kstep; const char* b2 = last ? nB : cB + (size_t)(t + 2) * kstep;
            const char* a3 = a2 + kstep; const char* b3 = b2 + kstep;
            unsigned p00 = oA00, p01 = oA01;
            if (last && has_next) { p00 = S.a_off(nxt, R[0], nrows) + C2[0]; p01 = S.a_off(nxt, R[1], nrows) + C2[1]; }
            PG8_LDB(B0, 0, 0); PG8_LDB(B1, 0, 1); PG8_SCHED; PG8_LDA(At, 0, 0); PG8_STAGE_A(PG8_SA(1, 1), a1, oA10, oA11);
            PG8_WAIT_V(8); PG8_WAIT_L(0); PG8_BAR; PG8_MMA(0, 0, At, B0); PG8_MMA(0, 1, At, B1); PG8_BAR; PG8_SCHED;
            unsigned p10 = oA10, p11 = oA11;
            if (last && has_next) { p10 = S.a_off(nxt, HALF + R[0], nrows) + C2[0]; p11 = S.a_off(nxt, HALF + R[1], nrows) + C2[1]; }
            PG8_LDA(At, 0, 1); PG8_STAGE_B(PG8_SB(0, 0), b2); PG8_STAGE_B(PG8_SB(0, 1), b2 + hstepB); PG8_STAGE_A(PG8_SA(0, 0), a2, p00, p01);
            PG8_WAIT_V(8); PG8_WAIT_L(0); PG8_BAR; PG8_MMA(1, 0, At, B0); PG8_MMA(1, 1, At, B1); PG8_BAR; PG8_SCHED;
            PG8_LDB(B0, 1, 0); PG8_LDB(B1, 1, 1); PG8_SCHED; PG8_LDA(At, 1, 0); PG8_STAGE_A(PG8_SA(0, 1), a2, p10, p11);
            PG8_WAIT_V(8); PG8_WAIT_L(0); PG8_BAR; PG8_MMA(0, 0, At, B0); PG8_MMA(0, 1, At, B1); PG8_BAR; PG8_SCHED;
            PG8_LDA(At, 1, 1); PG8_STAGE_B(PG8_SB(1, 0), b3); PG8_STAGE_B(PG8_SB(1, 1), b3 + hstepB); PG8_STAGE_A(PG8_SA(1, 0), a3, p00, p01);
            PG8_WAIT_V(8); PG8_WAIT_L(0); PG8_BAR; PG8_MMA(1, 0, At, B0); PG8_MMA(1, 1, At, B1); PG8_BAR; PG8_SCHED;
            if (last) { oA00 = p00; oA01 = p01; oA10 = p10; oA11 = p11; }
        }
        if constexpr (ALIGN_EPI) { if (wr == 0) PG8_BAR; }
        if constexpr (FP8) asm volatile("s_nop 15\n\ts_nop 7" ::: "memory");
        const bool zero = E(acc, cur, wr, wc, fr, fq, eslot0 + (ui & 1) * 4096);
        if (!has_next) break;
        if (zero) {
#pragma unroll
            for (int a = 0; a < 2; ++a)
#pragma unroll
                for (int b = 0; b < 2; ++b)
#pragma unroll
                    for (int m = 0; m < 4; ++m)
#pragma unroll
                        for (int n = 0; n < 2; ++n) acc[a][b][m][n] = (f32x4){0.f, 0.f, 0.f, 0.f};
        }
        cur = nxt; cA = nA; cB = nB; ++ui;
        if (wid == 0) E.prefetch(cur, eslot0 + (ui & 1) * 4096, lane);
        if constexpr (ALIGN_EPI) { if (wr == 1) PG8_BAR; }
    }
    PG8_WAIT_V(0);
    if constexpr (!ALIGN_EPI) { if (wr == 0) PG8_BAR; }
    PG8_BAR;
#undef PG8_SA
#undef PG8_SB
#undef PG8_STAGE_A
#undef PG8_STAGE_B
#undef PG8_LDA
#undef PG8_LDB
#undef PG8_MMA
#undef PG8_LO
#undef PG8_HI
#undef PG8_WAIT_V
#undef PG8_WAIT_L
#undef PG8_BAR
#undef PG8_SCHED
}
}
using pg8::Unit;

#define XB_TMO      128
#define XB_XCNT(j)  (256  + 64 * (j))
#define XB_XSUB(j)  (1280 + 64 * (j))
#define XB_XGEN(j)  (2304 + 64 * (j))
#define XB_TOP      3328
#define XB_TOPGEN   3392
#define XCD_BAR_WORDS 3456
#define XB_SPIN_CAP (1u << 18)
__device__ __forceinline__ unsigned xb_ld(unsigned* p)              { return __hip_atomic_load(p, __ATOMIC_RELAXED, __HIP_MEMORY_SCOPE_AGENT); }
__device__ __forceinline__ unsigned xb_add(unsigned* p, unsigned v) { return __hip_atomic_fetch_add(p, v, __ATOMIC_RELAXED, __HIP_MEMORY_SCOPE_AGENT); }
__device__ __forceinline__ unsigned xb_xcc_id() { return (unsigned)__builtin_amdgcn_s_getreg((3 << 11) | 20) & 0xFu; }
#define XB_SPIN(cond, bar) do { unsigned _sp = 0; while (cond) { __builtin_amdgcn_s_sleep(1); \
    if ((++_sp & 255u) == 0u) { if (xb_ld(&(bar)[XB_TMO])) break; if (_sp > XB_SPIN_CAP) { atomicAdd(&(bar)[XB_TMO], 1u); break; } } } } while (0)
struct XcdBarrier { unsigned* bar; unsigned x; volatile LAS unsigned* st; };
__device__ __forceinline__ XcdBarrier xcd_barrier_post(unsigned* bar, volatile LAS unsigned* st) {
    XcdBarrier b; b.bar = bar; b.x = xb_xcc_id(); b.st = st;
    if (threadIdx.x == 0) (void)xb_add(&bar[XB_XCNT(b.x)], 1u);
    return b;
}
__device__ __forceinline__ void xcd_barrier_complete(unsigned* bar, unsigned x, unsigned& nloc, unsigned& nx) {
    const unsigned G = gridDim.x * gridDim.y * gridDim.z;
    unsigned sum, cnt, mine, sp = 0u;
    for (;;) {
        sum = 0u; cnt = 0u; mine = 0u;
#pragma unroll
        for (unsigned j = 0; j < 16; ++j) { const unsigned c = xb_ld(&bar[XB_XCNT(j)]); sum += c; cnt += (c > 0u) ? 1u : 0u; mine = (j == x) ? c : mine; }
        if (sum == G) break;
        __builtin_amdgcn_s_sleep(1);
        if ((++sp & 255u) == 0u) { if (xb_ld(&bar[XB_TMO])) break; if (sp > XB_SPIN_CAP) { atomicAdd(&bar[XB_TMO], 1u); break; } }
    }
    nloc = mine > 0u ? mine : 1u; nx = cnt > 0u ? cnt : 1u;
}
__device__ __forceinline__ void xcd_barrier(const XcdBarrier& b) {
    asm volatile("s_waitcnt vmcnt(0)" ::: "memory");
    __syncthreads();
    if (threadIdx.x == 0) {
        unsigned* bar = b.bar;
        __builtin_amdgcn_s_waitcnt(0);
        unsigned nloc = b.st[0], nx = b.st[1];
        if (nloc == 0u) { xcd_barrier_complete(bar, b.x, nloc, nx); b.st[0] = nloc; b.st[1] = nx; }
        const unsigned old = xb_add(&bar[XB_XSUB(b.x)], 1u);
        const unsigned gen = old / nloc;
        if (old + 1u == (gen + 1u) * nloc) {
            __builtin_amdgcn_fence(__ATOMIC_RELEASE, "agent");
            asm volatile("s_waitcnt vmcnt(0)" ::: "memory");
            const unsigned og = xb_add(&bar[XB_TOP], 1u);
            const unsigned tg = og / nx;
            if (og + 1u == (tg + 1u) * nx) xb_add(&bar[XB_TOPGEN], 1u);
            else XB_SPIN(xb_ld(&bar[XB_TOPGEN]) == tg, bar);
            __builtin_amdgcn_fence(__ATOMIC_ACQUIRE, "agent");
            xb_add(&bar[XB_XGEN(b.x)], 1u);
            asm volatile("s_waitcnt vmcnt(0)" ::: "memory");
        } else {
            XB_SPIN(xb_ld(&bar[XB_XGEN(b.x)]) == gen, bar);
            __builtin_amdgcn_fence(__ATOMIC_ACQUIRE, "agent");
            asm volatile("s_waitcnt vmcnt(0)" ::: "memory");
        }
    }
    __syncthreads();
}

struct Args { const float* in[17]; float* out; unsigned char* ws; int ph_lo, ph_hi, li, pad; };
struct Frame {
    LAS unsigned char* lds;
    int tid, lane, wave, G, vcu;
    unsigned char* ws;
};

struct MapId { __device__ __forceinline__ int operator()(int n) const { return n; } };
struct MapWin { __device__ __forceinline__ int operator()(int n) const {
    const int tile = n >> 8, bj = (n >> 7) & 1;
    if (tile == 6 || tile == 7 || (tile == 8 && bj == 0)) {
        const int hb = n & ~127, p = n & 127, wc = p >> 5, fq = (p >> 3) & 3, nn = (p >> 2) & 1, e = p & 3;
        return hb + 64 * (wc >> 1) + 32 * nn + 16 * (wc & 1) + 4 * fq + e;
    }
    return n; } };
struct MapGate { __device__ __forceinline__ int operator()(int n) const { return C_GA + 1024 * ((n >> 7) & 1) + 128 * (n >> 8) + (n & 127); } };
struct MapY16 { __device__ __forceinline__ int operator()(int n) const { const int p = n & 255, bj = p >> 7, wc = (p >> 5) & 3, fq = (p >> 3) & 3, j = p & 7; return (n & ~255) + 64 * wc + 16 * fq + 8 * bj + j; } };
struct MapW1 { __device__ __forceinline__ int operator()(int n) const { const int pn = n >> 8, r = n & 255; return 1024 * (r >> 7) + 128 * pn + (r & 127); } };

template <class Map>
__device__ __forceinline__ void p0_transpose_item(const float* W, int K, int N, bf16_t* WT, LAS float* scr, int item, int lane, const Map& map, const float* kscale, int ncols = 0) {
    const int nblk = (ncols ? ncols : N) / 64, kb = item / nblk, nb = item % nblk, k0 = 64 * kb, n0 = 64 * nb;
    const int srcc = map(n0 + 4 * (lane & 15));
    f32x4 v[16];
#pragma unroll
    for (int i = 0; i < 16; ++i) v[i] = *(const f32x4*)(W + (size_t)(k0 + 4 * i + (lane >> 4)) * N + srcc);
    if (kscale) {
#pragma unroll
        for (int i = 0; i < 16; ++i) v[i] = v[i] * kscale[k0 + 4 * i + (lane >> 4)];
    }
#pragma unroll
    for (int i = 0; i < 16; ++i) *(LAS f32x4*)(scr + (4 * i + (lane >> 4)) * 68 + 4 * (lane & 15)) = v[i];
    asm volatile("s_waitcnt lgkmcnt(0)" ::: "memory");
    const int kc = lane & 7, ngl = lane >> 3;
#pragma unroll
    for (int pp = 0; pp < 2; ++pp) {
        const int ng = 8 * pp + ngl; f32x4 r[8];
#pragma unroll
        for (int j = 0; j < 8; ++j) r[j] = *(const LAS f32x4*)(scr + (8 * kc + j) * 68 + 4 * ng);
#pragma unroll
        for (int e = 0; e < 4; ++e) { u32x4 o; o.x = pk2(r[0][e], r[1][e]); o.y = pk2(r[2][e], r[3][e]); o.z = pk2(r[4][e], r[5][e]); o.w = pk2(r[6][e], r[7][e]);
            *(u32x4*)(WT + (size_t)(n0 + 4 * ng + e) * K + k0 + 8 * kc) = o; }
    }
    asm volatile("s_waitcnt lgkmcnt(0)" ::: "memory");
}

template <class Map>
__device__ __forceinline__ void p0_transpose_item_fp8(const float* W, int K, int N, unsigned char* WT, LAS float* scr, int item, int lane, const Map& map, const float* kscale, float scale, int pitch = 0) {
    if (pitch == 0) pitch = N;
    const int nblk = N / 32, kb = item / nblk, nb = item % nblk, k0 = 128 * kb, n0 = 32 * nb;
    const int srcc = map(n0 + 4 * (lane & 7));
    f32x4 v[16];
#pragma unroll
    for (int i = 0; i < 16; ++i) v[i] = *(const f32x4*)(W + (size_t)(k0 + 8 * i + (lane >> 3)) * pitch + srcc);
#pragma unroll
    for (int i = 0; i < 16; ++i) v[i] = v[i] * (kscale ? kscale[k0 + 8 * i + (lane >> 3)] * scale : scale);
#pragma unroll
    for (int i = 0; i < 16; ++i) *(LAS f32x4*)(scr + (8 * i + (lane >> 3)) * 36 + 4 * (lane & 7)) = v[i];
    asm volatile("s_waitcnt lgkmcnt(0)" ::: "memory");
    const int kc = lane & 15, ngl = lane >> 4;
#pragma unroll
    for (int pp = 0; pp < 2; ++pp) {
        const int ng = 4 * pp + ngl; f32x4 r[8];
#pragma unroll
        for (int j = 0; j < 8; ++j) r[j] = *(const LAS f32x4*)(scr + (8 * kc + j) * 36 + 4 * ng);
#pragma unroll
        for (int e = 0; e < 4; ++e) { u32x2 o; o.x = pk4_fp8(r[0][e], r[1][e], r[2][e], r[3][e]); o.y = pk4_fp8(r[4][e], r[5][e], r[6][e], r[7][e]);
            *(u32x2*)(WT + (size_t)(n0 + 4 * ng + e) * K + k0 + 8 * kc) = o; }
    }
    asm volatile("s_waitcnt lgkmcnt(0)" ::: "memory");
}

struct F8Item { const float* W; unsigned char* WT; int K, N, k0, n0, srcc; f32x4 ks0, ks1; };
template <class Map> __device__ __forceinline__ void f8_item_load(F8Item& I, const float* W, int K, int N, unsigned char* WT, int item, int lane, const Map& map, const float* kscale, f32x4 (&v)[16]) {
    const int nblk = N / 32, kb = item / nblk, nb = item % nblk;
    I.W = W; I.WT = WT; I.K = K; I.N = N; I.k0 = 128 * kb; I.n0 = 32 * nb; I.srcc = map(I.n0 + 4 * (lane & 7));
    if (kscale) { const float* kp = kscale + I.k0 + 8 * (lane & 15); I.ks0 = *(const f32x4*)kp; I.ks1 = *(const f32x4*)(kp + 4); }
    else { I.ks0 = (f32x4){1.f, 1.f, 1.f, 1.f}; I.ks1 = I.ks0; }
#pragma unroll
    for (int i = 0; i < 16; ++i) v[i] = *(const f32x4*)(W + (size_t)(I.k0 + 8 * i + (lane >> 3)) * N + I.srcc);
}
__device__ __forceinline__ void f8_item_finish(const F8Item& I, LAS float* scr, int lane, f32x4 (&v)[16], float scale) {
#pragma unroll
    for (int i = 0; i < 16; ++i) *(LAS f32x4*)(scr + (8 * i + (lane >> 3)) * 36 + 4 * (lane & 7)) = v[i];
    asm volatile("s_waitcnt lgkmcnt(0)" ::: "memory");
    const int kc = lane & 15, ngl = lane >> 4;
    const f32x4 s0 = I.ks0 * scale, s1 = I.ks1 * scale;
#pragma unroll
    for (int pp = 0; pp < 2; ++pp) {
        const int ng = 4 * pp + ngl; f32x4 r[8];
#pragma unroll
        for (int j = 0; j < 8; ++j) r[j] = *(const LAS f32x4*)(scr + (8 * kc + j) * 36 + 4 * ng) * (j < 4 ? s0[j] : s1[j - 4]);
#pragma unroll
        for (int e = 0; e < 4; ++e) { u32x2 o; o.x = pk4_fp8(r[0][e], r[1][e], r[2][e], r[3][e]); o.y = pk4_fp8(r[4][e], r[5][e], r[6][e], r[7][e]);
            *(u32x2*)(I.WT + (size_t)(I.n0 + 4 * ng + e) * I.K + I.k0 + 8 * kc) = o; }
    }
    asm volatile("s_waitcnt lgkmcnt(0)" ::: "memory");
}

__device__ __forceinline__ void p0_prologue(Frame& F, const Args& a) {
    LAS float* scr = (LAS float*)(F.lds + F.wave * 18432);
    const int gw = F.vcu * NWAVES + F.wave, NGW = F.G * NWAVES;
    const float* w_in = a.in[2]; const float* w_up_a = a.in[6]; const float* w_up_b = a.in[7]; const float* w_out = a.in[8];
    const float* w1 = a.in[12]; const float* w2 = a.in[14]; const float* g2 = a.in[9];
    bf16_t* Win_t = (bf16_t*)(F.ws + WS_WIN); bf16_t* Wa_t = (bf16_t*)(F.ws + WS_WA); bf16_t* Wb_t = (bf16_t*)(F.ws + WS_WB); bf16_t* Wout_t = (bf16_t*)(F.ws + WS_WOUT);
    unsigned char* W1_t = (unsigned char*)(F.ws + WS_W1); unsigned char* W2_t = (unsigned char*)(F.ws + WS_W2);
    constexpr int I_IN = (D / 64) * (C_GA / 64), I_G8 = (D / 128) * (2048 / 32), I_UP = (512 / 64) * (D / 64), I_OUT = (D / 64) * (D / 64), I_W1 = (D / 128) * (2 * FF / 32), I_W2 = (FF / 128) * (D / 32);
        constexpr int NSMALL = I_IN + I_G8 + 2 * I_UP + I_OUT, NEXPERT = NEXP * (I_W1 + I_W2);
    for (int it = gw; it < NSMALL; it += NGW) {
        int r = it;
        if (r < I_IN) { p0_transpose_item(w_in, D, DIN, Win_t, scr, r, F.lane, MapWin(), nullptr, C_GA); continue; } r -= I_IN;
        if (r < I_G8) { p0_transpose_item_fp8(w_in, D, 2048, (unsigned char*)(F.ws + WS_WING8), scr, r, F.lane, MapGate(), nullptr, F8_W, DIN); continue; } r -= I_G8;
        if (r < I_UP) { p0_transpose_item(w_up_a, 512, D, Wa_t, scr, r, F.lane, MapId(), nullptr); continue; } r -= I_UP;
        if (r < I_UP) { p0_transpose_item(w_up_b, 512, D, Wb_t, scr, r, F.lane, MapId(), nullptr); continue; } r -= I_UP;
        p0_transpose_item(w_out, D, D, Wout_t, scr, r, F.lane, MapId(), nullptr);
    }
#define F8_LOAD(I_, V_, r_) do { const int rr_ = (r_); const bool w1_ = rr_ < NEXP * I_W1; const int r2_ = w1_ ? rr_ : rr_ - NEXP * I_W1; \
        const int e_ = w1_ ? r2_ / I_W1 : r2_ / I_W2, q_ = w1_ ? r2_ % I_W1 : r2_ % I_W2, N_ = w1_ ? 2 * FF : D, nblk_ = N_ / 32, kb_ = q_ / nblk_, nb_ = q_ % nblk_; \
        I_.W = w1_ ? w1 + (size_t)e_ * D * 2 * FF : w2 + (size_t)e_ * FF * D; I_.WT = w1_ ? W1_t + (size_t)e_ * 2 * FF * D : W2_t + (size_t)e_ * D * FF; \
        I_.K = D; I_.N = N_; I_.k0 = 128 * kb_; I_.n0 = 32 * nb_; { const int n_ = I_.n0 + 4 * (F.lane & 7); I_.srcc = w1_ ? MapW1()(n_) : MapY16()(n_); } \
        { const float* kp_ = g2 + I_.k0 + 8 * (F.lane & 15); const f32x4 k0_ = *(const f32x4*)kp_, k1_ = *(const f32x4*)(kp_ + 4); const f32x4 one_ = {1.f, 1.f, 1.f, 1.f}; \
          I_.ks0 = w1_ ? k0_ : one_; I_.ks1 = w1_ ? k1_ : one_; } \
        _Pragma("unroll") for (int i_ = 0; i_ < 16; ++i_) V_[i_] = *(const f32x4*)(I_.W + (size_t)(I_.k0 + 8 * i_ + (F.lane >> 3)) * N_ + I_.srcc); } while (0)
    {
        static_assert(D == FF && (NEXP * ((D / 128) * (2 * FF / 32) + (FF / 128) * (D / 32))) % 16 == 0, "expert items: K = 1024 for both weight sets, item count a multiple of the waves per block");
        F8Item IA, IB; f32x4 va[16], vb[16];
        constexpr int NPAIR = NEXPERT / 2;
        int r = gw;
        if (r < NPAIR) {
            F8_LOAD(IA, va, 2 * r);
#pragma unroll 1
            for (;;) {
                __builtin_amdgcn_s_barrier(); F8_LOAD(IB, vb, 2 * r + 1);
                f8_item_finish(IA, scr, F.lane, va, F8_W);
                const bool hn = r + NGW < NPAIR; __builtin_amdgcn_s_barrier(); F8_LOAD(IA, va, hn ? 2 * (r + NGW) : 2 * r + 1);
                f8_item_finish(IB, scr, F.lane, vb, F8_W);
                if (!hn) break;
                r += NGW;
            }
        }
    }
#undef F8_LOAD
    const float* x = a.in[0]; const float* g1 = a.in[1]; bf16_t* H1 = (bf16_t*)(F.ws + WS_H1);
    f32x4 gv[4];
#pragma unroll
    for (int j = 0; j < 4; ++j) gv[j] = *((const f32x4*)g1 + F.lane + 64 * j);
    for (int m = 2 * gw; m < T; m += 2 * NGW) {
        const f32x4* xr = (const f32x4*)(x + (size_t)m * D) + F.lane;
        f32x4 v[2][4]; float s[2] = {0.f, 0.f};
#pragma unroll
        for (int q = 0; q < 2; ++q)
#pragma unroll
            for (int j = 0; j < 4; ++j) v[q][j] = xr[q * 256 + 64 * j];
#pragma unroll
        for (int q = 0; q < 2; ++q)
#pragma unroll
            for (int j = 0; j < 4; ++j) s[q] += (v[q][j].x * v[q][j].x + v[q][j].y * v[q][j].y) + (v[q][j].z * v[q][j].z + v[q][j].w * v[q][j].w);
#pragma unroll
        for (int q = 0; q < 2; ++q) {
            const float rstd = 1.0f / sqrtf(wave_sum(s[q]) * (1.f / D) + RMS_EPS);
            u32x2* o8 = (u32x2*)(H1 + (size_t)(m + q) * D) + F.lane; unsigned* o4 = (unsigned*)(F.ws + WS_H1Q + (size_t)(m + q) * D) + F.lane;
#pragma unroll
            for (int j = 0; j < 4; ++j) { const f32x4 hv = v[q][j] * rstd * gv[j]; u32x2 w; w.x = pk2(hv.x, hv.y); w.y = pk2(hv.z, hv.w); o8[64 * j] = w;
                o4[64 * j] = pk4_fp8(hv.x * F8_ACT, hv.y * F8_ACT, hv.z * F8_ACT, hv.w * F8_ACT); }
        }
    }
    float* rope = (float*)(F.ws + WS_ROPE);
    for (int idx = (F.vcu * NTHREADS + F.tid); idx < SEQ * 32; idx += F.G * NTHREADS) {
        const int pos = idx >> 5, i = idx & 31;
        const float invf = (float)exp2(-(double)i * (13.287712379549449 / 32.0));
        const float ang = (float)pos * invf;
        double rev = (double)ang * 0.15915494309189535; rev -= floor(rev);
        const float rv = (float)rev;
        rope[2 * idx] = __builtin_amdgcn_cosf(rv); rope[2 * idx + 1] = __builtin_amdgcn_sinf(rv);
    }
    float* bt = (float*)(F.ws + WS_BT); const float* rpb = a.in[4];
    for (int idx = (F.vcu * NTHREADS + F.tid); idx < 8 * 4 * 15 * 2 * 64 * 4; idx += F.G * NTHREADS) {
        const int reg = idx & 3, ln = (idx >> 2) & 63, hf = (idx >> 8) & 1; int rest = idx >> 9; const int dr = rest % 15; rest /= 15; const int gq = rest & 3, h = rest >> 2;
        const int c = 16 * gq + (ln & 15), base = (gq == 0) ? 0 : (gq == 1) ? 8 : (gq == 2) ? 24 : 32, kc = base + 16 * hf + 4 * (ln >> 4) + reg;
        const int cs = min(max(c - 8, 0), 48);
        bt[idx] = (kc >= cs && kc < cs + 16) ? rpb[h * 465 + dr * 31 + (kc - c + 15)] * LOG2E : -INFINITY;
    }
}

struct DenseSched {
    pg8::StaticOrder so; const char* A; unsigned lda; const char* Bt; int K;
    __device__ __forceinline__ bool next(int i, Unit& u) const { return so.next(i, u); }
    __device__ __forceinline__ const char* a_base(const Unit& u) const { return A + (size_t)u.pm * 256 * lda; }
    static constexpr bool GATHER = false;
    __device__ __forceinline__ unsigned a_off(const Unit&, int rho, const LAS unsigned char*) const { return (unsigned)rho * lda; }
    __device__ __forceinline__ const char* b_base(const Unit& u) const { return Bt + (size_t)u.pn * 256 * K; }
};
struct UpSched {
    pg8::StaticOrder so; const char* OA; const char* OB; const char* Wa; const char* Wb;
    __device__ __forceinline__ bool next(int i, Unit& u) const { const bool ok = so.next(i >> 1, u); u.part = i & 1; return ok; }
    __device__ __forceinline__ const char* a_base(const Unit& u) const { return (u.part ? OB : OA) + (size_t)u.pm * 256 * 1024; }
    static constexpr bool GATHER = false;
    __device__ __forceinline__ unsigned a_off(const Unit&, int rho, const LAS unsigned char*) const { return (unsigned)rho * 1024u; }
    __device__ __forceinline__ const char* b_base(const Unit& u) const { return (u.part ? Wb : Wa) + (size_t)u.pn * 256 * 512 * 2; }
};
template <bool GATHER_> struct MoeSched {
    static constexpr bool GATHER = GATHER_;
    const LAS int* tstart; const LAS int* cnt; const LAS unsigned char* t2e; int G, vcu, log_mt, total;
    const char* A; const int* list; const char* Bt; size_t b_estride; int K;
    __device__ __forceinline__ bool next(int i, Unit& u) const {
        const int L = i * G + vcu; const int blk = L >> 5, w = L & 31;
        const int mtg = (blk << log_mt) + (w & ((1 << log_mt) - 1)), pn = w >> log_mt;
        if (mtg >= total) return false;
        const int e = t2e[mtg];
        u.e = __builtin_amdgcn_readfirstlane(e); u.pm = __builtin_amdgcn_readfirstlane(mtg); u.mt = __builtin_amdgcn_readfirstlane(mtg - tstart[e]); u.pn = __builtin_amdgcn_readfirstlane(pn); u.part = 0; return true;
    }
    __device__ __forceinline__ const char* a_base(const Unit& u) const { return GATHER ? A : A + (size_t)u.pm * 256 * 1024; }
    __device__ __forceinline__ void rows_prefetch(const Unit& u, LAS unsigned char* dst, int lane) const {
        __builtin_amdgcn_global_load_lds((const unsigned*)(list + (size_t)u.e * LISTCAP + u.mt * 256 + 4 * lane), (LAS unsigned*)dst, 16, 0, 0); }
    __device__ __forceinline__ unsigned a_off(const Unit& u, int rho, const LAS unsigned char* rows) const {
        if (!GATHER) return (unsigned)rho * 1024u;
        const int tk = ((const LAS int*)rows)[rho];
        return (u.mt * 256 + rho < cnt[u.e]) ? (unsigned)(tk >> 2) * 1024u : 0u;
    }
    __device__ __forceinline__ const char* b_base(const Unit& u) const { return Bt + (size_t)u.e * b_estride + (size_t)u.pn * 256 * K; }
};

__device__ __forceinline__ size_t hm_off(int t, int nh, int h, int d) { return ((size_t)((t >> 13) * nh + h) * SEQ + (t & (SEQ - 1))) * 64 + d; }
struct EpiInProj {
    unsigned char* ws; const float* bias; const float* rope;
    __device__ __forceinline__ void prefetch(const Unit& u, LAS unsigned char* es, int lane) const {
        __builtin_amdgcn_global_load_lds((const unsigned*)(bias + 256 * u.pn + 4 * lane), (LAS unsigned*)es, 16, 0, 0); }
    __device__ __forceinline__ bool operator()(f32x4 (&acc)[2][2][4][2], const Unit& u, int wr, int wc, int fr, int fq, const LAS unsigned char* es) const {
        const int pn = u.pn; const int row0 = u.pm * 256 + wr * 64 + fr;
#pragma unroll
        for (int bj = 0; bj < 2; ++bj) {
            const bool rp = (pn == 6 || pn == 7 || (pn == 8 && bj == 0));
            const int hb = 256 * pn + 128 * bj;
            if (rp) {
                const int Lb = hb + 64 * (wc >> 1) + 16 * (wc & 1) + 4 * fq, i0 = 16 * (wc & 1) + 4 * fq;
                const LAS float* bl = (const LAS float*)es - 256 * pn;
                const f32x4 b1v = *(const LAS f32x4*)(bl + Lb), b2v = *(const LAS f32x4*)(bl + Lb + 32);
                const float sc = (pn <= 7) ? QSCALE : 1.0f;
                bf16_t* dst = (bf16_t*)(ws + (pn <= 7 ? WS_QB : WS_KB)); const int nh = (pn <= 7) ? 8 : 2; const int cl = Lb - (pn <= 7 ? C_QB : C_KB);
#pragma unroll
                for (int ai = 0; ai < 2; ++ai) {
                    f32x4 cs0a[4], cs1a[4];
#pragma unroll
                    for (int m = 0; m < 4; ++m) { const int pos = (row0 + ai * 128 + m * 16) & (SEQ - 1);
                        cs0a[m] = *(const f32x4*)(rope + (size_t)(pos * 32 + i0) * 2); cs1a[m] = *(const f32x4*)(rope + (size_t)(pos * 32 + i0) * 2 + 4); }
                    asm volatile("" ::: "memory");
#pragma unroll
                    for (int m = 0; m < 4; ++m) {
                        const int row = row0 + ai * 128 + m * 16;
                        const f32x4 cs0 = cs0a[m], cs1 = cs1a[m];
                        const f32x4 x1 = acc[ai][bj][m][0] + b1v, x2 = acc[ai][bj][m][1] + b2v;
                        const float c[4] = {cs0.x, cs0.z, cs1.x, cs1.z}, s[4] = {cs0.y, cs0.w, cs1.y, cs1.w};
                        float o1[4], o2[4];
#pragma unroll
                        for (int e = 0; e < 4; ++e) { o1[e] = (x1[e] * c[e] - x2[e] * s[e]) * sc; o2[e] = (x2[e] * c[e] + x1[e] * s[e]) * sc; }
                        bf16_t* rp_ = dst + hm_off(row, nh, cl >> 6, cl & 63);
                        u32x2 w1; w1.x = pk2(o1[0], o1[1]); w1.y = pk2(o1[2], o1[3]); *(u32x2*)rp_ = w1;
                        u32x2 w2; w2.x = pk2(o2[0], o2[1]); w2.y = pk2(o2[2], o2[3]); *(u32x2*)(rp_ + 32) = w2;
                    }
                }
            } else {
                const int c0 = hb + 32 * wc + 8 * fq;
                const LAS float* bl = (const LAS float*)es - 256 * pn;
                const f32x4 b0 = *(const LAS f32x4*)(bl + c0), b1 = *(const LAS f32x4*)(bl + c0 + 4);
                const int mode = (pn <= 1) ? 1 : (pn >= 9 ? 2 : 0);
                bf16_t* dst; int nh = 8, cl;
                if (pn <= 1) { dst = (bf16_t*)(ws + WS_QA); cl = c0 - C_QA; }
                else if (pn <= 3) { dst = (bf16_t*)(ws + WS_KA); cl = c0 - C_KA; }
                else if (pn <= 5) { dst = (bf16_t*)(ws + WS_VA); cl = c0 - C_VA; }
                else if (pn == 8) { dst = (bf16_t*)(ws + WS_VB); cl = c0 - C_VB; nh = 2; }
                else { dst = (bf16_t*)(ws + WS_SG); cl = c0 - C_GA; }
#pragma unroll
                for (int ai = 0; ai < 2; ++ai)
#pragma unroll
                    for (int m = 0; m < 4; ++m) {
                        const int row = row0 + ai * 128 + m * 16;
                        f32x4 v0 = acc[ai][bj][m][0] + b0, v1 = acc[ai][bj][m][1] + b1;
                        if (mode == 1) { v0 = v0 * QSCALE; v1 = v1 * QSCALE; }
                        if (mode == 2) {
#pragma unroll
                            for (int e = 0; e < 4; ++e) { v0[e] = sigmoidf_(v0[e]); v1[e] = sigmoidf_(v1[e]); } }
                        u32x4 w; w.x = pk2(v0[0], v0[1]); w.y = pk2(v0[2], v0[3]); w.z = pk2(v1[0], v1[1]); w.w = pk2(v1[2], v1[3]);
                        bf16_t* p_ = (pn >= 9) ? dst + (size_t)row * 2048 + cl : dst + hm_off(row, nh, cl >> 6, cl & 63);
                        *(u32x4*)p_ = w;
                    }
            }
        }
        return true;
    }
};
struct EpiGate {
    bf16_t* SG; const float* bias;
    __device__ __forceinline__ void prefetch(const Unit& u, LAS unsigned char* es, int lane) const {
        const float* s = bias + C_GA + 128 * u.pn + (lane < 32 ? 4 * lane : 1024 + 4 * (lane - 32));
        __builtin_amdgcn_global_load_lds((const unsigned*)s, (LAS unsigned*)es, 16, 0, 0); }
    __device__ __forceinline__ bool operator()(f32x4 (&acc)[2][2][4][2], const Unit& u, int wr, int wc, int fr, int fq, const LAS unsigned char* es) const {
        const int row0 = u.pm * 256 + wr * 64 + fr, ch = 32 * wc + 8 * fq;
        const LAS float* bl = (const LAS float*)es + ch;
        f32x4 za_b[2], zb_b[2];
        za_b[0] = *(const LAS f32x4*)bl * -LOG2E; za_b[1] = *(const LAS f32x4*)(bl + 4) * -LOG2E; zb_b[0] = *(const LAS f32x4*)(bl + 128) * -LOG2E; zb_b[1] = *(const LAS f32x4*)(bl + 132) * -LOG2E;
#pragma unroll
        for (int ai = 0; ai < 2; ++ai)
#pragma unroll
            for (int m = 0; m < 4; ++m) {
                const int row = row0 + ai * 128 + m * 16;
                float rt[8], sb[8];
#pragma unroll
                for (int n = 0; n < 2; ++n) {
                    const f32x4 za = acc[ai][0][m][n] * (-F8_INV * LOG2E) + za_b[n], zb = acc[ai][1][m][n] * (-F8_INV * LOG2E) + zb_b[n];
#pragma unroll
                    for (int e = 0; e < 4; ++e) {
                        const float da = 1.0f + __builtin_amdgcn_exp2f(fminf(za[e], 60.0f)), db = 1.0f + __builtin_amdgcn_exp2f(fminf(zb[e], 60.0f));
                        const float r = __builtin_amdgcn_rcpf(da * db), sga = db * r;
                        sb[4 * n + e] = da * r; rt[4 * n + e] = db * sga;
                    }
                }
                u32x4 w; w.x = pk2(rt[0], rt[1]); w.y = pk2(rt[2], rt[3]); w.z = pk2(rt[4], rt[5]); w.w = pk2(rt[6], rt[7]);
                *(u32x4*)(SG + (size_t)row * 2048 + 128 * u.pn + ch) = w;
                w.x = pk2(sb[0], sb[1]); w.y = pk2(sb[2], sb[3]); w.z = pk2(sb[4], sb[5]); w.w = pk2(sb[6], sb[7]);
                *(u32x4*)(SG + (size_t)row * 2048 + 1024 + 128 * u.pn + ch) = w;
            }
        return true;
    }
};
struct EpiUp {
    const bf16_t* P; bf16_t* Mg;
    __device__ __forceinline__ void prefetch(const Unit&, LAS unsigned char*, int) const {}
    template <int PART>
    __device__ __forceinline__ void run(f32x4 (&acc)[2][2][4][2], const Unit& u, int wr, int wc, int fr, int fq) const {
        const int row0 = u.pm * 256 + wr * 64 + fr, cb = u.pn * 256 + 32 * wc + 8 * fq;
        const bf16_t* Pp = P + (PART ? 1024 : 0) + (size_t)row0 * 2048 + cb;
        u32x4 g[2][4][2];
#pragma unroll
        for (int ai = 0; ai < 2; ++ai)
#pragma unroll
            for (int m = 0; m < 4; ++m)
#pragma unroll
                for (int bj = 0; bj < 2; ++bj) g[ai][m][bj] = *(const u32x4*)(Pp + (size_t)(ai * 128 + m * 16) * 2048 + 128 * bj);
        __builtin_amdgcn_sched_barrier(0);
#pragma unroll
        for (int ai = 0; ai < 2; ++ai)
#pragma unroll
            for (int m = 0; m < 4; ++m)
#pragma unroll
                for (int bj = 0; bj < 2; ++bj) {
                    const u32x4 gb = g[ai][m][bj];
                    const float sb[8] = {bflo(gb.x), bfhi(gb.x), bflo(gb.y), bfhi(gb.y), bflo(gb.z), bfhi(gb.z), bflo(gb.w), bfhi(gb.w)};
                    if constexpr (PART == 0) {
#pragma unroll
                        for (int e = 0; e < 4; ++e) { acc[ai][bj][m][0][e] *= sb[e]; acc[ai][bj][m][1][e] *= sb[4 + e]; }
                    } else {
                        const f32x4 v0 = acc[ai][bj][m][0], v1 = acc[ai][bj][m][1];
                        u32x4 w; w.x = pk2(v0[0] * sb[0], v0[1] * sb[1]); w.y = pk2(v0[2] * sb[2], v0[3] * sb[3]); w.z = pk2(v1[0] * sb[4], v1[1] * sb[5]); w.w = pk2(v1[2] * sb[6], v1[3] * sb[7]);
                        *(u32x4*)(Mg + (size_t)(row0 + ai * 128 + m * 16) * D + cb + 128 * bj) = w;
                    }
                }
    }
    __device__ __forceinline__ bool operator()(f32x4 (&acc)[2][2][4][2], const Unit& u, int wr, int wc, int fr, int fq, const LAS unsigned char* es) const {
        if (u.part == 0) run<0>(acc, u, wr, wc, fr, fq); else run<1>(acc, u, wr, wc, fr, fq);
        return u.part != 0;
    }
};
struct EpiAo {
    bf16_t* AO;
    __device__ __forceinline__ void prefetch(const Unit&, LAS unsigned char*, int) const {}
    __device__ __forceinline__ bool operator()(f32x4 (&acc)[2][2][4][2], const Unit& u, int wr, int wc, int fr, int fq, const LAS unsigned char* es) const {
        const int row0 = u.pm * 256 + wr * 64 + fr, col0 = u.pn * 256 + wc * 32 + 8 * fq;
#pragma unroll
        for (int ai = 0; ai < 2; ++ai)
#pragma unroll
            for (int m = 0; m < 4; ++m) {
                bf16_t* rowp = AO + (size_t)(row0 + ai * 128 + m * 16) * D + col0;
#pragma unroll
                for (int bj = 0; bj < 2; ++bj) { const f32x4 v0 = acc[ai][bj][m][0], v1 = acc[ai][bj][m][1];
                    u32x4 w; w.x = pk2(v0[0], v0[1]); w.y = pk2(v0[2], v0[3]); w.z = pk2(v1[0], v1[1]); w.w = pk2(v1[2], v1[3]); *(u32x4*)(rowp + bj * 128) = w; }
            }
        return true;
    }
};
struct EpiMoe1 {
    const float* b1; unsigned char* H;
    __device__ __forceinline__ void prefetch(const Unit& u, LAS unsigned char* es, int lane) const {
        const float* s = b1 + (size_t)u.e * 2 * FF + 128 * u.pn + (lane < 32 ? 4 * lane : FF + 4 * (lane - 32));
        __builtin_amdgcn_global_load_lds((const unsigned*)s, (LAS unsigned*)es, 16, 0, 0); }
    __device__ __forceinline__ bool operator()(f32x4 (&acc)[2][2][4][2], const Unit& u, int wr, int wc, int fr, int fq, const LAS unsigned char* es) const {
        const int p0 = 32 * wc + 8 * fq;
        const LAS float* bg = (const LAS float*)es + p0;
        constexpr float KS = -1.702f * LOG2E, QC = F8_ACT / KS;
        f32x4 bz[2], bq[2];
        bz[0] = *(const LAS f32x4*)bg * KS; bz[1] = *(const LAS f32x4*)(bg + 4) * KS; bq[0] = *(const LAS f32x4*)(bg + 128) * QC + QC; bq[1] = *(const LAS f32x4*)(bg + 132) * QC + QC;
#pragma unroll
        for (int ai = 0; ai < 2; ++ai)
#pragma unroll
            for (int m = 0; m < 4; ++m) {
                const int rho = 128 * ai + 64 * wr + 16 * m + fr;
                float a8[8];
#pragma unroll
                for (int n = 0; n < 2; ++n) {
                    const f32x4 z4 = acc[ai][0][m][n] * (F8_INV * KS) + bz[n], q4 = acc[ai][1][m][n] * (F8_INV * QC) + bq[n];
#pragma unroll
                    for (int p = 0; p < 2; ++p) {
                        f32x2 z = {__builtin_amdgcn_fmed3f(z4[2 * p], 7.0f * KS, 40.0f), __builtin_amdgcn_fmed3f(z4[2 * p + 1], 7.0f * KS, 40.0f)};
                        f32x2 q = {__builtin_amdgcn_fmed3f(q4[2 * p], 8.0f * QC, -6.0f * QC), __builtin_amdgcn_fmed3f(q4[2 * p + 1], 8.0f * QC, -6.0f * QC)};
                        f32x2 d = {__builtin_amdgcn_exp2f(z.x), __builtin_amdgcn_exp2f(z.y)};
                        d = d + 1.0f;
                        const f32x2 nn = q * z; const float r = __builtin_amdgcn_rcpf(d.x * d.y);
                        const f32x2 o = nn * __builtin_shufflevector(d, d, 1, 0) * r;
                        a8[4 * n + 2 * p] = o.x; a8[4 * n + 2 * p + 1] = o.y;
                    }
                }
                u32x2 w; w.x = pk4_fp8(a8[0], a8[1], a8[2], a8[3]); w.y = pk4_fp8(a8[4], a8[5], a8[6], a8[7]);
                *(u32x2*)(H + (size_t)(u.pm * 256 + rho) * FF + 128 * u.pn + p0) = w;
            }
        return true;
    }
};
struct EpiMoe2 {
    const LAS int* cnt; const float* gwl; const float* b2; unsigned char* Y;
    __device__ __forceinline__ void prefetch(const Unit& u, LAS unsigned char* es, int lane) const {
        __builtin_amdgcn_global_load_lds((const unsigned*)(b2 + (size_t)u.e * D + 256 * u.pn + 4 * lane), (LAS unsigned*)es, 16, 0, 0);
        __builtin_amdgcn_global_load_lds((const unsigned*)(gwl + (size_t)u.e * LISTCAP + u.mt * 256 + 4 * lane), (LAS unsigned*)(es + 1024), 16, 0, 0); }
    __device__ __forceinline__ bool operator()(f32x4 (&acc)[2][2][4][2], const Unit& u, int wr, int wc, int fr, int fq, const LAS unsigned char* es) const {
        const int n_e = cnt[u.e]; const int cl = 64 * wc + 16 * fq;
        f32x4 bv[2][2];
#pragma unroll
        for (int bj = 0; bj < 2; ++bj)
#pragma unroll
            for (int n = 0; n < 2; ++n) bv[bj][n] = *(const LAS f32x4*)((const LAS float*)es + cl + 8 * bj + 4 * n);
        float gw[2][4];
#pragma unroll
        for (int ai = 0; ai < 2; ++ai)
#pragma unroll
            for (int m = 0; m < 4; ++m) gw[ai][m] = ((const LAS float*)(es + 1024))[128 * ai + 64 * wr + 16 * m + fr] * F8_Y;
#pragma unroll
        for (int ai = 0; ai < 2; ++ai)
#pragma unroll
            for (int m = 0; m < 4; ++m) {
                const int rho = 128 * ai + 64 * wr + 16 * m + fr;
                if (u.mt * 256 + rho < n_e) {
                    const float g_ = gw[ai][m];
                    u32x4 w;
#pragma unroll
                    for (int bj = 0; bj < 2; ++bj) {
                        const f32x4 v0 = (acc[ai][bj][m][0] * F8_INV + bv[bj][0]) * g_, v1 = (acc[ai][bj][m][1] * F8_INV + bv[bj][1]) * g_;
                        w[2 * bj] = pk4_fp8(v0[0], v0[1], v0[2], v0[3]); w[2 * bj + 1] = pk4_fp8(v1[0], v1[1], v1[2], v1[3]);
                    }
                    *(u32x4*)(Y + (size_t)(u.pm * 256 + rho) * D + u.pn * 256 + cl) = w;
                }
            }
        return true;
    }
};

__device__ __forceinline__ void ld64(const bf16_t* p, float (&f)[64]) {
#pragma unroll
    for (int i = 0; i < 8; ++i) { const u32x4 w = *((const u32x4*)p + i); f[8 * i] = bflo(w.x); f[8 * i + 1] = bfhi(w.x); f[8 * i + 2] = bflo(w.y); f[8 * i + 3] = bfhi(w.y); f[8 * i + 4] = bflo(w.z); f[8 * i + 5] = bfhi(w.z); f[8 * i + 6] = bflo(w.w); f[8 * i + 7] = bfhi(w.w); }
}
__device__ __forceinline__ float dot64(const bf16_t* p, const float (&q)[64]) {
    float s = 0.f;
#pragma unroll
    for (int i = 0; i < 8; ++i) { const u32x4 w = *((const u32x4*)p + i);
        s += q[8 * i] * bflo(w.x) + q[8 * i + 1] * bfhi(w.x) + q[8 * i + 2] * bflo(w.y) + q[8 * i + 3] * bfhi(w.y) + q[8 * i + 4] * bflo(w.z) + q[8 * i + 5] * bfhi(w.z) + q[8 * i + 6] * bflo(w.w) + q[8 * i + 7] * bfhi(w.w); }
    return s;
}
__device__ __forceinline__ void axpy64(const bf16_t* p, float a, float pw, float (&o)[64]) {
#pragma unroll
    for (int i = 0; i < 8; ++i) { const u32x4 w = *((const u32x4*)p + i);
        o[8 * i] = o[8 * i] * a + pw * bflo(w.x); o[8 * i + 1] = o[8 * i + 1] * a + pw * bfhi(w.x); o[8 * i + 2] = o[8 * i + 2] * a + pw * bflo(w.y); o[8 * i + 3] = o[8 * i + 3] * a + pw * bfhi(w.y);
        o[8 * i + 4] = o[8 * i + 4] * a + pw * bflo(w.z); o[8 * i + 5] = o[8 * i + 5] * a + pw * bfhi(w.z); o[8 * i + 6] = o[8 * i + 6] * a + pw * bflo(w.w); o[8 * i + 7] = o[8 * i + 7] * a + pw * bfhi(w.w); }
}
__device__ __forceinline__ void st64(bf16_t* p, const float (&o)[64], float inv) {
#pragma unroll
    for (int i = 0; i < 8; ++i) { u32x4 w; w.x = pk2(o[8 * i] * inv, o[8 * i + 1] * inv); w.y = pk2(o[8 * i + 2] * inv, o[8 * i + 3] * inv); w.z = pk2(o[8 * i + 4] * inv, o[8 * i + 5] * inv); w.w = pk2(o[8 * i + 6] * inv, o[8 * i + 7] * inv); *((u32x4*)p + i) = w; }
}
__device__ __forceinline__ void attn_naive(Frame& F, const Args& a) {
    const bf16_t* QA = (const bf16_t*)(F.ws + WS_QA); const bf16_t* KA = (const bf16_t*)(F.ws + WS_KA); const bf16_t* VA = (const bf16_t*)(F.ws + WS_VA);
    const bf16_t* QB = (const bf16_t*)(F.ws + WS_QB); const bf16_t* KB = (const bf16_t*)(F.ws + WS_KB); const bf16_t* VB = (const bf16_t*)(F.ws + WS_VB);
    bf16_t* OA = (bf16_t*)(F.ws + WS_OA); bf16_t* OB = (bf16_t*)(F.ws + WS_OB);
    const float* rpb = a.in[4]; const float* sinks = a.in[5];
    const int gt = F.vcu * NTHREADS + F.tid, NGT = F.G * NTHREADS;
    for (int it = gt; it < T * 16; it += NGT) {
        const int t = it >> 4, hh = it & 15; const int b = t >> 13, s = t & (SEQ - 1);
        float q[64], o[64];
#pragma unroll
        for (int d = 0; d < 64; ++d) o[d] = 0.f;
        if (hh < 8) {
            const int h = hh, r = s >> 6, c = s & 63; const int rs = min(max(r - 4, 0), 120), cs = min(max(c - 8, 0), 48);
            ld64(QA + hm_off(t, 8, h, 0), q);
            float m = -INFINITY, l = 0.f;
            for (int kr = 0; kr < 8; ++kr)
                for (int kc = 0; kc < 16; ++kc) {
                    const int kt = (b << 13) + ((rs + kr) << 6) + cs + kc;
                    float sc = dot64(KA + hm_off(kt, 8, h, 0), q) + rpb[h * 15 * 31 + (rs + kr - r + 7) * 31 + (cs + kc - c + 15)] * LOG2E;
                    const float mn = fmaxf(m, sc), al = __builtin_amdgcn_exp2f(m - mn), pw = __builtin_amdgcn_exp2f(sc - mn);
                    l = l * al + pw; axpy64(VA + hm_off(kt, 8, h, 0), al, pw, o); m = mn;
                }
            st64(OA + (size_t)t * 512 + h * 64, o, 1.0f / l);
        } else {
            const int hq = hh - 8, kvh = hq >> 2;
            ld64(QB + hm_off(t, 8, hq, 0), q);
            float m = sinks[hq] * LOG2E, l = 1.f;
            const int j0 = max(s - 128, 0), j1 = min(s + 128, SEQ - 1);
            for (int j = j0; j <= j1; ++j) {
                const int kt = (b << 13) + j;
                const float sc = dot64(KB + hm_off(kt, 2, kvh, 0), q);
                const float mn = fmaxf(m, sc), al = __builtin_amdgcn_exp2f(m - mn), pw = __builtin_amdgcn_exp2f(sc - mn);
                l = l * al + pw; axpy64(VB + hm_off(kt, 2, kvh, 0), al, pw, o); m = mn;
            }
            st64(OB + (size_t)t * 512 + hq * 64, o, 1.0f / l);
        }
    }
}


typedef short s16x4 __attribute__((ext_vector_type(4)));
typedef short v4i16_t __attribute__((ext_vector_type(4)));
#define MFMA16(a, b, c) __builtin_amdgcn_mfma_f32_16x16x32_bf16((a), (b), (c), 0, 0, 0)
__device__ __forceinline__ bf16x8 ldK(const LAS unsigned char* img, int key, int chunk) { return *(const LAS bf16x8*)(img + key * 128 + ((chunk ^ ((key >> 1) & 7)) << 4)); }
__device__ __forceinline__ s16x4 ldVt(const LAS unsigned char* img, int key, int dt, int p) {
    const LAS unsigned char* a = img + key * 128 + (((2 * dt + (p >> 1)) ^ (((key >> 1) & 3) << 1)) << 4) + (p & 1) * 8;
    return __builtin_bit_cast(s16x4, __builtin_amdgcn_ds_read_tr16_b64_v4i16((LAS v4i16_t*)a)); }
template <bool ISV> __device__ __forceinline__ void dma_piece(const bf16_t* grow0, LAS unsigned char* img, int k0, int lane) {
    const int key = k0 + (lane >> 3), slot = lane & 7;
    const int ss = ISV ? (slot ^ (((key >> 1) & 3) << 1)) : (slot ^ ((key >> 1) & 7));
    __builtin_amdgcn_global_load_lds((const unsigned*)((const char*)grow0 + (lane >> 3) * 128 + ss * 16), (LAS unsigned*)(img + k0 * 128), 16, 0, 0);
}
__device__ __forceinline__ float xmax16_32(float v) { v = fmaxf(v, __shfl_xor(v, 16)); return fmaxf(v, __shfl_xor(v, 32)); }
__device__ __forceinline__ float xsum16_32(float v) { v += __shfl_xor(v, 16); return v + __shfl_xor(v, 32); }
__device__ __forceinline__ bf16x8 pack8(const f32x4& a, const f32x4& b) { u32x4 w; w.x = pk2(a[0], a[1]); w.y = pk2(a[2], a[3]); w.z = pk2(b[0], b[1]); w.w = pk2(b[2], b[3]); return __builtin_bit_cast(bf16x8, w); }

__device__ __forceinline__ void na_phase(Frame& F, const Args& a) {
    const bf16_t* QA = (const bf16_t*)(F.ws + WS_QA); const bf16_t* KA = (const bf16_t*)(F.ws + WS_KA); const bf16_t* VA = (const bf16_t*)(F.ws + WS_VA);
    bf16_t* OA = (bf16_t*)(F.ws + WS_OA); const f32x4* BT = (const f32x4*)(F.ws + WS_BT);
    LAS unsigned char* imgK = F.lds; LAS unsigned char* imgV = F.lds + 9 * 8192;
    const int lane = F.lane, g = lane >> 4, ql = lane & 15, q4 = (lane & 15) >> 2, p4 = lane & 3;
    const int per = (2048 + F.G - 1) / F.G;
    int res_lo = -1000, res_bh = -1;
    u32x4 pf[4]; int pf_lo = 0, pf_cnt = 0;
    f32x4 bt[8][2]; int bt_key = -1;
    bf16x8 qf0, qf1, qn0, qn1;
    auto q_ptr = [&](int u_) -> const bf16_t* { const int p_ = u_ & 63, h_ = (u_ >> 6) & 7, b_ = u_ >> 9;
        return QA + (((size_t)(b_ * 8 + h_) * SEQ) + (2 * p_ + (F.wave >> 2)) * 64 + 16 * (F.wave & 3) + ql) * 64 + 8 * g; };
    { const int u0 = F.vcu * per; if (u0 < 2048) { const bf16_t* q_ = q_ptr(u0); qf0 = *(const bf16x8*)q_; qf1 = *(const bf16x8*)(q_ + 32); } }
    asm volatile("" : "+v"(qf0), "+v"(qf1));
    for (int i = 0; i < per; ++i) {
        const int u = F.vcu * per + i; if (u >= 2048) break;
        const int p = u & 63, h = (u >> 6) & 7, b = u >> 9, bh = b * 8 + h;
        const int R0 = min(max(2 * p - 4, 0), 120);
        const size_t rowbase = (size_t)bh * SEQ;
        if (res_bh != bh || res_lo != R0) {
            __syncthreads();
            for (int j = F.wave; j < 144; j += 8) {
                const int kr = j >> 4, isv = (j >> 3) & 1, pc = j & 7; const int slot = (R0 + kr) % 9;
                const size_t tok0 = rowbase + (R0 + kr) * 64 + pc * 8;
                if (isv) dma_piece<true>(VA + tok0 * 64, imgV + slot * 8192, pc * 8, lane); else dma_piece<false>(KA + tok0 * 64, imgK + slot * 8192, pc * 8, lane);
            }
            asm volatile("s_waitcnt vmcnt(0)" ::: "memory");
            __syncthreads();
        }
        res_bh = bh; res_lo = R0;
        const int r = 2 * p + (F.wave >> 2), gq = F.wave & 3, base = (gq == 0) ? 0 : (gq == 1) ? 8 : (gq == 2) ? 24 : 32;
        const int rs = min(max(r - 4, 0), 120), rs9 = rs % 9, dr0 = rs - r + 7;
        if (bt_key != h * 64 + dr0) {
            bt_key = h * 64 + dr0;
#pragma unroll
            for (int kr = 0; kr < 8; ++kr)
#pragma unroll
                for (int hf = 0; hf < 2; ++hf) bt[kr][hf] = BT[((((h * 4 + gq) * 15 + dr0 + kr) * 2 + hf) * 64) + lane];
        }
        f32x4 S[8][2];
#pragma unroll
        for (int kr = 0; kr < 8; ++kr) {
            const int sl = (rs9 + kr >= 9) ? rs9 + kr - 9 : rs9 + kr; const LAS unsigned char* ik = imgK + sl * 8192;
#pragma unroll
            for (int hf = 0; hf < 2; ++hf) {
                const int key = base + 16 * hf + ql;
                f32x4 s = MFMA16(ldK(ik, key, g), qf0, bt[kr][hf]); s = MFMA16(ldK(ik, key, 4 + g), qf1, s); S[kr][hf] = s;
            }
        }
        __builtin_amdgcn_sched_barrier(0);
        const bool nxt_ok = (i + 1 < per && u + 1 < 2048), has_next = nxt_ok && ((u + 1) >> 6) == (u >> 6);
        { const bf16_t* q_ = q_ptr(nxt_ok ? u + 1 : u); qn0 = *(const bf16x8*)q_; qn1 = *(const bf16x8*)(q_ + 32); }
        pf_cnt = 0; pf_lo = R0;
        if (has_next) { const int nR0 = min(max(2 * (p + 1) - 4, 0), 120); pf_lo = max(nR0, R0 + 9); pf_cnt = nR0 + 9 - pf_lo; }
#pragma unroll
        for (int jj = 0; jj < 4; ++jj) {
            const int j = F.wave + 8 * jj, rowsel = j >> 4, isv = (j >> 3) & 1, pc = j & 7;
            const int prow = (rowsel < pf_cnt) ? pf_lo + rowsel : R0;
            const int key = pc * 8 + (lane >> 3), s16 = lane & 7; const int ss = isv ? (s16 ^ (((key >> 1) & 3) << 1)) : (s16 ^ ((key >> 1) & 7));
            const bf16_t* src = (isv ? VA : KA) + (rowbase + (size_t)prow * 64 + key) * 64 + ss * 8;
            pf[jj] = *(const u32x4*)src;
        }
        __builtin_amdgcn_sched_barrier(0);
        float m = -INFINITY;
#pragma unroll
        for (int kr = 0; kr < 8; ++kr)
#pragma unroll
            for (int hf = 0; hf < 2; ++hf) { m = fmaxf(fmaxf(m, S[kr][hf][0]), S[kr][hf][1]); m = fmaxf(fmaxf(m, S[kr][hf][2]), S[kr][hf][3]); }
        m = xmax16_32(m);
#pragma unroll
        for (int kr = 0; kr < 8; ++kr)
#pragma unroll
            for (int hf = 0; hf < 2; ++hf)
#pragma unroll
                for (int e = 0; e < 4; ++e) S[kr][hf][e] = __builtin_amdgcn_exp2f(S[kr][hf][e] - m);
        f32x4 o[4], osum = {0.f, 0.f, 0.f, 0.f};
        const bf16x8 ones8 = {0x3F80, 0x3F80, 0x3F80, 0x3F80, 0x3F80, 0x3F80, 0x3F80, 0x3F80};
#pragma unroll
        for (int dt = 0; dt < 4; ++dt) o[dt] = (f32x4){0.f, 0.f, 0.f, 0.f};
#pragma unroll
        for (int kr = 0; kr < 8; ++kr) {
            const int sl = (rs9 + kr >= 9) ? rs9 + kr - 9 : rs9 + kr;
            const bf16x8 pp = pack8(S[kr][0], S[kr][1]); const LAS unsigned char* iv = imgV + sl * 8192;
            const int ka = base + 4 * g + q4;
#pragma unroll
            for (int dt = 0; dt < 4; ++dt) {
                const s16x4 va = ldVt(iv, ka, dt, p4), vb = ldVt(iv, ka + 16, dt, p4);
                const bf16x8 vf = {va[0], va[1], va[2], va[3], vb[0], vb[1], vb[2], vb[3]};
                o[dt] = MFMA16(vf, pp, o[dt]);
            }
            osum = MFMA16(ones8, pp, osum);
        }
        const float inv = 1.0f / osum[0];
        bf16_t* op = OA + ((size_t)b * SEQ + r * 64 + 16 * gq + ql) * 512 + h * 64 + 4 * g;
#pragma unroll
        for (int dt = 0; dt < 4; ++dt) { u32x2 w; w.x = pk2(o[dt][0] * inv, o[dt][1] * inv); w.y = pk2(o[dt][2] * inv, o[dt][3] * inv); *(u32x2*)(op + 16 * dt) = w; }
        if (pf_cnt > 0) {
            __syncthreads();
#pragma unroll
            for (int jj = 0; jj < 4; ++jj) {
                const int j = F.wave + 8 * jj, rowsel = j >> 4, isv = (j >> 3) & 1, pc = j & 7;
                if (rowsel < pf_cnt) { const int slot = (pf_lo + rowsel) % 9; *(LAS u32x4*)((isv ? imgV : imgK) + slot * 8192 + pc * 1024 + lane * 16) = pf[jj]; }
            }
            res_lo = pf_lo + pf_cnt - 9;
            __syncthreads();
        }
        asm volatile("" :: "v"(pf[0]), "v"(pf[1]), "v"(pf[2]), "v"(pf[3]));
        qf0 = qn0; qf1 = qn1;
    }
    __syncthreads();
}

__device__ __forceinline__ void swa_phase(Frame& F, const Args& a) {
    const bf16_t* QB = (const bf16_t*)(F.ws + WS_QB); const bf16_t* KB = (const bf16_t*)(F.ws + WS_KB); const bf16_t* VB = (const bf16_t*)(F.ws + WS_VB);
    bf16_t* OB = (bf16_t*)(F.ws + WS_OB); const float* sinks = a.in[5];
    LAS unsigned char* imgK = F.lds; LAS unsigned char* imgV = F.lds + 65536;
    const int lane = F.lane, g = lane >> 4, ql = lane & 15, q4 = (lane & 15) >> 2, p4 = lane & 3;
    f32x4 mlo, mhi;
#pragma unroll
    for (int e = 0; e < 4; ++e) { mlo[e] = (4 * g + e >= ql) ? 0.f : -INFINITY; mhi[e] = (4 * g + e <= ql) ? 0.f : -INFINITY; }
    const int per = (512 + F.G - 1) / F.G;
    const float sink_a = sinks[F.wave >> 1] * LOG2E, sink_b = sinks[4 + (F.wave >> 1)] * LOG2E;
    auto q_base = [&](int u_) -> const bf16_t* { const int n_ = u_ & 63, kvh_ = (u_ >> 6) & 1, b_ = u_ >> 7;
        return QB + ((size_t)(b_ * 8 + 4 * kvh_ + (F.wave >> 1)) * SEQ + 128 * n_ + 64 * (F.wave & 1) + ql) * 64 + 8 * g; };
    bf16x8 qc0, qc1;
    { const int u0 = F.vcu * per; if (u0 < 512) { const bf16_t* q_ = q_base(u0); qc0 = *(const bf16x8*)q_; qc1 = *(const bf16x8*)(q_ + 32); } }
    { float sa_ = sink_a, sb_ = sink_b; asm volatile("" : "+v"(qc0), "+v"(qc1), "+v"(sa_), "+v"(sb_)); }
    int res_bk = -1, res_hi = -1000;
#define SWA_LOAD_BLOCK(bk, blk) do { const int slot_ = ((blk) + 1) & 3; const bool ok_ = (blk) >= 0 && (blk) < SEQ / 128; \
        for (int j = F.wave; j < 32; j += 8) { const int isv = j >> 4, pc = j & 15; \
            if (ok_) { const size_t tok0 = (size_t)(bk) * SEQ + (blk) * 128 + pc * 8; \
                if (isv) dma_piece<true>(VB + tok0 * 64, imgV + slot_ * 16384, pc * 8, lane); else dma_piece<false>(KB + tok0 * 64, imgK + slot_ * 16384, pc * 8, lane); } \
            else if (isv) { *(LAS u32x4*)(imgV + slot_ * 16384 + pc * 1024 + lane * 16) = (u32x4){0u, 0u, 0u, 0u}; } } } while (0)
    for (int i = 0; i < per; ++i) {
        const int u = F.vcu * per + i; if (u >= 512) break;
        const int n = u & 63, kvh = (u >> 6) & 1, b = u >> 7, bk = b * 2 + kvh;
        if (res_bk != bk || res_hi != n + 1) {
            __syncthreads();
            const bool keep2 = (res_bk == bk && res_hi == n);
            if (!keep2) { SWA_LOAD_BLOCK(bk, n - 1); SWA_LOAD_BLOCK(bk, n); }
            SWA_LOAD_BLOCK(bk, n + 1);
        }
        asm volatile("s_waitcnt vmcnt(0)" : "+v"(qc0), "+v"(qc1) :: "memory");
        __syncthreads();
        res_bk = bk; res_hi = n + 1;
        if (i + 1 < per && u + 1 < 512 && ((u + 1) >> 6) == (u >> 6)) { SWA_LOAD_BLOCK(bk, n + 2); res_hi = n + 2; }
        const int hq = 4 * kvh + (F.wave >> 1), half = F.wave & 1;
        const float sink2 = kvh ? sink_b : sink_a;
        const bf16_t* qbase = q_base(u);
        const bf16_t* nqbase = q_base((i + 1 < per && u + 1 < 512) ? u + 1 : u);
        const int kswz0 = (g ^ ((ql >> 1) & 7)) << 4, kswz1 = ((4 + g) ^ ((ql >> 1) & 7)) << 4;
        const int vk0 = 4 * g + q4; int vterm[4];
#pragma unroll
        for (int dt = 0; dt < 4; ++dt) vterm[dt] = (((2 * dt + (p4 >> 1)) ^ (((vk0 >> 1) & 3) << 1)) << 4) + (p4 & 1) * 8;
#pragma unroll 1
        for (int sub = 0; sub < 4; ++sub) {
            const int qrel0 = 64 * half + 16 * sub, qpos0 = 128 * n + qrel0;
            const bf16x8 qf0 = qc0, qf1 = qc1;
            const int kpos = 128 * n + qrel0 + ql, vpos = 128 * n + qrel0 + vk0;
            f32x4 S[17];
            bf16x8 kA[4][2], kB[4][2];
#define SW_KLD(buf, j, t) do { const LAS unsigned char* p_ = imgK + (((kpos + 16 * (t)) & 511) << 7); buf[j][0] = *(const LAS bf16x8*)(p_ + kswz0); buf[j][1] = *(const LAS bf16x8*)(p_ + kswz1); } while (0)
#define SW_KMM(buf, j, t) do { const f32x4 c_ = ((t) == 0) ? mlo : ((t) == 16) ? mhi : (f32x4){0.f, 0.f, 0.f, 0.f}; f32x4 s_ = MFMA16(buf[j][0], qf0, c_); s_ = MFMA16(buf[j][1], qf1, s_); \
                S[t] = s_; } while (0)
            SW_KLD(kA, 0, 0); SW_KLD(kA, 1, 1); SW_KLD(kA, 2, 2); SW_KLD(kA, 3, 3);
            SW_KLD(kB, 0, 4); SW_KLD(kB, 1, 5); SW_KLD(kB, 2, 6); SW_KLD(kB, 3, 7); __builtin_amdgcn_sched_barrier(0);
            SW_KMM(kA, 0, 0); SW_KMM(kA, 1, 1); SW_KMM(kA, 2, 2); SW_KMM(kA, 3, 3); __builtin_amdgcn_sched_barrier(0);
            SW_KLD(kA, 0, 8); SW_KLD(kA, 1, 9); SW_KLD(kA, 2, 10); SW_KLD(kA, 3, 11); __builtin_amdgcn_sched_barrier(0);
            SW_KMM(kB, 0, 4); SW_KMM(kB, 1, 5); SW_KMM(kB, 2, 6); SW_KMM(kB, 3, 7); __builtin_amdgcn_sched_barrier(0);
            SW_KLD(kB, 0, 12); SW_KLD(kB, 1, 13); SW_KLD(kB, 2, 14); SW_KLD(kB, 3, 15); __builtin_amdgcn_sched_barrier(0);
            SW_KMM(kA, 0, 8); SW_KMM(kA, 1, 9); SW_KMM(kA, 2, 10); SW_KMM(kA, 3, 11); __builtin_amdgcn_sched_barrier(0);
            SW_KLD(kA, 0, 16); __builtin_amdgcn_sched_barrier(0);
            SW_KMM(kB, 0, 12); SW_KMM(kB, 1, 13); SW_KMM(kB, 2, 14); SW_KMM(kB, 3, 15); __builtin_amdgcn_sched_barrier(0);
            SW_KMM(kA, 0, 16); __builtin_amdgcn_sched_barrier(0);
            { const bf16_t* qn_ = (sub < 3) ? qbase + (sub + 1) * 1024 : nqbase; qc0 = *(const bf16x8*)qn_; qc1 = *(const bf16x8*)(qn_ + 32); }
            __builtin_amdgcn_sched_barrier(0);
#undef SW_KLD
#undef SW_KMM
            if (n == 0 || n == SEQ / 128 - 1) {
#pragma unroll
                for (int t = 0; t < 17; ++t) { const int kp_ = qpos0 - 128 + 16 * t; if (kp_ < 0 || kp_ >= SEQ) S[t] = (f32x4){-INFINITY, -INFINITY, -INFINITY, -INFINITY}; }
            }
            float m = -INFINITY;
#pragma unroll
            for (int t = 0; t < 17; ++t) { m = fmaxf(fmaxf(m, S[t][0]), S[t][1]); m = fmaxf(fmaxf(m, S[t][2]), S[t][3]); }
            m = fmaxf(xmax16_32(m), sink2);
#pragma unroll
            for (int t = 0; t < 17; ++t)
#pragma unroll
                for (int e = 0; e < 4; ++e) S[t][e] = __builtin_amdgcn_exp2f(S[t][e] - m);
            f32x4 o[4], osum = {0.f, 0.f, 0.f, 0.f};
#pragma unroll
            for (int dt = 0; dt < 4; ++dt) o[dt] = (f32x4){0.f, 0.f, 0.f, 0.f};
            const f32x4 zero4 = {0.f, 0.f, 0.f, 0.f};
            const bf16x8 ones8 = {0x3F80, 0x3F80, 0x3F80, 0x3F80, 0x3F80, 0x3F80, 0x3F80, 0x3F80};
            s16x4 vA[4][2], vB[4][2];
#define SW_VLD(buf, ks) do { const int ta_ = 2 * (ks), tb_ = (2 * (ks) + 1 < 17) ? 2 * (ks) + 1 : 2 * (ks); \
                const LAS unsigned char* pa_ = imgV + (((vpos + 16 * ta_) & 511) << 7); const LAS unsigned char* pb_ = imgV + (((vpos + 16 * tb_) & 511) << 7); \
                _Pragma("unroll") for (int dt = 0; dt < 4; ++dt) { \
                    buf[dt][0] = __builtin_bit_cast(s16x4, __builtin_amdgcn_ds_read_tr16_b64_v4i16((LAS v4i16_t*)(pa_ + vterm[dt]))); \
                    buf[dt][1] = __builtin_bit_cast(s16x4, __builtin_amdgcn_ds_read_tr16_b64_v4i16((LAS v4i16_t*)(pb_ + vterm[dt]))); } } while (0)
#define SW_VMM(buf, ks) do { const bf16x8 pp_ = pack8(S[2 * (ks)], (2 * (ks) + 1 < 17) ? S[(2 * (ks) + 1 < 17) ? 2 * (ks) + 1 : 0] : zero4); \
                _Pragma("unroll") for (int dt = 0; dt < 4; ++dt) { const bf16x8 vf_ = {buf[dt][0][0], buf[dt][0][1], buf[dt][0][2], buf[dt][0][3], buf[dt][1][0], buf[dt][1][1], buf[dt][1][2], buf[dt][1][3]}; \
                    o[dt] = MFMA16(vf_, pp_, o[dt]); } osum = MFMA16(ones8, pp_, osum); } while (0)
            SW_VLD(vA, 0); SW_VLD(vB, 1); __builtin_amdgcn_sched_barrier(0);
            SW_VMM(vA, 0); __builtin_amdgcn_sched_barrier(0); SW_VLD(vA, 2); __builtin_amdgcn_sched_barrier(0);
            SW_VMM(vB, 1); __builtin_amdgcn_sched_barrier(0); SW_VLD(vB, 3); __builtin_amdgcn_sched_barrier(0);
            SW_VMM(vA, 2); __builtin_amdgcn_sched_barrier(0); SW_VLD(vA, 4); __builtin_amdgcn_sched_barrier(0);
            SW_VMM(vB, 3); __builtin_amdgcn_sched_barrier(0); SW_VLD(vB, 5); __builtin_amdgcn_sched_barrier(0);
            SW_VMM(vA, 4); __builtin_amdgcn_sched_barrier(0); SW_VLD(vA, 6); __builtin_amdgcn_sched_barrier(0);
            SW_VMM(vB, 5); __builtin_amdgcn_sched_barrier(0); SW_VLD(vB, 7); __builtin_amdgcn_sched_barrier(0);
            SW_VMM(vA, 6); __builtin_amdgcn_sched_barrier(0); SW_VLD(vA, 8); __builtin_amdgcn_sched_barrier(0);
            SW_VMM(vB, 7); __builtin_amdgcn_sched_barrier(0);
            SW_VMM(vA, 8);
#undef SW_VLD
#undef SW_VMM
            const float inv = 1.0f / (osum[0] + __builtin_amdgcn_exp2f(sink2 - m));
            bf16_t* op = OB + ((size_t)b * SEQ + qpos0 + ql) * 512 + hq * 64 + 4 * g;
#pragma unroll
            for (int dt = 0; dt < 4; ++dt) { u32x2 w; w.x = pk2(o[dt][0] * inv, o[dt][1] * inv); w.y = pk2(o[dt][2] * inv, o[dt][3] * inv); *(u32x2*)(op + 16 * dt) = w; }
        }
    }
#undef SWA_LOAD_BLOCK
    asm volatile("s_waitcnt vmcnt(0)" ::: "memory");
    __syncthreads();
}

__device__ __forceinline__ void router_phase(Frame& F, const Args& a) {
    const float* x = a.in[0]; bf16_t* AO = (bf16_t*)(F.ws + WS_AO); const float* g2 = a.in[9]; const float* wr_ = a.in[10]; const float* br = a.in[11];
    unsigned char* H2N = (unsigned char*)(F.ws + WS_H2N); float* gwl = (float*)(F.ws + WS_GWL); int* list = (int*)(F.ws + WS_LIST); int* inv = (int*)(F.ws + WS_INV);
    unsigned* counts = (unsigned*)(F.ws + WS_CTL) + CW_CNT;
    LAS float* wL = (LAS float*)F.lds;
    LAS float* lgs = (LAS float*)(F.lds + RING_BYTES) + F.wave * 512;
    LAS int* sel = (LAS int*)(F.lds + SEL_OFF); LAS float* selg = (LAS float*)(F.lds + SELG_OFF);
    {
        f32x4 wv[16]; float gk[16];
#pragma unroll
        for (int j = 0; j < 16; ++j) { const int i4 = F.tid + NTHREADS * j; wv[j] = *((const f32x4*)wr_ + i4); gk[j] = g2[i4 >> 3]; }
#pragma unroll
        for (int j = 0; j < 16; ++j) { const int i = 4 * (F.tid + NTHREADS * j), k = i >> 5, e = i & 31;
#pragma unroll
            for (int c = 0; c < 4; ++c) wL[k * 32 + 2 * ((e + c) & 15) + ((e + c) >> 4)] = wv[j][c] * gk[j]; }
    }
    __syncthreads();
    const int lane = F.lane, ti = lane & 15, q = lane >> 4;
    for (int ch = blockIdx.x; ch < T / 128; ch += F.G) {
        const int t0 = ch * 128 + F.wave * 16;
        const float* xrow = x + (size_t)(t0 + ti) * D + 4 * q; bf16_t* arow = AO + (size_t)(t0 + ti) * D + 4 * q;
        f32x4 acc0 = {0.f, 0.f, 0.f, 0.f}, acc1 = {0.f, 0.f, 0.f, 0.f}; float ss = 0.f;
#pragma unroll 4
        for (int s = 0; s < 64; ++s) {
            f32x4 v = *(const f32x4*)(xrow + 16 * s); const u32x2 w = *(const u32x2*)(arow + 16 * s);
            v.x += bflo(w.x); v.y += bfhi(w.x); v.z += bflo(w.y); v.w += bfhi(w.y);
            { u32x2 xb; xb.x = pk2(v.x, v.y); xb.y = pk2(v.z, v.w); *(u32x2*)(arow + 16 * s) = xb; }
            ss += (v.x * v.x + v.y * v.y) + (v.z * v.z + v.w * v.w);
            const LAS float* wp = wL + (16 * s + 4 * q) * 32 + 2 * ti;
#pragma unroll
            for (int u = 0; u < 4; ++u) {
                const f32x2 b = *(const LAS f32x2*)(wp + 32 * u);
                acc0 = __builtin_amdgcn_mfma_f32_16x16x4f32(v[u], b.x, acc0, 0, 0, 0);
                acc1 = __builtin_amdgcn_mfma_f32_16x16x4f32(v[u], b.y, acc1, 0, 0, 0);
            }
        }
        ss += __shfl_xor(ss, 16); ss += __shfl_xor(ss, 32);
        const float rstd = 1.0f / sqrtf(ss * (1.f / D) + RMS_EPS);
#pragma unroll
        for (int r = 0; r < 4; ++r) { lgs[(4 * q + r) * 32 + ti] = acc0[r]; lgs[(4 * q + r) * 32 + 16 + ti] = acc1[r]; }
        asm volatile("s_waitcnt lgkmcnt(0)" ::: "memory");
        if (lane < 16) {
            float lg[32];
#pragma unroll
            for (int e4 = 0; e4 < 8; ++e4) { const f32x4 v4 = *(const LAS f32x4*)(lgs + lane * 32 + 4 * e4); const f32x4 b4 = *(const f32x4*)(br + 4 * e4);
                lg[4 * e4] = v4.x * rstd + b4.x; lg[4 * e4 + 1] = v4.y * rstd + b4.y; lg[4 * e4 + 2] = v4.z * rstd + b4.z; lg[4 * e4 + 3] = v4.w * rstd + b4.w; }
            float tv[4]; int tix[4];
#pragma unroll
            for (int k = 0; k < 4; ++k) {
                float best = -INFINITY; int bi = 0;
#pragma unroll
                for (int e = 0; e < 32; ++e) if (lg[e] > best) { best = lg[e]; bi = e; }
#pragma unroll
                for (int e = 0; e < 32; ++e) lg[e] = (e == bi) ? -INFINITY : lg[e];
                tv[k] = best; tix[k] = bi;
            }
            const float e1 = __expf(tv[1] - tv[0]), e2 = __expf(tv[2] - tv[0]), e3 = __expf(tv[3] - tv[0]);
            const float inv = 1.0f / (1.0f + e1 + e2 + e3);
            const int rloc = F.wave * 16 + lane;
            sel[rloc * 4 + 0] = tix[0]; sel[rloc * 4 + 1] = tix[1]; sel[rloc * 4 + 2] = tix[2]; sel[rloc * 4 + 3] = tix[3];
            selg[rloc * 4 + 0] = inv; selg[rloc * 4 + 1] = e1 * inv; selg[rloc * 4 + 2] = e2 * inv; selg[rloc * 4 + 3] = e3 * inv;
        }
#pragma unroll 4
        for (int r = 0; r < 16; ++r) {
            const float rq = __shfl(rstd, r) * F8_ACT; const int t = t0 + r;
            const u32x4* ar = (const u32x4*)(AO + (size_t)t * D) + 2 * lane;
            const u32x4 wa = ar[0], wb = ar[1];
            u32x4 o; o.x = pk4_fp8(bflo(wa.x) * rq, bfhi(wa.x) * rq, bflo(wa.y) * rq, bfhi(wa.y) * rq); o.y = pk4_fp8(bflo(wa.z) * rq, bfhi(wa.z) * rq, bflo(wa.w) * rq, bfhi(wa.w) * rq);
            o.z = pk4_fp8(bflo(wb.x) * rq, bfhi(wb.x) * rq, bflo(wb.y) * rq, bfhi(wb.y) * rq); o.w = pk4_fp8(bflo(wb.z) * rq, bfhi(wb.z) * rq, bflo(wb.w) * rq, bfhi(wb.w) * rq);
            *((u32x4*)(H2N + (size_t)t * D) + lane) = o;
        }
        LAS int* lcnt = (LAS int*)(F.lds + TS_OFF) + 96; LAS int* lbase = lcnt + 32;
        if (F.tid < 32) lcnt[F.tid] = 0;
        __syncthreads();
        const int myj = F.tid, mye = sel[myj];
        const int mypos = __hip_atomic_fetch_add(lcnt + mye, 1, __ATOMIC_RELAXED, __HIP_MEMORY_SCOPE_WORKGROUP);
        __syncthreads();
        if (F.tid < 32) { const int c = lcnt[F.tid]; lbase[F.tid] = c > 0 ? (int)__hip_atomic_fetch_add(counts + F.tid, (unsigned)c, RLX_AGENT) : 0; }
        __syncthreads();
        { const int idx = lbase[mye] + mypos, slot = mye * LISTCAP + idx, tk = (ch * 128 + (myj >> 2)) * 4 + (myj & 3); list[slot] = tk; gwl[slot] = selg[myj]; inv[tk] = (mye << 16) | idx; }
        __syncthreads();
    }
}

__device__ __forceinline__ void moe_tables(Frame& F) {
    LAS int* ts = (LAS int*)(F.lds + TS_OFF); LAS int* cn = ts + 40;
    unsigned* counts = (unsigned*)(F.ws + WS_CTL) + CW_CNT;
    if (F.tid < 32) cn[F.tid] = (int)__hip_atomic_load(counts + F.tid, RLX_AGENT);
    __syncthreads();
    if (F.tid == 0) { int s = 0; for (int e = 0; e < 32; ++e) { ts[e] = s; s += (cn[e] + 255) >> 8; } ts[32] = s; ts[33] = 0x7fffffff; }
    __syncthreads();
    { LAS unsigned char* t2e = F.lds + T2E_OFF; const int total = ts[32];
      for (int m = F.tid; m < total; m += NTHREADS) { int e = 0; while (ts[e + 1] <= m) ++e; t2e[m] = (unsigned char)e; } }
    __syncthreads();
}

__device__ __forceinline__ void combine_phase(Frame& F, const Args& a) {
    moe_tables(F);
    const LAS int* ts = (const LAS int*)(F.lds + TS_OFF);
    float* out = a.out; const float* x = a.in[0]; const float* fg = a.in[16]; const unsigned char* Y = (const unsigned char*)(F.ws + WS_YTK); const bf16_t* AO = (const bf16_t*)(F.ws + WS_AO);
    const int* inv = (const int*)(F.ws + WS_INV);
    const int gw = F.vcu * NWAVES + F.wave, NGW = F.G * NWAVES;
    f32x4 gv[4];
#pragma unroll
    for (int j = 0; j < 4; ++j) gv[j] = *((const f32x4*)fg + F.lane + 64 * j);
    const int ntok = (T - gw + NGW - 1) / NGW;
    for (int i0 = 0; i0 < ntok; i0 += 16) {
        const int ti_ = i0 + (F.lane >> 2); int invv = 0;
        if (ti_ < ntok) invv = __hip_atomic_load(inv + 4 * (size_t)(gw + ti_ * NGW) + (F.lane & 3), RLX_AGENT);
        const int rowv = ts[(invv >> 16) & 31] * 256 + (invv & 0xffff);
        const int nloc = min(16, ntok - i0);
#define CB_LOAD(AV, YV, i_) do { const int t_ = gw + (i0 + (i_)) * NGW; int row_[4]; \
            _Pragma("unroll") for (int k = 0; k < 4; ++k) row_[k] = __builtin_amdgcn_readlane(rowv, 4 * (i_) + k); \
            _Pragma("unroll") for (int j = 0; j < 4; ++j) { AV[j] = *((const u32x2*)(AO + (size_t)t_ * D) + F.lane + 64 * j); \
                _Pragma("unroll") for (int k = 0; k < 4; ++k) YV[k][j] = *((const unsigned*)(Y + (size_t)row_[k] * D) + F.lane + 64 * j); } } while (0)
#define CB_PROC(AV, YV, i_) do { const int t_ = gw + (i0 + (i_)) * NGW; f32x4 v[4]; float ss = 0.f; \
            _Pragma("unroll") for (int j = 0; j < 4; ++j) { f32x4 ysum = {0.f, 0.f, 0.f, 0.f}; \
                _Pragma("unroll") for (int k = 0; k < 4; ++k) { const f32x2 lo2 = __builtin_amdgcn_cvt_pk_f32_fp8((int)YV[k][j], false), hi2 = __builtin_amdgcn_cvt_pk_f32_fp8((int)YV[k][j], true); \
                    ysum.x += lo2.x; ysum.y += lo2.y; ysum.z += hi2.x; ysum.w += hi2.y; } \
                v[j] = ysum * F8_YINV; v[j].x += bflo(AV[j].x); v[j].y += bfhi(AV[j].x); v[j].z += bflo(AV[j].y); v[j].w += bfhi(AV[j].y); \
                ss += (v[j].x * v[j].x + v[j].y * v[j].y) + (v[j].z * v[j].z + v[j].w * v[j].w); } \
            const float rstd = 1.0f / sqrtf(wave_sum(ss) * (1.f / D) + RMS_EPS); f32x4* orow = (f32x4*)(out + (size_t)t_ * D) + F.lane; \
            _Pragma("unroll") for (int j = 0; j < 4; ++j) orow[64 * j] = v[j] * rstd * gv[j]; } while (0)
        u32x2 avA[4], avB[4]; unsigned yvA[4][4], yvB[4][4];
        CB_LOAD(avA, yvA, 0);
#pragma unroll 1
        for (int i = 0; i < nloc; i += 2) {
            if (i + 1 < nloc) CB_LOAD(avB, yvB, i + 1);
            CB_PROC(avA, yvA, i);
            if (i + 2 < nloc) CB_LOAD(avA, yvA, i + 2);
            if (i + 1 < nloc) CB_PROC(avB, yvB, i + 1);
        }
#undef CB_LOAD
#undef CB_PROC
    }
}

constexpr int N_PHASES = 9;
#ifndef PROBE_PHASE
#define PROBE_PHASE -1
#endif
#ifndef PROBE_REPS
#define PROBE_REPS 2
#endif
template <int k> __device__ __forceinline__ void run_phase(Frame& F0, const Args& args) {
    Frame F = F0; { int t_ = threadIdx.x; asm volatile("" : "+v"(t_)); F.tid = t_; F.lane = t_ & 63; F.wave = __builtin_amdgcn_readfirstlane(t_ >> 6); }
    if constexpr (k == 0) { p0_prologue(F, args); }
    else if constexpr (k == 1) {
        { DenseSched S; S.so.init(T, C_GA, F.G, (int)blockIdx.x); S.A = (const char*)(F.ws + WS_H1); S.lda = D * 2; S.Bt = (const char*)(F.ws + WS_WIN); S.K = 2 * D;
          EpiInProj E{F.ws, args.in[3], (const float*)(F.ws + WS_ROPE)};
          pg8::gemm_phase<true, true, false>(F.lds, 2 * D, S, E); }
        { DenseSched S; S.so.init(T, 2048, F.G, (int)blockIdx.x); if (F.G == 256) S.so.tail_lo = 128; S.A = (const char*)(F.ws + WS_H1Q); S.lda = D; S.Bt = (const char*)(F.ws + WS_WING8); S.K = D;
          EpiGate E{(bf16_t*)(F.ws + WS_SG), args.in[3]};
          pg8::gemm_phase<true, true, true>(F.lds, D, S, E); }
    } else if constexpr (k == 2) {
#if ATTN_NAIVE
        attn_naive(F, args);
#else
        na_phase(F, args); swa_phase(F, args);
#if PROBE_ATTN == 1
        na_phase(F, args); na_phase(F, args);
#elif PROBE_ATTN == 2
        swa_phase(F, args); swa_phase(F, args);
#endif
#endif
    } else if constexpr (k == 3) {
        UpSched S; S.so.init(T, D, F.G, (int)blockIdx.x); S.OA = (const char*)(F.ws + WS_OA); S.OB = (const char*)(F.ws + WS_OB); S.Wa = (const char*)(F.ws + WS_WA); S.Wb = (const char*)(F.ws + WS_WB);
        EpiUp E{(const bf16_t*)(F.ws + WS_SG), (bf16_t*)(F.ws + WS_MERGED)};
        pg8::gemm_phase<true, true, false>(F.lds, 2 * 512, S, E);
    } else if constexpr (k == 4) {
        DenseSched S; S.so.init(T, D, F.G, (int)blockIdx.x); S.A = (const char*)(F.ws + WS_MERGED); S.lda = D * 2; S.Bt = (const char*)(F.ws + WS_WOUT); S.K = 2 * D;
        EpiAo E{(bf16_t*)(F.ws + WS_AO)};
        pg8::gemm_phase<true, true, false>(F.lds, 2 * D, S, E);
    } else if constexpr (k == 5) { router_phase(F, args); }
    else if constexpr (k == 6) {
        moe_tables(F);
        const LAS int* ts = (const LAS int*)(F.lds + TS_OFF);
        MoeSched<true> S; S.tstart = ts; S.cnt = ts + 40; S.t2e = (const LAS unsigned char*)(F.lds + T2E_OFF); S.G = F.G; S.vcu = F.vcu; S.log_mt = 2; S.total = ts[32];
        S.A = (const char*)(F.ws + WS_H2N); S.list = (const int*)(F.ws + WS_LIST); S.Bt = (const char*)(F.ws + WS_W1); S.b_estride = (size_t)2 * FF * D; S.K = D;
        EpiMoe1 E{args.in[13], (unsigned char*)(F.ws + WS_HACT)};
        pg8::gemm_phase<true, true, true>(F.lds, D, S, E);
    } else if constexpr (k == 7) {
        moe_tables(F);
        const LAS int* ts = (const LAS int*)(F.lds + TS_OFF);
        MoeSched<false> S; S.tstart = ts; S.cnt = ts + 40; S.t2e = (const LAS unsigned char*)(F.lds + T2E_OFF); S.G = F.G; S.vcu = F.vcu; S.log_mt = 3; S.total = ts[32];
        S.A = (const char*)(F.ws + WS_HACT); S.list = (const int*)(F.ws + WS_LIST); S.Bt = (const char*)(F.ws + WS_W2); S.b_estride = (size_t)D * FF; S.K = FF;
        EpiMoe2 E{ts + 40, (const float*)(F.ws + WS_GWL), args.in[15], (unsigned char*)(F.ws + WS_YTK)};
        pg8::gemm_phase<true, true, true>(F.lds, FF, S, E);
    } else if constexpr (k == 8) { combine_phase(F, args); }
}
__global__ void __launch_bounds__(NTHREADS, 2) fwd_kernel(Args args) {
    extern __shared__ __attribute__((aligned(16))) unsigned char lds_raw[];
    Frame F;
    F.lds = (LAS unsigned char*)lds_raw;
    F.tid = threadIdx.x; F.lane = F.tid & 63; F.wave = __builtin_amdgcn_readfirstlane(F.tid >> 6);
    F.G = gridDim.x; { const int bx = blockIdx.x; F.vcu = (F.G % 8 == 0) ? (bx % 8) * (F.G / 8) + bx / 8 : bx; }
    F.ws = args.ws;
    volatile LAS unsigned* MISC = (volatile LAS unsigned*)(F.lds + MISC_OFF);
    for (int u = F.tid; u < 256; u += NTHREADS) MISC[u] = 0u;
    __syncthreads();
    unsigned* ctl = (unsigned*)(F.ws + WS_CTL);
    XcdBarrier bar; bar.bar = ctl + CW_BAR + args.li * XCD_BAR_WORDS; bar.x = 0; bar.st = nullptr;
    const int lo = args.ph_lo, hi = args.ph_hi;
    if (hi - lo > 1) bar = xcd_barrier_post(ctl + CW_BAR + args.li * XCD_BAR_WORDS, MISC + 8);
#define PHASE(k) do { if (lo <= (k) && (k) < hi) { run_phase<k>(F, args); if ((k) + 1 < hi) xcd_barrier(bar); } } while (0)
    PHASE(0); PHASE(1); PHASE(2); PHASE(3); PHASE(4); PHASE(5); PHASE(6); PHASE(7); PHASE(8);
#undef PHASE
}

extern "C" void kernel_launch(void* const* d_in, const int* in_sizes, int n_in, void* d_out, int out_size, void* d_ws, size_t ws_size, hipStream_t stream) {
    static int grid = 0;
    if (grid == 0) {
        if (n_in != 17 || in_sizes[0] != T * D || out_size != T * D || ws_size < WS_END) { fprintf(stderr, "kernel_launch: unexpected shapes (n_in %d, in0 %d, out %d, ws %zu); nothing launched\n", n_in, n_in > 0 ? in_sizes[0] : -1, out_size, ws_size); grid = -1; return; }
        int dev = 0, cus = 0, per_cu = 0;
        if (hipGetDevice(&dev) != hipSuccess || hipDeviceGetAttribute(&cus, hipDeviceAttributeMultiprocessorCount, dev) != hipSuccess) { grid = -1; return; }
        if (hipFuncSetAttribute((const void*)fwd_kernel, hipFuncAttributeMaxDynamicSharedMemorySize, LDS_BYTES) != hipSuccess) { fprintf(stderr, "kernel_launch: hipFuncSetAttribute failed\n"); grid = -1; return; }
        if (hipOccupancyMaxActiveBlocksPerMultiprocessor(&per_cu, (const void*)fwd_kernel, NTHREADS, LDS_BYTES) != hipSuccess || per_cu < 1) { fprintf(stderr, "kernel_launch: occupancy query reports %d blocks per CU\n", per_cu); per_cu = 1; }
        (void)hipGetLastError();
        grid = cus;
    }
    if (grid < 0) return;
    (void)hipMemsetAsync((char*)d_ws + WS_CTL, 0, CTL_ZERO_BYTES, stream);
    Args a{};
    for (int i = 0; i < 17; ++i) a.in[i] = (const float*)d_in[i];
    a.out = (float*)d_out; a.ws = (unsigned char*)d_ws;
    void* kargs[] = {&a};
#if MK_SPLIT
    for (int p = 0; p < N_PHASES; ++p) {
        a.ph_lo = p; a.ph_hi = p + 1; a.li = 0;
        hipLaunchKernelGGL(fwd_kernel, dim3(grid), dim3(NTHREADS), LDS_BYTES, stream, a);
    }
#elif PROBE_PHASE >= 0
    {
        int li = 0;
        a.ph_lo = 0; a.ph_hi = PROBE_PHASE + 1; a.li = li++;
        (void)hipLaunchCooperativeKernel((const void*)fwd_kernel, dim3(grid), dim3(NTHREADS), kargs, LDS_BYTES, stream);
        for (int r = 0; r < PROBE_REPS; ++r) { a.ph_lo = PROBE_PHASE; a.ph_hi = PROBE_PHASE + 1; a.li = li++;
            if (PROBE_PHASE == 5) (void)hipMemsetAsync((char*)d_ws + WS_CTL + CW_CNT * 4, 0, 128, stream);
            (void)hipLaunchCooperativeKernel((const void*)fwd_kernel, dim3(grid), dim3(NTHREADS), kargs, LDS_BYTES, stream); }
        if (PROBE_PHASE + 1 < N_PHASES) { a.ph_lo = PROBE_PHASE + 1; a.ph_hi = N_PHASES; a.li = li++;
            (void)hipLaunchCooperativeKernel((const void*)fwd_kernel, dim3(grid), dim3(NTHREADS), kargs, LDS_BYTES, stream); }
    }
#else
    a.ph_lo = 0; a.ph_hi = N_PHASES; a.li = 0;
    hipError_t e = hipLaunchCooperativeKernel((const void*)fwd_kernel, dim3(grid), dim3(NTHREADS), kargs, LDS_BYTES, stream);
    if (e != hipSuccess) fprintf(stderr, "kernel_launch: cooperative launch failed: %s (grid %d)\n", hipGetErrorString(e), grid);
#endif
}
```

```cpp
#include <hip/hip_runtime.h>
#include <cstdio>
#include <cstdint>

#ifndef PROBE_ATTN
#define PROBE_ATTN 0
#endif
#ifndef ATTN_NAIVE
#define ATTN_NAIVE 0
#endif
#ifndef MK_SPLIT
#define MK_SPLIT 0
#endif

#define LAS __attribute__((address_space(3)))
#define GAS __attribute__((address_space(1)))
typedef unsigned short bf16_t;
typedef short bf16x8 __attribute__((ext_vector_type(8)));
typedef float f32x4 __attribute__((ext_vector_type(4)));
typedef float f32x2 __attribute__((ext_vector_type(2)));
typedef unsigned u32x4 __attribute__((ext_vector_type(4)));
typedef unsigned u32x2 __attribute__((ext_vector_type(2)));
typedef __bf16 bf16x2_t __attribute__((ext_vector_type(2)));

constexpr int NB = 4, SEQ = 8192, T = NB * SEQ, D = 1024, DIN = 4352;
constexpr int NEXP = 32, FF = 1024, LISTCAP = 32768;
constexpr float RMS_EPS = 1e-5f;
constexpr float LOG2E = 1.4426950408889634f;
constexpr float QSCALE = 0.125f * LOG2E;
constexpr int C_QA = 0, C_KA = 512, C_VA = 1024, C_QB = 1536, C_KB = 2048, C_VB = 2176, C_GA = 2304, C_GB = 3328;

constexpr size_t MiB = 1u << 20;
constexpr size_t WS_CTL = 0, CTL_ZERO_BYTES = 1 * MiB;
constexpr size_t WS_ROPE = 1 * MiB;
constexpr size_t WS_BT = 3 * MiB;
constexpr size_t WS_WIN = 4 * MiB;
constexpr size_t WS_WA = 13 * MiB, WS_WB = 14 * MiB, WS_WOUT = 15 * MiB;
constexpr size_t WS_W2 = 17 * MiB;
constexpr size_t WS_GWL = 744 * MiB;
constexpr size_t WS_LIST = 83 * MiB;
constexpr size_t WS_AO = 88 * MiB;
constexpr size_t WS_PROJ = 152 * MiB;
constexpr size_t WS_QA = WS_PROJ, WS_KA = WS_PROJ + 32 * MiB, WS_VA = WS_PROJ + 64 * MiB, WS_QB = WS_PROJ + 96 * MiB;
constexpr size_t WS_KB = WS_PROJ + 128 * MiB, WS_VB = WS_PROJ + 136 * MiB;
constexpr size_t WS_SG = WS_PROJ + 144 * MiB;
constexpr size_t WS_HACT = WS_PROJ;
constexpr size_t WS_W1 = 424 * MiB;
constexpr size_t WS_H1 = 552 * MiB;
constexpr size_t WS_H2N = WS_H1;
constexpr size_t WS_OA = 616 * MiB, WS_OB = 648 * MiB;
constexpr size_t WS_MERGED = 680 * MiB;
constexpr size_t WS_YTK = 424 * MiB;
constexpr size_t WS_H1Q = 680 * MiB;
constexpr size_t WS_WING8 = 50 * MiB;
constexpr size_t WS_INV = 748 * MiB;
constexpr size_t WS_END = 749 * MiB;
constexpr int CW_CNT = 64;
constexpr int CW_BAR = 4096;

constexpr int RING_BYTES = 131072;
constexpr int ATT_BYTES = 147456;
constexpr int MISC_OFF = ATT_BYTES;
constexpr int SEL_OFF = MISC_OFF + 1024;
constexpr int SELG_OFF = SEL_OFF + 2048;
constexpr int TS_OFF = SELG_OFF + 2048;
constexpr int T2E_OFF = TS_OFF + 1536;
constexpr int LDS_BYTES = 155648;
constexpr int NWAVES = 8, NTHREADS = 512;

#define RLX_AGENT __ATOMIC_RELAXED, __HIP_MEMORY_SCOPE_AGENT

__device__ __forceinline__ unsigned f2bf(float f) { unsigned u = __builtin_bit_cast(unsigned, f); return (u + 0x7fffu + ((u >> 16) & 1u)) >> 16; }
__device__ __forceinline__ unsigned pk2(float lo, float hi) { f32x2 v = {lo, hi}; bf16x2_t b = __builtin_convertvector(v, bf16x2_t); return __builtin_bit_cast(unsigned, b); }
constexpr float F8_ACT = 4.0f, F8_W = 128.0f, F8_INV = 1.0f / 512.0f, F8_Y = 32.0f, F8_YINV = 1.0f / 32.0f;
__device__ __forceinline__ unsigned pk4_fp8(float a, float b, float c, float d) { int w = 0; w = __builtin_amdgcn_cvt_pk_fp8_f32(a, b, w, false); w = __builtin_amdgcn_cvt_pk_fp8_f32(c, d, w, true); return (unsigned)w; }
__device__ __forceinline__ float bflo(unsigned w) { return __uint_as_float(w << 16); }
__device__ __forceinline__ float bfhi(unsigned w) { return __uint_as_float(w & 0xffff0000u); }
__device__ __forceinline__ float sigmoidf_(float x) { return __builtin_amdgcn_rcpf(1.0f + __builtin_amdgcn_exp2f(-x * LOG2E)); }
__device__ __forceinline__ const char* uniform_ptr(const char* p) {
    const unsigned long long v = (unsigned long long)p;
    const unsigned lo = __builtin_amdgcn_readfirstlane((unsigned)v), hi = __builtin_amdgcn_readfirstlane((unsigned)(v >> 32));
    return (const char*)(((unsigned long long)hi << 32) | lo);
}
__device__ __forceinline__ float wave_sum(float v) {
#pragma unroll
    for (int o = 1; o < 64; o <<= 1) v += __shfl_xor(v, o);
    return v;
}

namespace pg8 {
constexpr int BM = 256, BK = 64, HALF = 128, HTB = HALF * BK * 2, STAGE_BYTES = 8 * HTB, NXCD = 8, WGM = 8;
__host__ __device__ __forceinline__ int lds_byte(int r, int c) { const int st = (r >> 4) * 2 + (c >> 5), rr = r & 15, cc = c & 31, ob = rr * 64 + cc * 2; return st * 1024 + (ob ^ (((ob >> 9) & 1) << 5)); }
__host__ __device__ __forceinline__ void stage_rc(int b, int& R, int& C) { const int st = b / 1024, sb = b % 1024, swz = sb ^ (((sb >> 9) & 1) << 5); R = (st >> 1) * 16 + swz / 64; C = (st & 1) * 32 + (swz % 64) / 2; }
__host__ __device__ __forceinline__ int perm32(int rho) { const int n = rho >> 4, i = rho & 15; return 8 * (i >> 2) + 4 * n + (i & 3); }

struct Unit { int pm, pn, e, mt, part; };

struct StaticOrder {
    int nM, nN, nwg, G, c, tail_lo;
    __device__ void init(int M, int N, int G_, int c_) { nM = M / BM; nN = N / BM; nwg = nM * nN; G = G_; c = c_; tail_lo = -1; }
    __device__ bool next(int i, Unit& u) const {
        long L = (long)i * G + c;
        if (tail_lo >= 0 && i >= 3) { if (c < tail_lo || i >= 5) return false; L = 3L * G + 2 * (c - tail_lo) + (i - 3); }
        if (L >= nwg) return false;
        int wgid = (int)L; { const int q = nwg / NXCD, r = nwg % NXCD, xcd = wgid % NXCD, off = wgid / NXCD; wgid = (xcd < r ? xcd * (q + 1) : r * (q + 1) + (xcd - r) * q) + off; }
        const int nig = WGM * nN, gid = wgid / nig, fm = gid * WGM, gsz = (nM - fm) < WGM ? (nM - fm) : WGM;
        u.pm = fm + ((wgid % nig) % gsz); u.pn = (wgid % nig) / gsz; u.e = 0; u.mt = 0; u.part = 0; return true;
    }
};

typedef int v8i32_t __attribute__((ext_vector_type(8)));
typedef int v4i32_t __attribute__((ext_vector_type(4)));
__device__ __forceinline__ v8i32_t cat8(const bf16x8& a, const bf16x8& b) { const v4i32_t x = __builtin_bit_cast(v4i32_t, a), y = __builtin_bit_cast(v4i32_t, b); return __builtin_shufflevector(x, y, 0, 1, 2, 3, 4, 5, 6, 7); }
template <bool PERM, bool ALIGN_EPI, bool FP8, class Sched, class Epi>
__device__ __forceinline__ void gemm_phase(LAS unsigned char* lds, const int KB, const Sched& S, const Epi& E) {
    const int tid = threadIdx.x, wid = __builtin_amdgcn_readfirstlane(tid >> 6), lane = tid & 63, wr = wid >> 2, wc = wid & 3, fr = lane & 15, fq = lane >> 4;
    const int nt = KB / 128;
    int R[2], C2[2]; unsigned voffB[2];
#pragma unroll
    for (int i = 0; i < 2; ++i) { int r_, c_; stage_rc(tid * 16 + i * 8192, r_, c_); R[i] = r_; C2[i] = c_ * 2; const int Rb = PERM ? ((r_ & ~31) + perm32(r_ & 31)) : r_; voffB[i] = (unsigned)(Rb * KB + c_ * 2); }
    const size_t kstep = (size_t)(BK * 2);
    const size_t hstepB = (size_t)HALF * KB;
    const unsigned ldsw = (unsigned)wid * 1024u;
    const int aoff = lds_byte(wr * 64 + fr, fq * 8), boff = lds_byte(wc * 32 + fr, fq * 8);
#define PG8_SA(b, h) (((b) * 2 + (h)) * HTB)
#define PG8_SB(b, h) ((4 + (b) * 2 + (h)) * HTB)
#define PG8_STAGE_B(bufoff, gbase) do { _Pragma("unroll") for (int _i = 0; _i < 2; ++_i) \
        __builtin_amdgcn_global_load_lds((const unsigned*)((const char*)(gbase) + voffB[_i]), (LAS unsigned*)(lds + (bufoff) + ldsw + _i * 8192), 16, 0, 0); } while (0)
#define PG8_STAGE_A(bufoff, gbase, o0, o1) do { \
        __builtin_amdgcn_global_load_lds((const unsigned*)((const char*)(gbase) + (o0)), (LAS unsigned*)(lds + (bufoff) + ldsw), 16, 0, 0); \
        __builtin_amdgcn_global_load_lds((const unsigned*)((const char*)(gbase) + (o1)), (LAS unsigned*)(lds + (bufoff) + ldsw + 8192), 16, 0, 0); } while (0)
#define PG8_LDA(dst, b, h) do { _Pragma("unroll") for (int m = 0; m < 4; ++m) { const LAS unsigned char* p_ = lds + PG8_SA(b, h) + aoff + m * 2048; \
        dst[m] = __builtin_shufflevector(*(const LAS v4i32_t*)p_, *(const LAS v4i32_t*)(p_ + 1024), 0, 1, 2, 3, 4, 5, 6, 7); } } while (0)
#define PG8_LDB(dst, b, h) do { _Pragma("unroll") for (int n = 0; n < 2; ++n) { const LAS unsigned char* p_ = lds + PG8_SB(b, h) + boff + n * 2048; \
        dst[n] = __builtin_shufflevector(*(const LAS v4i32_t*)p_, *(const LAS v4i32_t*)(p_ + 1024), 0, 1, 2, 3, 4, 5, 6, 7); } } while (0)
#define PG8_LO(v) __builtin_bit_cast(bf16x8, __builtin_shufflevector(v, v, 0, 1, 2, 3))
#define PG8_HI(v) __builtin_bit_cast(bf16x8, __builtin_shufflevector(v, v, 4, 5, 6, 7))
#define PG8_MMA(ai, bj, At, Bt) do { __builtin_amdgcn_s_setprio(1); _Pragma("unroll") for (int m = 0; m < 4; ++m) _Pragma("unroll") for (int n = 0; n < 2; ++n) { \
        if constexpr (FP8) asm volatile("v_mfma_scale_f32_16x16x128_f8f6f4 %0, %1, %2, %0, %3, %3 op_sel_hi:[0,0,0]" : "+v"(acc[ai][bj][m][n]) : "v"(Bt[n]), "v"(At[m]), "v"(one_scale)); \
        else { acc[ai][bj][m][n] = __builtin_amdgcn_mfma_f32_16x16x32_bf16(PG8_LO(Bt[n]), PG8_LO(At[m]), acc[ai][bj][m][n], 0, 0, 0); \
               acc[ai][bj][m][n] = __builtin_amdgcn_mfma_f32_16x16x32_bf16(PG8_HI(Bt[n]), PG8_HI(At[m]), acc[ai][bj][m][n], 0, 0, 0); } } \
        __builtin_amdgcn_s_setprio(0); } while (0)
#define PG8_WAIT_V(n) asm volatile("s_waitcnt vmcnt(" #n ")" ::: "memory")
#define PG8_WAIT_L(n) asm volatile("s_waitcnt lgkmcnt(" #n ")" ::: "memory")
#define PG8_BAR __builtin_amdgcn_s_barrier()
#define PG8_SCHED __builtin_amdgcn_sched_barrier(0)
    Unit cur, nxt; int ui = 0;
    if (!S.next(0, cur)) return;
    f32x4 acc[2][2][4][2];
#pragma unroll
    for (int a = 0; a < 2; ++a)
#pragma unroll
        for (int b = 0; b < 2; ++b)
#pragma unroll
            for (int m = 0; m < 4; ++m)
#pragma unroll
                for (int n = 0; n < 2; ++n) acc[a][b][m][n] = (f32x4){0.f, 0.f, 0.f, 0.f};
    v8i32_t At[4], B0[2], B1[2];
    const int one_scale = 0x7f7f7f7f;
    const char* cA = S.a_base(cur); const char* cB = S.b_base(cur);
    LAS unsigned char* const eslot0 = lds + STAGE_BYTES;
    if (wid == 0) E.prefetch(cur, eslot0, lane);
    if constexpr (Sched::GATHER) { if (wid == 0) S.rows_prefetch(cur, eslot0 + 2048, lane); asm volatile("s_waitcnt vmcnt(0)" ::: "memory"); __syncthreads(); }
    unsigned oA00 = S.a_off(cur, R[0], eslot0 + 2048) + C2[0], oA01 = S.a_off(cur, R[1], eslot0 + 2048) + C2[1], oA10 = S.a_off(cur, HALF + R[0], eslot0 + 2048) + C2[0], oA11 = S.a_off(cur, HALF + R[1], eslot0 + 2048) + C2[1];
    PG8_STAGE_B(PG8_SB(0, 0), cB); PG8_STAGE_B(PG8_SB(0, 1), cB + hstepB); PG8_STAGE_A(PG8_SA(0, 0), cA, oA00, oA01); PG8_STAGE_A(PG8_SA(0, 1), cA, oA10, oA11);
    if (wr == 1) PG8_BAR;
    PG8_WAIT_V(2); PG8_BAR;
    PG8_STAGE_B(PG8_SB(1, 0), cB + kstep); PG8_STAGE_A(PG8_SA(1, 0), cA + kstep, oA00, oA01); PG8_STAGE_B(PG8_SB(1, 1), cB + hstepB + kstep);
    PG8_WAIT_V(6); PG8_BAR;
    for (;;) {
        const bool has_next = S.next(ui + 1, nxt);
        const char* nA = has_next ? S.a_base(nxt) : cA; const char* nB = has_next ? S.b_base(nxt) : cB;
        LAS unsigned char* const nrows = eslot0 + ((ui + 1) & 1) * 4096 + 2048;
        if constexpr (Sched::GATHER) { if (has_next && wid == 0) S.rows_prefetch(nxt, nrows, lane); }
        for (int t = 0; t < nt; t += 2) {
            const bool last = (t == nt - 2);
            const char* a1 = cA + (size_t)(t + 1) * kstep;
            const char* a2 = last ? nA : cA + (size_t)(t + 2) * kstep; const char* b2 = last ? nB : cB + (size_t)(t + 2) * kstep;
            const char* a3 = a2 + kstep; const char* b3 = b2 + kstep;
            unsigned p00 = oA00, p01 = oA01;
            if (last && has_next) { p00 = S.a_off(nxt, R[0], nrows) + C2[0]; p01 = S.a_off(nxt, R[1], nrows) + C2[1]; }
            PG8_LDB(B0, 0, 0); PG8_LDB(B1, 0, 1); PG8_SCHED; PG8_LDA(At, 0, 0); PG8_STAGE_A(PG8_SA(1, 1), a1, oA10, oA11);
            PG8_WAIT_V(8); PG8_WAIT_L(0); PG8_BAR; PG8_MMA(0, 0, At, B0); PG8_MMA(0, 1, At, B1); PG8_BAR; PG8_SCHED;
            unsigned p10 = oA10, p11 = oA11;
            if (last && has_next) { p10 = S.a_off(nxt, HALF + R[0], nrows) + C2[0]; p11 = S.a_off(nxt, HALF + R[1], nrows) + C2[1]; }
            PG8_LDA(At, 0, 1); PG8_STAGE_B(PG8_SB(0, 0), b2); PG8_STAGE_B(PG8_SB(0, 1), b2 + hstepB); PG8_STAGE_A(PG8_SA(0, 0), a2, p00, p01);
            PG8_WAIT_V(8); PG8_WAIT_L(0); PG8_BAR; PG8_MMA(1, 0, At, B0); PG8_MMA(1, 1, At, B1); PG8_BAR; PG8_SCHED;
            PG8_LDB(B0, 1, 0); PG8_LDB(B1, 1, 1); PG8_SCHED; PG8_LDA(At, 1, 0); PG8_STAGE_A(PG8_SA(0, 1), a2, p10, p11);
            PG8_WAIT_V(8); PG8_WAIT_L(0); PG8_BAR; PG8_MMA(0, 0, At, B0); PG8_MMA(0, 1, At, B1); PG8_BAR; PG8_SCHED;
            PG8_LDA(At, 1, 1); PG8_STAGE_B(PG8_SB(1, 0), b3); PG8_STAGE_B(PG8_SB(1, 1), b3 + hstepB); PG8_STAGE_A(PG8_SA(1, 0), a3, p00, p01);
            PG8_WAIT_V(8); PG8_WAIT_L(0); PG8_BAR; PG8_MMA(1, 0, At, B0); PG8_MMA(1, 1, At, B1); PG8_BAR; PG8_SCHED;
            if (last) { oA00 = p00; oA01 = p01; oA10 = p10; oA11 = p11; }
        }
        if constexpr (ALIGN_EPI) { if (wr == 0) PG8_BAR; }
        if constexpr (FP8) asm volatile("s_nop 15\n\ts_nop 7" ::: "memory");
        const bool zero = E(acc, cur, wr, wc, fr, fq, eslot0 + (ui & 1) * 4096);
        if (!has_next) break;
        if (zero) {
#pragma unroll
            for (int a = 0; a < 2; ++a)
#pragma unroll
                for (int b = 0; b < 2; ++b)
#pragma unroll
                    for (int m = 0; m < 4; ++m)
#pragma unroll
                        for (int n = 0; n < 2; ++n) acc[a][b][m][n] = (f32x4){0.f, 0.f, 0.f, 0.f};
        }
        cur = nxt; cA = nA; cB = nB; ++ui;
        if (wid == 0) E.prefetch(cur, eslot0 + (ui & 1) * 4096, lane);
        if constexpr (ALIGN_EPI) { if (wr == 1) PG8_BAR; }
    }
    PG8_WAIT_V(0);
    if constexpr (!ALIGN_EPI) { if (wr == 0) PG8_BAR; }
    PG8_BAR;
#undef PG8_SA
#undef PG8_SB
#undef PG8_STAGE_A
#undef PG8_STAGE_B
#undef PG8_LDA
#undef PG8_LDB
#undef PG8_MMA
#undef PG8_LO
#undef PG8_HI
#undef PG8_WAIT_V
#undef PG8_WAIT_L
#undef PG8_BAR
#undef PG8_SCHED
}
}
using pg8::Unit;

#define XB_TMO      128
#define XB_XCNT(j)  (256  + 64 * (j))
#define XB_XSUB(j)  (1280 + 64 * (j))
#define XB_XGEN(j)  (2304 + 64 * (j))
#define XB_TOP      3328
#define XB_TOPGEN   3392
#define XCD_BAR_WORDS 3456
#define XB_SPIN_CAP (1u << 18)
__device__ __forceinline__ unsigned xb_ld(unsigned* p)              { return __hip_atomic_load(p, __ATOMIC_RELAXED, __HIP_MEMORY_SCOPE_AGENT); }
__device__ __forceinline__ unsigned xb_add(unsigned* p, unsigned v) { return __hip_atomic_fetch_add(p, v, __ATOMIC_RELAXED, __HIP_MEMORY_SCOPE_AGENT); }
__device__ __forceinline__ unsigned xb_xcc_id() { return (unsigned)__builtin_amdgcn_s_getreg((3 << 11) | 20) & 0xFu; }
#define XB_SPIN(cond, bar) do { unsigned _sp = 0; while (cond) { __builtin_amdgcn_s_sleep(1); \
    if ((++_sp & 255u) == 0u) { if (xb_ld(&(bar)[XB_TMO])) break; if (_sp > XB_SPIN_CAP) { atomicAdd(&(bar)[XB_TMO], 1u); break; } } } } while (0)
struct XcdBarrier { unsigned* bar; unsigned x; volatile LAS unsigned* st; };
__device__ __forceinline__ XcdBarrier xcd_barrier_post(unsigned* bar, volatile LAS unsigned* st) {
    XcdBarrier b; b.bar = bar; b.x = xb_xcc_id(); b.st = st;
    if (threadIdx.x == 0) (void)xb_add(&bar[XB_XCNT(b.x)], 1u);
    return b;
}
__device__ __forceinline__ void xcd_barrier_complete(unsigned* bar, unsigned x, unsigned& nloc, unsigned& nx) {
    const unsigned G = gridDim.x * gridDim.y * gridDim.z;
    unsigned sum, cnt, mine, sp = 0u;
    for (;;) {
        sum = 0u; cnt = 0u; mine = 0u;
#pragma unroll
        for (unsigned j = 0; j < 16; ++j) { const unsigned c = xb_ld(&bar[XB_XCNT(j)]); sum += c; cnt += (c > 0u) ? 1u : 0u; mine = (j == x) ? c : mine; }
        if (sum == G) break;
        __builtin_amdgcn_s_sleep(1);
        if ((++sp & 255u) == 0u) { if (xb_ld(&bar[XB_TMO])) break; if (sp > XB_SPIN_CAP) { atomicAdd(&bar[XB_TMO], 1u); break; } }
    }
    nloc = mine > 0u ? mine : 1u; nx = cnt > 0u ? cnt : 1u;
}
__device__ __forceinline__ void xcd_barrier(const XcdBarrier& b) {
    asm volatile("s_waitcnt vmcnt(0)" ::: "memory");
    __syncthreads();
    if (threadIdx.x == 0) {
        unsigned* bar = b.bar;
        __builtin_amdgcn_s_waitcnt(0);
        unsigned nloc = b.st[0], nx = b.st[1];
        if (nloc == 0u) { xcd_barrier_complete(bar, b.x, nloc, nx); b.st[0] = nloc; b.st[1] = nx; }
        const unsigned old = xb_add(&bar[XB_XSUB(b.x)], 1u);
        const unsigned gen = old / nloc;
        if (old + 1u == (gen + 1u) * nloc) {
            __builtin_amdgcn_fence(__ATOMIC_RELEASE, "agent");
            asm volatile("s_waitcnt vmcnt(0)" ::: "memory");
            const unsigned og = xb_add(&bar[XB_TOP], 1u);
            const unsigned tg = og / nx;
            if (og + 1u == (tg + 1u) * nx) xb_add(&bar[XB_TOPGEN], 1u);
            else XB_SPIN(xb_ld(&bar[XB_TOPGEN]) == tg, bar);
            __builtin_amdgcn_fence(__ATOMIC_ACQUIRE, "agent");
            xb_add(&bar[XB_XGEN(b.x)], 1u);
            asm volatile("s_waitcnt vmcnt(0)" ::: "memory");
        } else {
            XB_SPIN(xb_ld(&bar[XB_XGEN(b.x)]) == gen, bar);
            __builtin_amdgcn_fence(__ATOMIC_ACQUIRE, "agent");
            asm volatile("s_waitcnt vmcnt(0)" ::: "memory");
        }
    }
    __syncthreads();
}

struct Args { const float* in[17]; float* out; unsigned char* ws; int ph_lo, ph_hi, li, pad; };
struct Frame {
    LAS unsigned char* lds;
    int tid, lane, wave, G, vcu;
    unsigned char* ws;
};

struct MapId { __device__ __forceinline__ int operator()(int n) const { return n; } };
struct MapWin { __device__ __forceinline__ int operator()(int n) const {
    const int tile = n >> 8, bj = (n >> 7) & 1;
    if (tile == 6 || tile == 7 || (tile == 8 && bj == 0)) {
        const int hb = n & ~127, p = n & 127, wc = p >> 5, fq = (p >> 3) & 3, nn = (p >> 2) & 1, e = p & 3;
        return hb + 64 * (wc >> 1) + 32 * nn + 16 * (wc & 1) + 4 * fq + e;
    }
    return n; } };
struct MapGate { __device__ __forceinline__ int operator()(int n) const { return C_GA + 1024 * ((n >> 7) & 1) + 128 * (n >> 8) + (n & 127); } };
struct MapY16 { __device__ __forceinline__ int operator()(int n) const { const int p = n & 255, bj = p >> 7, wc = (p >> 5) & 3, fq = (p >> 3) & 3, j = p & 7; return (n & ~255) + 64 * wc + 16 * fq + 8 * bj + j; } };
struct MapW1 { __device__ __forceinline__ int operator()(int n) const { const int pn = n >> 8, r = n & 255; return 1024 * (r >> 7) + 128 * pn + (r & 127); } };

template <class Map>
__device__ __forceinline__ void p0_transpose_item(const float* W, int K, int N, bf16_t* WT, LAS float* scr, int item, int lane, const Map& map, const float* kscale, int ncols = 0) {
    const int nblk = (ncols ? ncols : N) / 64, kb = item / nblk, nb = item % nblk, k0 = 64 * kb, n0 = 64 * nb;
    const int srcc = map(n0 + 4 * (lane & 15));
    f32x4 v[16];
#pragma unroll
    for (int i = 0; i < 16; ++i) v[i] = *(const f32x4*)(W + (size_t)(k0 + 4 * i + (lane >> 4)) * N + srcc);
    if (kscale) {
#pragma unroll
        for (int i = 0; i < 16; ++i) v[i] = v[i] * kscale[k0 + 4 * i + (lane >> 4)];
    }
#pragma unroll
    for (int i = 0; i < 16; ++i) *(LAS f32x4*)(scr + (4 * i + (lane >> 4)) * 68 + 4 * (lane & 15)) = v[i];
    asm volatile("s_waitcnt lgkmcnt(0)" ::: "memory");
    const int kc = lane & 7, ngl = lane >> 3;
#pragma unroll
    for (int pp = 0; pp < 2; ++pp) {
        const int ng = 8 * pp + ngl; f32x4 r[8];
#pragma unroll
        for (int j = 0; j < 8; ++j) r[j] = *(const LAS f32x4*)(scr + (8 * kc + j) * 68 + 4 * ng);
#pragma unroll
        for (int e = 0; e < 4; ++e) { u32x4 o; o.x = pk2(r[0][e], r[1][e]); o.y = pk2(r[2][e], r[3][e]); o.z = pk2(r[4][e], r[5][e]); o.w = pk2(r[6][e], r[7][e]);
            *(u32x4*)(WT + (size_t)(n0 + 4 * ng + e) * K + k0 + 8 * kc) = o; }
    }
    asm volatile("s_waitcnt lgkmcnt(0)" ::: "memory");
}

template <class Map>
__device__ __forceinline__ void p0_transpose_item_fp8(const float* W, int K, int N, unsigned char* WT, LAS float* scr, int item, int lane, const Map& map, const float* kscale, float scale, int pitch = 0) {
    if (pitch == 0) pitch = N;
    const int nblk = N / 32, kb = item / nblk, nb = item % nblk, k0 = 128 * kb, n0 = 32 * nb;
    const int srcc = map(n0 + 4 * (lane & 7));
    f32x4 v[16];
#pragma unroll
    for (int i = 0; i < 16; ++i) v[i] = *(const f32x4*)(W + (size_t)(k0 + 8 * i + (lane >> 3)) * pitch + srcc);
#pragma unroll
    for (int i = 0; i < 16; ++i) v[i] = v[i] * (kscale ? kscale[k0 + 8 * i + (lane >> 3)] * scale : scale);
#pragma unroll
    for (int i = 0; i < 16; ++i) *(LAS f32x4*)(scr + (8 * i + (lane >> 3)) * 36 + 4 * (lane & 7)) = v[i];
    asm volatile("s_waitcnt lgkmcnt(0)" ::: "memory");
    const int kc = lane & 15, ngl = lane >> 4;
#pragma unroll
    for (int pp = 0; pp < 2; ++pp) {
        const int ng = 4 * pp + ngl; f32x4 r[8];
#pragma unroll
        for (int j = 0; j < 8; ++j) r[j] = *(const LAS f32x4*)(scr + (8 * kc + j) * 36 + 4 * ng);
#pragma unroll
        for (int e = 0; e < 4; ++e) { u32x2 o; o.x = pk4_fp8(r[0][e], r[1][e], r[2][e], r[3][e]); o.y = pk4_fp8(r[4][e], r[5][e], r[6][e], r[7][e]);
            *(u32x2*)(WT + (size_t)(n0 + 4 * ng + e) * K + k0 + 8 * kc) = o; }
    }
    asm volatile("s_waitcnt lgkmcnt(0)" ::: "memory");
}

struct F8Item { const float* W; unsigned char* WT; int K, N, k0, n0, srcc; f32x4 ks0, ks1; };
template <class Map> __device__ __forceinline__ void f8_item_load(F8Item& I, const float* W, int K, int N, unsigned char* WT, int item, int lane, const Map& map, const float* kscale, f32x4 (&v)[16]) {
    const int nblk = N / 32, kb = item / nblk, nb = item % nblk;
    I.W = W; I.WT = WT; I.K = K; I.N = N; I.k0 = 128 * kb; I.n0 = 32 * nb; I.srcc = map(I.n0 + 4 * (lane & 7));
    if (kscale) { const float* kp = kscale + I.k0 + 8 * (lane & 15); I.ks0 = *(const f32x4*)kp; I.ks1 = *(const f32x4*)(kp + 4); }
    else { I.ks0 = (f32x4){1.f, 1.f, 1.f, 1.f}; I.ks1 = I.ks0; }
#pragma unroll
    for (int i = 0; i < 16; ++i) v[i] = *(const f32x4*)(W + (size_t)(I.k0 + 8 * i + (lane >> 3)) * N + I.srcc);
}
__device__ __forceinline__ void f8_item_finish(const F8Item& I, LAS float* scr, int lane, f32x4 (&v)[16], float scale) {
#pragma unroll
    for (int i = 0; i < 16; ++i) *(LAS f32x4*)(scr + (8 * i + (lane >> 3)) * 36 + 4 * (lane & 7)) = v[i];
    asm volatile("s_waitcnt lgkmcnt(0)" ::: "memory");
    const int kc = lane & 15, ngl = lane >> 4;
    const f32x4 s0 = I.ks0 * scale, s1 = I.ks1 * scale;
#pragma unroll
    for (int pp = 0; pp < 2; ++pp) {
        const int ng = 4 * pp + ngl; f32x4 r[8];
#pragma unroll
        for (int j = 0; j < 8; ++j) r[j] = *(const LAS f32x4*)(scr + (8 * kc + j) * 36 + 4 * ng) * (j < 4 ? s0[j] : s1[j - 4]);
#pragma unroll
        for (int e = 0; e < 4; ++e) { u32x2 o; o.x = pk4_fp8(r[0][e], r[1][e], r[2][e], r[3][e]); o.y = pk4_fp8(r[4][e], r[5][e], r[6][e], r[7][e]);
            *(u32x2*)(I.WT + (size_t)(I.n0 + 4 * ng + e) * I.K + I.k0 + 8 * kc) = o; }
    }
    asm volatile("s_waitcnt lgkmcnt(0)" ::: "memory");
}

__device__ __forceinline__ void p0_prologue(Frame& F, const Args& a) {
    LAS float* scr = (LAS float*)(F.lds + F.wave * 18432);
    const int gw = F.vcu * NWAVES + F.wave, NGW = F.G * NWAVES;
    const float* w_in = a.in[2]; const float* w_up_a = a.in[6]; const float* w_up_b = a.in[7]; const float* w_out = a.in[8];
    const float* w1 = a.in[12]; const float* w2 = a.in[14]; const float* g2 = a.in[9];
    bf16_t* Win_t = (bf16_t*)(F.ws + WS_WIN); bf16_t* Wa_t = (bf16_t*)(F.ws + WS_WA); bf16_t* Wb_t = (bf16_t*)(F.ws + WS_WB); bf16_t* Wout_t = (bf16_t*)(F.ws + WS_WOUT);
    unsigned char* W1_t = (unsigned char*)(F.ws + WS_W1); unsigned char* W2_t = (unsigned char*)(F.ws + WS_W2);
    constexpr int I_IN = (D / 64) * (C_GA / 64), I_G8 = (D / 128) * (2048 / 32), I_UP = (512 / 64) * (D / 64), I_OUT = (D / 64) * (D / 64), I_W1 = (D / 128) * (2 * FF / 32), I_W2 = (FF / 128) * (D / 32);
        constexpr int NSMALL = I_IN + I_G8 + 2 * I_UP + I_OUT, NEXPERT = NEXP * (I_W1 + I_W2);
    for (int it = gw; it < NSMALL; it += NGW) {
        int r = it;
        if (r < I_IN) { p0_transpose_item(w_in, D, DIN, Win_t, scr, r, F.lane, MapWin(), nullptr, C_GA); continue; } r -= I_IN;
        if (r < I_G8) { p0_transpose_item_fp8(w_in, D, 2048, (unsigned char*)(F.ws + WS_WING8), scr, r, F.lane, MapGate(), nullptr, F8_W, DIN); continue; } r -= I_G8;
        if (r < I_UP) { p0_transpose_item(w_up_a, 512, D, Wa_t, scr, r, F.lane, MapId(), nullptr); continue; } r -= I_UP;
        if (r < I_UP) { p0_transpose_item(w_up_b, 512, D, Wb_t, scr, r, F.lane, MapId(), nullptr); continue; } r -= I_UP;
        p0_transpose_item(w_out, D, D, Wout_t, scr, r, F.lane, MapId(), nullptr);
    }
#define F8_LOAD(I_, V_, r_) do { const int rr_ = (r_); const bool w1_ = rr_ < NEXP * I_W1; const int r2_ = w1_ ? rr_ : rr_ - NEXP * I_W1; \
        const int e_ = w1_ ? r2_ / I_W1 : r2_ / I_W2, q_ = w1_ ? r2_ % I_W1 : r2_ % I_W2, N_ = w1_ ? 2 * FF : D, nblk_ = N_ / 32, kb_ = q_ / nblk_, nb_ = q_ % nblk_; \
        I_.W = w1_ ? w1 + (size_t)e_ * D * 2 * FF : w2 + (size_t)e_ * FF * D; I_.WT = w1_ ? W1_t + (size_t)e_ * 2 * FF * D : W2_t + (size_t)e_ * D * FF; \
        I_.K = D; I_.N = N_; I_.k0 = 128 * kb_; I_.n0 = 32 * nb_; { const int n_ = I_.n0 + 4 * (F.lane & 7); I_.srcc = w1_ ? MapW1()(n_) : MapY16()(n_); } \
        { const float* kp_ = g2 + I_.k0 + 8 * (F.lane & 15); const f32x4 k0_ = *(const f32x4*)kp_, k1_ = *(const f32x4*)(kp_ + 4); const f32x4 one_ = {1.f, 1.f, 1.f, 1.f}; \
          I_.ks0 = w1_ ? k0_ : one_; I_.ks1 = w1_ ? k1_ : one_; } \
        _Pragma("unroll") for (int i_ = 0; i_ < 16; ++i_) V_[i_] = *(const f32x4*)(I_.W + (size_t)(I_.k0 + 8 * i_ + (F.lane >> 3)) * N_ + I_.srcc); } while (0)
    {
        static_assert(D == FF && (NEXP * ((D / 128) * (2 * FF / 32) + (FF / 128) * (D / 32))) % 16 == 0, "expert items: K = 1024 for both weight sets, item count a multiple of the waves per block");
        F8Item IA, IB; f32x4 va[16], vb[16];
        constexpr int NPAIR = NEXPERT / 2;
        int r = gw;
        if (r < NPAIR) {
            F8_LOAD(IA, va, 2 * r);
#pragma unroll 1
            for (;;) {
                __builtin_amdgcn_s_barrier(); F8_LOAD(IB, vb, 2 * r + 1);
                f8_item_finish(IA, scr, F.lane, va, F8_W);
                const bool hn = r + NGW < NPAIR; __builtin_amdgcn_s_barrier(); F8_LOAD(IA, va, hn ? 2 * (r + NGW) : 2 * r + 1);
                f8_item_finish(IB, scr, F.lane, vb, F8_W);
                if (!hn) break;
                r += NGW;
            }
        }
    }
#undef F8_LOAD
    const float* x = a.in[0]; const float* g1 = a.in[1]; bf16_t* H1 = (bf16_t*)(F.ws + WS_H1);
    f32x4 gv[4];
#pragma unroll
    for (int j = 0; j < 4; ++j) gv[j] = *((const f32x4*)g1 + F.lane + 64 * j);
    for (int m = 2 * gw; m < T; m += 2 * NGW) {
        const f32x4* xr = (const f32x4*)(x + (size_t)m * D) + F.lane;
        f32x4 v[2][4]; float s[2] = {0.f, 0.f};
#pragma unroll
        for (int q = 0; q < 2; ++q)
#pragma unroll
            for (int j = 0; j < 4; ++j) v[q][j] = xr[q * 256 + 64 * j];
#pragma unroll
        for (int q = 0; q < 2; ++q)
#pragma unroll
            for (int j = 0; j < 4; ++j) s[q] += (v[q][j].x * v[q][j].x + v[q][j].y * v[q][j].y) + (v[q][j].z * v[q][j].z + v[q][j].w * v[q][j].w);
#pragma unroll
        for (int q = 0; q < 2; ++q) {
            const float rstd = 1.0f / sqrtf(wave_sum(s[q]) * (1.f / D) + RMS_EPS);
            u32x2* o8 = (u32x2*)(H1 + (size_t)(m + q) * D) + F.lane; unsigned* o4 = (unsigned*)(F.ws + WS_H1Q + (size_t)(m + q) * D) + F.lane;
#pragma unroll
            for (int j = 0; j < 4; ++j) { const f32x4 hv = v[q][j] * rstd * gv[j]; u32x2 w; w.x = pk2(hv.x, hv.y); w.y = pk2(hv.z, hv.w); o8[64 * j] = w;
                o4[64 * j] = pk4_fp8(hv.x * F8_ACT, hv.y * F8_ACT, hv.z * F8_ACT, hv.w * F8_ACT); }
        }
    }
    float* rope = (float*)(F.ws + WS_ROPE);
    for (int idx = (F.vcu * NTHREADS + F.tid); idx < SEQ * 32; idx += F.G * NTHREADS) {
        const int pos = idx >> 5, i = idx & 31;
        const float invf = (float)exp2(-(double)i * (13.287712379549449 / 32.0));
        const float ang = (float)pos * invf;
        double rev = (double)ang * 0.15915494309189535; rev -= floor(rev);
        const float rv = (float)rev;
        rope[2 * idx] = __builtin_amdgcn_cosf(rv); rope[2 * idx + 1] = __builtin_amdgcn_sinf(rv);
    }
    float* bt = (float*)(F.ws + WS_BT); const float* rpb = a.in[4];
    for (int idx = (F.vcu * NTHREADS + F.tid); idx < 8 * 4 * 15 * 2 * 64 * 4; idx += F.G * NTHREADS) {
        const int reg = idx & 3, ln = (idx >> 2) & 63, hf = (idx >> 8) & 1; int rest = idx >> 9; const int dr = rest % 15; rest /= 15; const int gq = rest & 3, h = rest >> 2;
        const int c = 16 * gq + (ln & 15), base = (gq == 0) ? 0 : (gq == 1) ? 8 : (gq == 2) ? 24 : 32, kc = base + 16 * hf + 4 * (ln >> 4) + reg;
        const int cs = min(max(c - 8, 0), 48);
        bt[idx] = (kc >= cs && kc < cs + 16) ? rpb[h * 465 + dr * 31 + (kc - c + 15)] * LOG2E : -INFINITY;
    }
}

struct DenseSched {
    pg8::StaticOrder so; const char* A; unsigned lda; const char* Bt; int K;
    __device__ __forceinline__ bool next(int i, Unit& u) const { return so.next(i, u); }
    __device__ __forceinline__ const char* a_base(const Unit& u) const { return A + (size_t)u.pm * 256 * lda; }
    static constexpr bool GATHER = false;
    __device__ __forceinline__ unsigned a_off(const Unit&, int rho, const LAS unsigned char*) const { return (unsigned)rho * lda; }
    __device__ __forceinline__ const char* b_base(const Unit& u) const { return Bt + (size_t)u.pn * 256 * K; }
};
struct UpSched {
    pg8::StaticOrder so; const char* OA; const char* OB; const char* Wa; const char* Wb;
    __device__ __forceinline__ bool next(int i, Unit& u) const { const bool ok = so.next(i >> 1, u); u.part = i & 1; return ok; }
    __device__ __forceinline__ const char* a_base(const Unit& u) const { return (u.part ? OB : OA) + (size_t)u.pm * 256 * 1024; }
    static constexpr bool GATHER = false;
    __device__ __forceinline__ unsigned a_off(const Unit&, int rho, const LAS unsigned char*) const { return (unsigned)rho * 1024u; }
    __device__ __forceinline__ const char* b_base(const Unit& u) const { return (u.part ? Wb : Wa) + (size_t)u.pn * 256 * 512 * 2; }
};
template <bool GATHER_> struct MoeSched {
    static constexpr bool GATHER = GATHER_;
    const LAS int* tstart; const LAS int* cnt; const LAS unsigned char* t2e; int G, vcu, log_mt, total;
    const char* A; const int* list; const char* Bt; size_t b_estride; int K;
    __device__ __forceinline__ bool next(int i, Unit& u) const {
        const int L = i * G + vcu; const int blk = L >> 5, w = L & 31;
        const int mtg = (blk << log_mt) + (w & ((1 << log_mt) - 1)), pn = w >> log_mt;
        if (mtg >= total) return false;
        const int e = t2e[mtg];
        u.e = __builtin_amdgcn_readfirstlane(e); u.pm = __builtin_amdgcn_readfirstlane(mtg); u.mt = __builtin_amdgcn_readfirstlane(mtg - tstart[e]); u.pn = __builtin_amdgcn_readfirstlane(pn); u.part = 0; return true;
    }
    __device__ __forceinline__ const char* a_base(const Unit& u) const { return GATHER ? A : A + (size_t)u.pm * 256 * 1024; }
    __device__ __forceinline__ void rows_prefetch(const Unit& u, LAS unsigned char* dst, int lane) const {
        __builtin_amdgcn_global_load_lds((const unsigned*)(list + (size_t)u.e * LISTCAP + u.mt * 256 + 4 * lane), (LAS unsigned*)dst, 16, 0, 0); }
    __device__ __forceinline__ unsigned a_off(const Unit& u, int rho, const LAS unsigned char* rows) const {
        if (!GATHER) return (unsigned)rho * 1024u;
        const int tk = ((const LAS int*)rows)[rho];
        return (u.mt * 256 + rho < cnt[u.e]) ? (unsigned)(tk >> 2) * 1024u : 0u;
    }
    __device__ __forceinline__ const char* b_base(const Unit& u) const { return Bt + (size_t)u.e * b_estride + (size_t)u.pn * 256 * K; }
};

__device__ __forceinline__ size_t hm_off(int t, int nh, int h, int d) { return ((size_t)((t >> 13) * nh + h) * SEQ + (t & (SEQ - 1))) * 64 + d; }
struct EpiInProj {
    unsigned char* ws; const float* bias; const float* rope;
    __device__ __forceinline__ void prefetch(const Unit& u, LAS unsigned char* es, int lane) const {
        __builtin_amdgcn_global_load_lds((const unsigned*)(bias + 256 * u.pn + 4 * lane), (LAS unsigned*)es, 16, 0, 0); }
    __device__ __forceinline__ bool operator()(f32x4 (&acc)[2][2][4][2], const Unit& u, int wr, int wc, int fr, int fq, const LAS unsigned char* es) const {
        const int pn = u.pn; const int row0 = u.pm * 256 + wr * 64 + fr;
#pragma unroll
        for (int bj = 0; bj < 2; ++bj) {
            const bool rp = (pn == 6 || pn == 7 || (pn == 8 && bj == 0));
            const int hb = 256 * pn + 128 * bj;
            if (rp) {
                const int Lb = hb + 64 * (wc >> 1) + 16 * (wc & 1) + 4 * fq, i0 = 16 * (wc & 1) + 4 * fq;
                const LAS float* bl = (const LAS float*)es - 256 * pn;
                const f32x4 b1v = *(const LAS f32x4*)(bl + Lb), b2v = *(const LAS f32x4*)(bl + Lb + 32);
                const float sc = (pn <= 7) ? QSCALE : 1.0f;
                bf16_t* dst = (bf16_t*)(ws + (pn <= 7 ? WS_QB : WS_KB)); const int nh = (pn <= 7) ? 8 : 2; const int cl = Lb - (pn <= 7 ? C_QB : C_KB);
#pragma unroll
                for (int ai = 0; ai < 2; ++ai) {
                    f32x4 cs0a[4], cs1a[4];
#pragma unroll
                    for (int m = 0; m < 4; ++m) { const int pos = (row0 + ai * 128 + m * 16) & (SEQ - 1);
                        cs0a[m] = *(const f32x4*)(rope + (size_t)(pos * 32 + i0) * 2); cs1a[m] = *(const f32x4*)(rope + (size_t)(pos * 32 + i0) * 2 + 4); }
                    asm volatile("" ::: "memory");
#pragma unroll
                    for (int m = 0; m < 4; ++m) {
                        const int row = row0 + ai * 128 + m * 16;
                        const f32x4 cs0 = cs0a[m], cs1 = cs1a[m];
                        const f32x4 x1 = acc[ai][bj][m][0] + b1v, x2 = acc[ai][bj][m][1] + b2v;
                        const float c[4] = {cs0.x, cs0.z, cs1.x, cs1.z}, s[4] = {cs0.y, cs0.w, cs1.y, cs1.w};
                        float o1[4], o2[4];
#pragma unroll
                        for (int e = 0; e < 4; ++e) { o1[e] = (x1[e] * c[e] - x2[e] * s[e]) * sc; o2[e] = (x2[e] * c[e] + x1[e] * s[e]) * sc; }
                        bf16_t* rp_ = dst + hm_off(row, nh, cl >> 6, cl & 63);
                        u32x2 w1; w1.x = pk2(o1[0], o1[1]); w1.y = pk2(o1[2], o1[3]); *(u32x2*)rp_ = w1;
                        u32x2 w2; w2.x = pk2(o2[0], o2[1]); w2.y = pk2(o2[2], o2[3]); *(u32x2*)(rp_ + 32) = w2;
                    }
                }
            } else {
                const int c0 = hb + 32 * wc + 8 * fq;
                const LAS float* bl = (const LAS float*)es - 256 * pn;
                const f32x4 b0 = *(const LAS f32x4*)(bl + c0), b1 = *(const LAS f32x4*)(bl + c0 + 4);
                const int mode = (pn <= 1) ? 1 : (pn >= 9 ? 2 : 0);
                bf16_t* dst; int nh = 8, cl;
                if (pn <= 1) { dst = (bf16_t*)(ws + WS_QA); cl = c0 - C_QA; }
                else if (pn <= 3) { dst = (bf16_t*)(ws + WS_KA); cl = c0 - C_KA; }
                else if (pn <= 5) { dst = (bf16_t*)(ws + WS_VA); cl = c0 - C_VA; }
                else if (pn == 8) { dst = (bf16_t*)(ws + WS_VB); cl = c0 - C_VB; nh = 2; }
                else { dst = (bf16_t*)(ws + WS_SG); cl = c0 - C_GA; }
#pragma unroll
                for (int ai = 0; ai < 2; ++ai)
#pragma unroll
                    for (int m = 0; m < 4; ++m) {
                        const int row = row0 + ai * 128 + m * 16;
                        f32x4 v0 = acc[ai][bj][m][0] + b0, v1 = acc[ai][bj][m][1] + b1;
                        if (mode == 1) { v0 = v0 * QSCALE; v1 = v1 * QSCALE; }
                        if (mode == 2) {
#pragma unroll
                            for (int e = 0; e < 4; ++e) { v0[e] = sigmoidf_(v0[e]); v1[e] = sigmoidf_(v1[e]); } }
                        u32x4 w; w.x = pk2(v0[0], v0[1]); w.y = pk2(v0[2], v0[3]); w.z = pk2(v1[0], v1[1]); w.w = pk2(v1[2], v1[3]);
                        bf16_t* p_ = (pn >= 9) ? dst + (size_t)row * 2048 + cl : dst + hm_off(row, nh, cl >> 6, cl & 63);
                        *(u32x4*)p_ = w;
                    }
            }
        }
        return true;
    }
};
__device__ __forceinline__ unsigned q8x4(float a, float b, float c, float d) {
    return (unsigned)a | ((unsigned)b << 8) | ((unsigned)c << 16) | ((unsigned)d << 24); }
struct EpiGate {
    unsigned char* SG; const float* bias;
    __device__ __forceinline__ void prefetch(const Unit& u, LAS unsigned char* es, int lane) const {
        const float* s = bias + C_GA + 128 * u.pn + (lane < 32 ? 4 * lane : 1024 + 4 * (lane - 32));
        __builtin_amdgcn_global_load_lds((const unsigned*)s, (LAS unsigned*)es, 16, 0, 0); }
    __device__ __forceinline__ bool operator()(f32x4 (&acc)[2][2][4][2], const Unit& u, int wr, int wc, int fr, int fq, const LAS unsigned char* es) const {
        const int row0 = u.pm * 256 + wr * 64 + fr, ch = 32 * wc + 8 * fq;
        const LAS float* bl = (const LAS float*)es + ch;
        f32x4 za_b[2], zb_b[2];
        za_b[0] = *(const LAS f32x4*)bl * -LOG2E; za_b[1] = *(const LAS f32x4*)(bl + 4) * -LOG2E; zb_b[0] = *(const LAS f32x4*)(bl + 128) * -LOG2E; zb_b[1] = *(const LAS f32x4*)(bl + 132) * -LOG2E;
#pragma unroll
        for (int ai = 0; ai < 2; ++ai)
#pragma unroll
            for (int m = 0; m < 4; ++m) {
                const int row = row0 + ai * 128 + m * 16;
                float qa[8], qb[8];
#pragma unroll
                for (int n = 0; n < 2; ++n) {
                    const f32x4 za = acc[ai][0][m][n] * (-F8_INV * LOG2E) + za_b[n], zb = acc[ai][1][m][n] * (-F8_INV * LOG2E) + zb_b[n];
#pragma unroll
                    for (int e = 0; e < 4; ++e) {
                        const float da = 1.0f + __builtin_amdgcn_exp2f(fminf(za[e], 60.0f)), db = 1.0f + __builtin_amdgcn_exp2f(fminf(zb[e], 60.0f));
                        const float r = __builtin_amdgcn_rcpf(da * db) * 255.0f;
                        qa[4 * n + e] = __builtin_fmaf(db, r, 0.5f); qb[4 * n + e] = fmaxf(__builtin_fmaf(da, r, 0.5f), 1.0f);
                    }
                }
                u32x4 w; w.x = q8x4(qa[0], qa[1], qa[2], qa[3]); w.y = q8x4(qa[4], qa[5], qa[6], qa[7]); w.z = q8x4(qb[0], qb[1], qb[2], qb[3]); w.w = q8x4(qb[4], qb[5], qb[6], qb[7]);
                *(u32x4*)(SG + (size_t)row * 2048 + 2 * (128 * u.pn + ch)) = w;
            }
        return true;
    }
};
__device__ __forceinline__ float ub(unsigned w, int i) { return (float)((w >> (8 * i)) & 0xffu); }
struct EpiUp {
    const unsigned char* P; bf16_t* Mg;
    __device__ __forceinline__ void prefetch(const Unit&, LAS unsigned char*, int) const {}
    template <int PART>
    __device__ __forceinline__ void run(f32x4 (&acc)[2][2][4][2], const Unit& u, int wr, int wc, int fr, int fq) const {
        const int row0 = u.pm * 256 + wr * 64 + fr, cb = u.pn * 256 + 32 * wc + 8 * fq;
        const unsigned char* Pp = P + (size_t)row0 * 2048 + 2 * cb;
        u32x4 g[2][4][2];
#pragma unroll
        for (int ai = 0; ai < 2; ++ai)
#pragma unroll
            for (int m = 0; m < 4; ++m)
#pragma unroll
                for (int bj = 0; bj < 2; ++bj) {
                    const unsigned char* q_ = Pp + (size_t)(ai * 128 + m * 16) * 2048 + 256 * bj;
                    if constexpr (PART == 0) g[ai][m][bj] = *(const u32x4*)q_;
                    else { const u32x2 t_ = *(const u32x2*)(q_ + 8); g[ai][m][bj].z = t_.x; g[ai][m][bj].w = t_.y; }
                }
        __builtin_amdgcn_sched_barrier(0);
#pragma unroll
        for (int ai = 0; ai < 2; ++ai)
#pragma unroll
            for (int m = 0; m < 4; ++m)
#pragma unroll
                for (int bj = 0; bj < 2; ++bj) {
                    const u32x4 gq = g[ai][m][bj];
                    if constexpr (PART == 0) {
#pragma unroll
                        for (int e = 0; e < 4; ++e) { acc[ai][bj][m][0][e] *= ub(gq.x, e) * __builtin_amdgcn_rcpf(ub(gq.z, e)); acc[ai][bj][m][1][e] *= ub(gq.y, e) * __builtin_amdgcn_rcpf(ub(gq.w, e)); }
                    } else {
                        const f32x4 v0 = acc[ai][bj][m][0] * (1.0f / 255.0f), v1 = acc[ai][bj][m][1] * (1.0f / 255.0f);
                        u32x4 w; w.x = pk2(v0[0] * ub(gq.z, 0), v0[1] * ub(gq.z, 1)); w.y = pk2(v0[2] * ub(gq.z, 2), v0[3] * ub(gq.z, 3));
                        w.z = pk2(v1[0] * ub(gq.w, 0), v1[1] * ub(gq.w, 1)); w.w = pk2(v1[2] * ub(gq.w, 2), v1[3] * ub(gq.w, 3));
                        *(u32x4*)(Mg + (size_t)(row0 + ai * 128 + m * 16) * D + cb + 128 * bj) = w;
                    }
                }
    }
    __device__ __forceinline__ bool operator()(f32x4 (&acc)[2][2][4][2], const Unit& u, int wr, int wc, int fr, int fq, const LAS unsigned char* es) const {
        if (u.part == 0) run<0>(acc, u, wr, wc, fr, fq); else run<1>(acc, u, wr, wc, fr, fq);
        return u.part != 0;
    }
};
struct EpiAo {
    bf16_t* AO;
    __device__ __forceinline__ void prefetch(const Unit&, LAS unsigned char*, int) const {}
    __device__ __forceinline__ bool operator()(f32x4 (&acc)[2][2][4][2], const Unit& u, int wr, int wc, int fr, int fq, const LAS unsigned char* es) const {
        const int row0 = u.pm * 256 + wr * 64 + fr, col0 = u.pn * 256 + wc * 32 + 8 * fq;
#pragma unroll
        for (int ai = 0; ai < 2; ++ai)
#pragma unroll
            for (int m = 0; m < 4; ++m) {
                bf16_t* rowp = AO + (size_t)(row0 + ai * 128 + m * 16) * D + col0;
#pragma unroll
                for (int bj = 0; bj < 2; ++bj) { const f32x4 v0 = acc[ai][bj][m][0], v1 = acc[ai][bj][m][1];
                    u32x4 w; w.x = pk2(v0[0], v0[1]); w.y = pk2(v0[2], v0[3]); w.z = pk2(v1[0], v1[1]); w.w = pk2(v1[2], v1[3]); *(u32x4*)(rowp + bj * 128) = w; }
            }
        return true;
    }
};
struct EpiMoe1 {
    const float* b1; unsigned char* H;
    __device__ __forceinline__ void prefetch(const Unit& u, LAS unsigned char* es, int lane) const {
        const float* s = b1 + (size_t)u.e * 2 * FF + 128 * u.pn + (lane < 32 ? 4 * lane : FF + 4 * (lane - 32));
        __builtin_amdgcn_global_load_lds((const unsigned*)s, (LAS unsigned*)es, 16, 0, 0); }
    __device__ __forceinline__ bool operator()(f32x4 (&acc)[2][2][4][2], const Unit& u, int wr, int wc, int fr, int fq, const LAS unsigned char* es) const {
        const int p0 = 32 * wc + 8 * fq;
        const LAS float* bg = (const LAS float*)es + p0;
        constexpr float KS = -1.702f * LOG2E, QC = F8_ACT / KS;
        f32x4 bz[2], bq[2];
        bz[0] = *(const LAS f32x4*)bg * KS; bz[1] = *(const LAS f32x4*)(bg + 4) * KS; bq[0] = *(const LAS f32x4*)(bg + 128) * QC + QC; bq[1] = *(const LAS f32x4*)(bg + 132) * QC + QC;
#pragma unroll
        for (int ai = 0; ai < 2; ++ai)
#pragma unroll
            for (int m = 0; m < 4; ++m) {
                const int rho = 128 * ai + 64 * wr + 16 * m + fr;
                float a8[8];
#pragma unroll
                for (int n = 0; n < 2; ++n) {
                    const f32x4 z4 = acc[ai][0][m][n] * (F8_INV * KS) + bz[n], q4 = acc[ai][1][m][n] * (F8_INV * QC) + bq[n];
#pragma unroll
                    for (int p = 0; p < 2; ++p) {
                        f32x2 z = {__builtin_amdgcn_fmed3f(z4[2 * p], 7.0f * KS, 40.0f), __builtin_amdgcn_fmed3f(z4[2 * p + 1], 7.0f * KS, 40.0f)};
                        f32x2 q = {__builtin_amdgcn_fmed3f(q4[2 * p], 8.0f * QC, -6.0f * QC), __builtin_amdgcn_fmed3f(q4[2 * p + 1], 8.0f * QC, -6.0f * QC)};
                        f32x2 d = {__builtin_amdgcn_exp2f(z.x), __builtin_amdgcn_exp2f(z.y)};
                        d = d + 1.0f;
                        const f32x2 nn = q * z; const float r = __builtin_amdgcn_rcpf(d.x * d.y);
                        const f32x2 o = nn * __builtin_shufflevector(d, d, 1, 0) * r;
                        a8[4 * n + 2 * p] = o.x; a8[4 * n + 2 * p + 1] = o.y;
                    }
                }
                u32x2 w; w.x = pk4_fp8(a8[0], a8[1], a8[2], a8[3]); w.y = pk4_fp8(a8[4], a8[5], a8[6], a8[7]);
                *(u32x2*)(H + (size_t)(u.pm * 256 + rho) * FF + 128 * u.pn + p0) = w;
            }
        return true;
    }
};
struct EpiMoe2 {
    const LAS int* cnt; const float* gwl; const float* b2; unsigned char* Y;
    __device__ __forceinline__ void prefetch(const Unit& u, LAS unsigned char* es, int lane) const {
        __builtin_amdgcn_global_load_lds((const unsigned*)(b2 + (size_t)u.e * D + 256 * u.pn + 4 * lane), (LAS unsigned*)es, 16, 0, 0);
        __builtin_amdgcn_global_load_lds((const unsigned*)(gwl + (size_t)u.e * LISTCAP + u.mt * 256 + 4 * lane), (LAS unsigned*)(es + 1024), 16, 0, 0); }
    __device__ __forceinline__ bool operator()(f32x4 (&acc)[2][2][4][2], const Unit& u, int wr, int wc, int fr, int fq, const LAS unsigned char* es) const {
        const int n_e = cnt[u.e]; const int cl = 64 * wc + 16 * fq;
        f32x4 bv[2][2];
#pragma unroll
        for (int bj = 0; bj < 2; ++bj)
#pragma unroll
            for (int n = 0; n < 2; ++n) bv[bj][n] = *(const LAS f32x4*)((const LAS float*)es + cl + 8 * bj + 4 * n);
        float gw[2][4];
#pragma unroll
        for (int ai = 0; ai < 2; ++ai)
#pragma unroll
            for (int m = 0; m < 4; ++m) gw[ai][m] = ((const LAS float*)(es + 1024))[128 * ai + 64 * wr + 16 * m + fr] * F8_Y;
#pragma unroll
        for (int ai = 0; ai < 2; ++ai)
#pragma unroll
            for (int m = 0; m < 4; ++m) {
                const int rho = 128 * ai + 64 * wr + 16 * m + fr;
                if (u.mt * 256 + rho < n_e) {
                    const float g_ = gw[ai][m];
                    u32x4 w;
#pragma unroll
                    for (int bj = 0; bj < 2; ++bj) {
                        const f32x4 v0 = (acc[ai][bj][m][0] * F8_INV + bv[bj][0]) * g_, v1 = (acc[ai][bj][m][1] * F8_INV + bv[bj][1]) * g_;
                        w[2 * bj] = pk4_fp8(v0[0], v0[1], v0[2], v0[3]); w[2 * bj + 1] = pk4_fp8(v1[0], v1[1], v1[2], v1[3]);
                    }
                    *(u32x4*)(Y + (size_t)(u.pm * 256 + rho) * D + u.pn * 256 + cl) = w;
                }
            }
        return true;
    }
};

__device__ __forceinline__ void ld64(const bf16_t* p, float (&f)[64]) {
#pragma unroll
    for (int i = 0; i < 8; ++i) { const u32x4 w = *((const u32x4*)p + i); f[8 * i] = bflo(w.x); f[8 * i + 1] = bfhi(w.x); f[8 * i + 2] = bflo(w.y); f[8 * i + 3] = bfhi(w.y); f[8 * i + 4] = bflo(w.z); f[8 * i + 5] = bfhi(w.z); f[8 * i + 6] = bflo(w.w); f[8 * i + 7] = bfhi(w.w); }
}
__device__ __forceinline__ float dot64(const bf16_t* p, const float (&q)[64]) {
    float s = 0.f;
#pragma unroll
    for (int i = 0; i < 8; ++i) { const u32x4 w = *((const u32x4*)p + i);
        s += q[8 * i] * bflo(w.x) + q[8 * i + 1] * bfhi(w.x) + q[8 * i + 2] * bflo(w.y) + q[8 * i + 3] * bfhi(w.y) + q[8 * i + 4] * bflo(w.z) + q[8 * i + 5] * bfhi(w.z) + q[8 * i + 6] * bflo(w.w) + q[8 * i + 7] * bfhi(w.w); }
    return s;
}
__device__ __forceinline__ void axpy64(const bf16_t* p, float a, float pw, float (&o)[64]) {
#pragma unroll
    for (int i = 0; i < 8; ++i) { const u32x4 w = *((const u32x4*)p + i);
        o[8 * i] = o[8 * i] * a + pw * bflo(w.x); o[8 * i + 1] = o[8 * i + 1] * a + pw * bfhi(w.x); o[8 * i + 2] = o[8 * i + 2] * a + pw * bflo(w.y); o[8 * i + 3] = o[8 * i + 3] * a + pw * bfhi(w.y);
        o[8 * i + 4] = o[8 * i + 4] * a + pw * bflo(w.z); o[8 * i + 5] = o[8 * i + 5] * a + pw * bfhi(w.z); o[8 * i + 6] = o[8 * i + 6] * a + pw * bflo(w.w); o[8 * i + 7] = o[8 * i + 7] * a + pw * bfhi(w.w); }
}
__device__ __forceinline__ void st64(bf16_t* p, const float (&o)[64], float inv) {
#pragma unroll
    for (int i = 0; i < 8; ++i) { u32x4 w; w.x = pk2(o[8 * i] * inv, o[8 * i + 1] * inv); w.y = pk2(o[8 * i + 2] * inv, o[8 * i + 3] * inv); w.z = pk2(o[8 * i + 4] * inv, o[8 * i + 5] * inv); w.w = pk2(o[8 * i + 6] * inv, o[8 * i + 7] * inv); *((u32x4*)p + i) = w; }
}
__device__ __forceinline__ void attn_naive(Frame& F, const Args& a) {
    const bf16_t* QA = (const bf16_t*)(F.ws + WS_QA); const bf16_t* KA = (const bf16_t*)(F.ws + WS_KA); const bf16_t* VA = (const bf16_t*)(F.ws + WS_VA);
    const bf16_t* QB = (const bf16_t*)(F.ws + WS_QB); const bf16_t* KB = (const bf16_t*)(F.ws + WS_KB); const bf16_t* VB = (const bf16_t*)(F.ws + WS_VB);
    bf16_t* OA = (bf16_t*)(F.ws + WS_OA); bf16_t* OB = (bf16_t*)(F.ws + WS_OB);
    const float* rpb = a.in[4]; const float* sinks = a.in[5];
    const int gt = F.vcu * NTHREADS + F.tid, NGT = F.G * NTHREADS;
    for (int it = gt; it < T * 16; it += NGT) {
        const int t = it >> 4, hh = it & 15; const int b = t >> 13, s = t & (SEQ - 1);
        float q[64], o[64];
#pragma unroll
        for (int d = 0; d < 64; ++d) o[d] = 0.f;
        if (hh < 8) {
            const int h = hh, r = s >> 6, c = s & 63; const int rs = min(max(r - 4, 0), 120), cs = min(max(c - 8, 0), 48);
            ld64(QA + hm_off(t, 8, h, 0), q);
            float m = -INFINITY, l = 0.f;
            for (int kr = 0; kr < 8; ++kr)
                for (int kc = 0; kc < 16; ++kc) {
                    const int kt = (b << 13) + ((rs + kr) << 6) + cs + kc;
                    float sc = dot64(KA + hm_off(kt, 8, h, 0), q) + rpb[h * 15 * 31 + (rs + kr - r + 7) * 31 + (cs + kc - c + 15)] * LOG2E;
                    const float mn = fmaxf(m, sc), al = __builtin_amdgcn_exp2f(m - mn), pw = __builtin_amdgcn_exp2f(sc - mn);
                    l = l * al + pw; axpy64(VA + hm_off(kt, 8, h, 0), al, pw, o); m = mn;
                }
            st64(OA + (size_t)t * 512 + h * 64, o, 1.0f / l);
        } else {
            const int hq = hh - 8, kvh = hq >> 2;
            ld64(QB + hm_off(t, 8, hq, 0), q);
            float m = sinks[hq] * LOG2E, l = 1.f;
            const int j0 = max(s - 128, 0), j1 = min(s + 128, SEQ - 1);
            for (int j = j0; j <= j1; ++j) {
                const int kt = (b << 13) + j;
                const float sc = dot64(KB + hm_off(kt, 2, kvh, 0), q);
                const float mn = fmaxf(m, sc), al = __builtin_amdgcn_exp2f(m - mn), pw = __builtin_amdgcn_exp2f(sc - mn);
                l = l * al + pw; axpy64(VB + hm_off(kt, 2, kvh, 0), al, pw, o); m = mn;
            }
            st64(OB + (size_t)t * 512 + hq * 64, o, 1.0f / l);
        }
    }
}


typedef short s16x4 __attribute__((ext_vector_type(4)));
typedef short v4i16_t __attribute__((ext_vector_type(4)));
#define MFMA16(a, b, c) __builtin_amdgcn_mfma_f32_16x16x32_bf16((a), (b), (c), 0, 0, 0)
__device__ __forceinline__ bf16x8 ldK(const LAS unsigned char* img, int key, int chunk) { return *(const LAS bf16x8*)(img + key * 128 + ((chunk ^ ((key >> 1) & 7)) << 4)); }
__device__ __forceinline__ s16x4 ldVt(const LAS unsigned char* img, int key, int dt, int p) {
    const LAS unsigned char* a = img + key * 128 + (((2 * dt + (p >> 1)) ^ (((key >> 1) & 3) << 1)) << 4) + (p & 1) * 8;
    return __builtin_bit_cast(s16x4, __builtin_amdgcn_ds_read_tr16_b64_v4i16((LAS v4i16_t*)a)); }
template <bool ISV> __device__ __forceinline__ void dma_piece(const bf16_t* grow0, LAS unsigned char* img, int k0, int lane) {
    const int key = k0 + (lane >> 3), slot = lane & 7;
    const int ss = ISV ? (slot ^ (((key >> 1) & 3) << 1)) : (slot ^ ((key >> 1) & 7));
    __builtin_amdgcn_global_load_lds((const unsigned*)((const char*)grow0 + (lane >> 3) * 128 + ss * 16), (LAS unsigned*)(img + k0 * 128), 16, 0, 0);
}
__device__ __forceinline__ float xmax16_32(float v) { v = fmaxf(v, __shfl_xor(v, 16)); return fmaxf(v, __shfl_xor(v, 32)); }
__device__ __forceinline__ float xsum16_32(float v) { v += __shfl_xor(v, 16); return v + __shfl_xor(v, 32); }
__device__ __forceinline__ bf16x8 pack8(const f32x4& a, const f32x4& b) { u32x4 w; w.x = pk2(a[0], a[1]); w.y = pk2(a[2], a[3]); w.z = pk2(b[0], b[1]); w.w = pk2(b[2], b[3]); return __builtin_bit_cast(bf16x8, w); }

__device__ __forceinline__ void na_phase(Frame& F, const Args& a) {
    const bf16_t* QA = (const bf16_t*)(F.ws + WS_QA); const bf16_t* KA = (const bf16_t*)(F.ws + WS_KA); const bf16_t* VA = (const bf16_t*)(F.ws + WS_VA);
    bf16_t* OA = (bf16_t*)(F.ws + WS_OA); const f32x4* BT = (const f32x4*)(F.ws + WS_BT);
    LAS unsigned char* imgK = F.lds; LAS unsigned char* imgV = F.lds + 9 * 8192;
    const int lane = F.lane, g = lane >> 4, ql = lane & 15, q4 = (lane & 15) >> 2, p4 = lane & 3;
    const int per = (2048 + F.G - 1) / F.G;
    int res_lo = -1000, res_bh = -1;
    u32x4 pf[4]; int pf_lo = 0, pf_cnt = 0;
    f32x4 bt[8][2]; int bt_key = -1;
    bf16x8 qf0, qf1, qn0, qn1;
    auto q_ptr = [&](int u_) -> const bf16_t* { const int p_ = u_ & 63, h_ = (u_ >> 6) & 7, b_ = u_ >> 9;
        return QA + (((size_t)(b_ * 8 + h_) * SEQ) + (2 * p_ + (F.wave >> 2)) * 64 + 16 * (F.wave & 3) + ql) * 64 + 8 * g; };
    { const int u0 = F.vcu * per; if (u0 < 2048) { const bf16_t* q_ = q_ptr(u0); qf0 = *(const bf16x8*)q_; qf1 = *(const bf16x8*)(q_ + 32); } }
    asm volatile("" : "+v"(qf0), "+v"(qf1));
    for (int i = 0; i < per; ++i) {
        const int u = F.vcu * per + i; if (u >= 2048) break;
        const int p = u & 63, h = (u >> 6) & 7, b = u >> 9, bh = b * 8 + h;
        const int R0 = min(max(2 * p - 4, 0), 120);
        const size_t rowbase = (size_t)bh * SEQ;
        if (res_bh != bh || res_lo != R0) {
            __syncthreads();
            for (int j = F.wave; j < 144; j += 8) {
                const int kr = j >> 4, isv = (j >> 3) & 1, pc = j & 7; const int slot = (R0 + kr) % 9;
                const size_t tok0 = rowbase + (R0 + kr) * 64 + pc * 8;
                if (isv) dma_piece<true>(VA + tok0 * 64, imgV + slot * 8192, pc * 8, lane); else dma_piece<false>(KA + tok0 * 64, imgK + slot * 8192, pc * 8, lane);
            }
            asm volatile("s_waitcnt vmcnt(0)" ::: "memory");
            __syncthreads();
        }
        res_bh = bh; res_lo = R0;
        const int r = 2 * p + (F.wave >> 2), gq = F.wave & 3, base = (gq == 0) ? 0 : (gq == 1) ? 8 : (gq == 2) ? 24 : 32;
        const int rs = min(max(r - 4, 0), 120), rs9 = rs % 9, dr0 = rs - r + 7;
        if (bt_key != h * 64 + dr0) {
            bt_key = h * 64 + dr0;
#pragma unroll
            for (int kr = 0; kr < 8; ++kr)
#pragma unroll
                for (int hf = 0; hf < 2; ++hf) bt[kr][hf] = BT[((((h * 4 + gq) * 15 + dr0 + kr) * 2 + hf) * 64) + lane];
        }
        f32x4 S[8][2];
#pragma unroll
        for (int kr = 0; kr < 8; ++kr) {
            const int sl = (rs9 + kr >= 9) ? rs9 + kr - 9 : rs9 + kr; const LAS unsigned char* ik = imgK + sl * 8192;
#pragma unroll
            for (int hf = 0; hf < 2; ++hf) {
                const int key = base + 16 * hf + ql;
                f32x4 s = MFMA16(ldK(ik, key, g), qf0, bt[kr][hf]); s = MFMA16(ldK(ik, key, 4 + g), qf1, s); S[kr][hf] = s;
            }
        }
        __builtin_amdgcn_sched_barrier(0);
        const bool nxt_ok = (i + 1 < per && u + 1 < 2048), has_next = nxt_ok && ((u + 1) >> 6) == (u >> 6);
        { const bf16_t* q_ = q_ptr(nxt_ok ? u + 1 : u); qn0 = *(const bf16x8*)q_; qn1 = *(const bf16x8*)(q_ + 32); }
        pf_cnt = 0; pf_lo = R0;
        if (has_next) { const int nR0 = min(max(2 * (p + 1) - 4, 0), 120); pf_lo = max(nR0, R0 + 9); pf_cnt = nR0 + 9 - pf_lo; }
#pragma unroll
        for (int jj = 0; jj < 4; ++jj) {
            const int j = F.wave + 8 * jj, rowsel = j >> 4, isv = (j >> 3) & 1, pc = j & 7;
            const int prow = (rowsel < pf_cnt) ? pf_lo + rowsel : R0;
            const int key = pc * 8 + (lane >> 3), s16 = lane & 7; const int ss = isv ? (s16 ^ (((key >> 1) & 3) << 1)) : (s16 ^ ((key >> 1) & 7));
            const bf16_t* src = (isv ? VA : KA) + (rowbase + (size_t)prow * 64 + key) * 64 + ss * 8;
            pf[jj] = *(const u32x4*)src;
        }
        __builtin_amdgcn_sched_barrier(0);
        float m = -INFINITY;
#pragma unroll
        for (int kr = 0; kr < 8; ++kr)
#pragma unroll
            for (int hf = 0; hf < 2; ++hf) { m = fmaxf(fmaxf(m, S[kr][hf][0]), S[kr][hf][1]); m = fmaxf(fmaxf(m, S[kr][hf][2]), S[kr][hf][3]); }
        m = xmax16_32(m);
#pragma unroll
        for (int kr = 0; kr < 8; ++kr)
#pragma unroll
            for (int hf = 0; hf < 2; ++hf)
#pragma unroll
                for (int e = 0; e < 4; ++e) S[kr][hf][e] = __builtin_amdgcn_exp2f(S[kr][hf][e] - m);
        f32x4 o[4], osum = {0.f, 0.f, 0.f, 0.f};
        const bf16x8 ones8 = {0x3F80, 0x3F80, 0x3F80, 0x3F80, 0x3F80, 0x3F80, 0x3F80, 0x3F80};
#pragma unroll
        for (int dt = 0; dt < 4; ++dt) o[dt] = (f32x4){0.f, 0.f, 0.f, 0.f};
#pragma unroll
        for (int kr = 0; kr < 8; ++kr) {
            const int sl = (rs9 + kr >= 9) ? rs9 + kr - 9 : rs9 + kr;
            const bf16x8 pp = pack8(S[kr][0], S[kr][1]); const LAS unsigned char* iv = imgV + sl * 8192;
            const int ka = base + 4 * g + q4;
#pragma unroll
            for (int dt = 0; dt < 4; ++dt) {
                const s16x4 va = ldVt(iv, ka, dt, p4), vb = ldVt(iv, ka + 16, dt, p4);
                const bf16x8 vf = {va[0], va[1], va[2], va[3], vb[0], vb[1], vb[2], vb[3]};
                o[dt] = MFMA16(vf, pp, o[dt]);
            }
            osum = MFMA16(ones8, pp, osum);
        }
        const float inv = 1.0f / osum[0];
        bf16_t* op = OA + ((size_t)b * SEQ + r * 64 + 16 * gq + ql) * 512 + h * 64 + 4 * g;
#pragma unroll
        for (int dt = 0; dt < 4; ++dt) { u32x2 w; w.x = pk2(o[dt][0] * inv, o[dt][1] * inv); w.y = pk2(o[dt][2] * inv, o[dt][3] * inv); *(u32x2*)(op + 16 * dt) = w; }
        if (pf_cnt > 0) {
            __syncthreads();
#pragma unroll
            for (int jj = 0; jj < 4; ++jj) {
                const int j = F.wave + 8 * jj, rowsel = j >> 4, isv = (j >> 3) & 1, pc = j & 7;
                if (rowsel < pf_cnt) { const int slot = (pf_lo + rowsel) % 9; *(LAS u32x4*)((isv ? imgV : imgK) + slot * 8192 + pc * 1024 + lane * 16) = pf[jj]; }
            }
            res_lo = pf_lo + pf_cnt - 9;
            __syncthreads();
        }
        asm volatile("" :: "v"(pf[0]), "v"(pf[1]), "v"(pf[2]), "v"(pf[3]));
        qf0 = qn0; qf1 = qn1;
    }
    __syncthreads();
}

__device__ __forceinline__ void swa_phase(Frame& F, const Args& a) {
    const bf16_t* QB = (const bf16_t*)(F.ws + WS_QB); const bf16_t* KB = (const bf16_t*)(F.ws + WS_KB); const bf16_t* VB = (const bf16_t*)(F.ws + WS_VB);
    bf16_t* OB = (bf16_t*)(F.ws + WS_OB); const float* sinks = a.in[5];
    LAS unsigned char* imgK = F.lds; LAS unsigned char* imgV = F.lds + 65536;
    const int lane = F.lane, g = lane >> 4, ql = lane & 15, q4 = (lane & 15) >> 2, p4 = lane & 3;
    f32x4 mlo, mhi;
#pragma unroll
    for (int e = 0; e < 4; ++e) { mlo[e] = (4 * g + e >= ql) ? 0.f : -INFINITY; mhi[e] = (4 * g + e <= ql) ? 0.f : -INFINITY; }
    const int per = (512 + F.G - 1) / F.G;
    const float sink_a = sinks[F.wave >> 1] * LOG2E, sink_b = sinks[4 + (F.wave >> 1)] * LOG2E;
    auto q_base = [&](int u_) -> const bf16_t* { const int n_ = u_ & 63, kvh_ = (u_ >> 6) & 1, b_ = u_ >> 7;
        return QB + ((size_t)(b_ * 8 + 4 * kvh_ + (F.wave >> 1)) * SEQ + 128 * n_ + 64 * (F.wave & 1) + ql) * 64 + 8 * g; };
    bf16x8 qc0, qc1;
    { const int u0 = F.vcu * per; if (u0 < 512) { const bf16_t* q_ = q_base(u0); qc0 = *(const bf16x8*)q_; qc1 = *(const bf16x8*)(q_ + 32); } }
    { float sa_ = sink_a, sb_ = sink_b; asm volatile("" : "+v"(qc0), "+v"(qc1), "+v"(sa_), "+v"(sb_)); }
    int res_bk = -1, res_hi = -1000;
#define SWA_LOAD_BLOCK(bk, blk) do { const int slot_ = ((blk) + 1) & 3; const bool ok_ = (blk) >= 0 && (blk) < SEQ / 128; \
        for (int j = F.wave; j < 32; j += 8) { const int isv = j >> 4, pc = j & 15; \
            if (ok_) { const size_t tok0 = (size_t)(bk) * SEQ + (blk) * 128 + pc * 8; \
                if (isv) dma_piece<true>(VB + tok0 * 64, imgV + slot_ * 16384, pc * 8, lane); else dma_piece<false>(KB + tok0 * 64, imgK + slot_ * 16384, pc * 8, lane); } \
            else if (isv) { *(LAS u32x4*)(imgV + slot_ * 16384 + pc * 1024 + lane * 16) = (u32x4){0u, 0u, 0u, 0u}; } } } while (0)
    for (int i = 0; i < per; ++i) {
        const int u = F.vcu * per + i; if (u >= 512) break;
        const int n = u & 63, kvh = (u >> 6) & 1, b = u >> 7, bk = b * 2 + kvh;
        if (res_bk != bk || res_hi != n + 1) {
            __syncthreads();
            const bool keep2 = (res_bk == bk && res_hi == n);
            if (!keep2) { SWA_LOAD_BLOCK(bk, n - 1); SWA_LOAD_BLOCK(bk, n); }
            SWA_LOAD_BLOCK(bk, n + 1);
        }
        asm volatile("s_waitcnt vmcnt(0)" : "+v"(qc0), "+v"(qc1) :: "memory");
        __syncthreads();
        res_bk = bk; res_hi = n + 1;
        if (i + 1 < per && u + 1 < 512 && ((u + 1) >> 6) == (u >> 6)) { SWA_LOAD_BLOCK(bk, n + 2); res_hi = n + 2; }
        const int hq = 4 * kvh + (F.wave >> 1), half = F.wave & 1;
        const float sink2 = kvh ? sink_b : sink_a;
        const bf16_t* qbase = q_base(u);
        const bf16_t* nqbase = q_base((i + 1 < per && u + 1 < 512) ? u + 1 : u);
        const int kswz0 = (g ^ ((ql >> 1) & 7)) << 4, kswz1 = ((4 + g) ^ ((ql >> 1) & 7)) << 4;
        const int vk0 = 4 * g + q4; int vterm[4];
#pragma unroll
        for (int dt = 0; dt < 4; ++dt) vterm[dt] = (((2 * dt + (p4 >> 1)) ^ (((vk0 >> 1) & 3) << 1)) << 4) + (p4 & 1) * 8;
#pragma unroll 1
        for (int sub = 0; sub < 4; ++sub) {
            const int qrel0 = 64 * half + 16 * sub, qpos0 = 128 * n + qrel0;
            const bf16x8 qf0 = qc0, qf1 = qc1;
            const int kpos = 128 * n + qrel0 + ql, vpos = 128 * n + qrel0 + vk0;
            f32x4 S[17];
            bf16x8 kA[4][2], kB[4][2];
#define SW_KLD(buf, j, t) do { const LAS unsigned char* p_ = imgK + (((kpos + 16 * (t)) & 511) << 7); buf[j][0] = *(const LAS bf16x8*)(p_ + kswz0); buf[j][1] = *(const LAS bf16x8*)(p_ + kswz1); } while (0)
#define SW_KMM(buf, j, t) do { const f32x4 c_ = ((t) == 0) ? mlo : ((t) == 16) ? mhi : (f32x4){0.f, 0.f, 0.f, 0.f}; f32x4 s_ = MFMA16(buf[j][0], qf0, c_); s_ = MFMA16(buf[j][1], qf1, s_); \
                S[t] = s_; } while (0)
            SW_KLD(kA, 0, 0); SW_KLD(kA, 1, 1); SW_KLD(kA, 2, 2); SW_KLD(kA, 3, 3);
            SW_KLD(kB, 0, 4); SW_KLD(kB, 1, 5); SW_KLD(kB, 2, 6); SW_KLD(kB, 3, 7); __builtin_amdgcn_sched_barrier(0);
            SW_KMM(kA, 0, 0); SW_KMM(kA, 1, 1); SW_KMM(kA, 2, 2); SW_KMM(kA, 3, 3); __builtin_amdgcn_sched_barrier(0);
            SW_KLD(kA, 0, 8); SW_KLD(kA, 1, 9); SW_KLD(kA, 2, 10); SW_KLD(kA, 3, 11); __builtin_amdgcn_sched_barrier(0);
            SW_KMM(kB, 0, 4); SW_KMM(kB, 1, 5); SW_KMM(kB, 2, 6); SW_KMM(kB, 3, 7); __builtin_amdgcn_sched_barrier(0);
            SW_KLD(kB, 0, 12); SW_KLD(kB, 1, 13); SW_KLD(kB, 2, 14); SW_KLD(kB, 3, 15); __builtin_amdgcn_sched_barrier(0);
            SW_KMM(kA, 0, 8); SW_KMM(kA, 1, 9); SW_KMM(kA, 2, 10); SW_KMM(kA, 3, 11); __builtin_amdgcn_sched_barrier(0);
            SW_KLD(kA, 0, 16); __builtin_amdgcn_sched_barrier(0);
            SW_KMM(kB, 0, 12); SW_KMM(kB, 1, 13); SW_KMM(kB, 2, 14); SW_KMM(kB, 3, 15); __builtin_amdgcn_sched_barrier(0);
            SW_KMM(kA, 0, 16); __builtin_amdgcn_sched_barrier(0);
            { const bf16_t* qn_ = (sub < 3) ? qbase + (sub + 1) * 1024 : nqbase; qc0 = *(const bf16x8*)qn_; qc1 = *(const bf16x8*)(qn_ + 32); }
            __builtin_amdgcn_sched_barrier(0);
#undef SW_KLD
#undef SW_KMM
            if (n == 0 || n == SEQ / 128 - 1) {
#pragma unroll
                for (int t = 0; t < 17; ++t) { const int kp_ = qpos0 - 128 + 16 * t; if (kp_ < 0 || kp_ >= SEQ) S[t] = (f32x4){-INFINITY, -INFINITY, -INFINITY, -INFINITY}; }
            }
            float m = -INFINITY;
#pragma unroll
            for (int t = 0; t < 17; ++t) { m = fmaxf(fmaxf(m, S[t][0]), S[t][1]); m = fmaxf(fmaxf(m, S[t][2]), S[t][3]); }
            m = fmaxf(xmax16_32(m), sink2);
#pragma unroll
            for (int t = 0; t < 17; ++t)
#pragma unroll
                for (int e = 0; e < 4; ++e) S[t][e] = __builtin_amdgcn_exp2f(S[t][e] - m);
            f32x4 o[4], osum = {0.f, 0.f, 0.f, 0.f};
#pragma unroll
            for (int dt = 0; dt < 4; ++dt) o[dt] = (f32x4){0.f, 0.f, 0.f, 0.f};
            const f32x4 zero4 = {0.f, 0.f, 0.f, 0.f};
            const bf16x8 ones8 = {0x3F80, 0x3F80, 0x3F80, 0x3F80, 0x3F80, 0x3F80, 0x3F80, 0x3F80};
            s16x4 vA[4][2], vB[4][2];
#define SW_VLD(buf, ks) do { const int ta_ = 2 * (ks), tb_ = (2 * (ks) + 1 < 17) ? 2 * (ks) + 1 : 2 * (ks); \
                const LAS unsigned char* pa_ = imgV + (((vpos + 16 * ta_) & 511) << 7); const LAS unsigned char* pb_ = imgV + (((vpos + 16 * tb_) & 511) << 7); \
                _Pragma("unroll") for (int dt = 0; dt < 4; ++dt) { \
                    buf[dt][0] = __builtin_bit_cast(s16x4, __builtin_amdgcn_ds_read_tr16_b64_v4i16((LAS v4i16_t*)(pa_ + vterm[dt]))); \
                    buf[dt][1] = __builtin_bit_cast(s16x4, __builtin_amdgcn_ds_read_tr16_b64_v4i16((LAS v4i16_t*)(pb_ + vterm[dt]))); } } while (0)
#define SW_VMM(buf, ks) do { const bf16x8 pp_ = pack8(S[2 * (ks)], (2 * (ks) + 1 < 17) ? S[(2 * (ks) + 1 < 17) ? 2 * (ks) + 1 : 0] : zero4); \
                _Pragma("unroll") for (int dt = 0; dt < 4; ++dt) { const bf16x8 vf_ = {buf[dt][0][0], buf[dt][0][1], buf[dt][0][2], buf[dt][0][3], buf[dt][1][0], buf[dt][1][1], buf[dt][1][2], buf[dt][1][3]}; \
                    o[dt] = MFMA16(vf_, pp_, o[dt]); } osum = MFMA16(ones8, pp_, osum); } while (0)
            SW_VLD(vA, 0); SW_VLD(vB, 1); __builtin_amdgcn_sched_barrier(0);
            SW_VMM(vA, 0); __builtin_amdgcn_sched_barrier(0); SW_VLD(vA, 2); __builtin_amdgcn_sched_barrier(0);
            SW_VMM(vB, 1); __builtin_amdgcn_sched_barrier(0); SW_VLD(vB, 3); __builtin_amdgcn_sched_barrier(0);
            SW_VMM(vA, 2); __builtin_amdgcn_sched_barrier(0); SW_VLD(vA, 4); __builtin_amdgcn_sched_barrier(0);
            SW_VMM(vB, 3); __builtin_amdgcn_sched_barrier(0); SW_VLD(vB, 5); __builtin_amdgcn_sched_barrier(0);
            SW_VMM(vA, 4); __builtin_amdgcn_sched_barrier(0); SW_VLD(vA, 6); __builtin_amdgcn_sched_barrier(0);
            SW_VMM(vB, 5); __builtin_amdgcn_sched_barrier(0); SW_VLD(vB, 7); __builtin_amdgcn_sched_barrier(0);
            SW_VMM(vA, 6); __builtin_amdgcn_sched_barrier(0); SW_VLD(vA, 8); __builtin_amdgcn_sched_barrier(0);
            SW_VMM(vB, 7); __builtin_amdgcn_sched_barrier(0);
            SW_VMM(vA, 8);
#undef SW_VLD
#undef SW_VMM
            const float inv = 1.0f / (osum[0] + __builtin_amdgcn_exp2f(sink2 - m));
            bf16_t* op = OB + ((size_t)b * SEQ + qpos0 + ql) * 512 + hq * 64 + 4 * g;
#pragma unroll
            for (int dt = 0; dt < 4; ++dt) { u32x2 w; w.x = pk2(o[dt][0] * inv, o[dt][1] * inv); w.y = pk2(o[dt][2] * inv, o[dt][3] * inv); *(u32x2*)(op + 16 * dt) = w; }
        }
    }
#undef SWA_LOAD_BLOCK
    asm volatile("s_waitcnt vmcnt(0)" ::: "memory");
    __syncthreads();
}

__device__ __forceinline__ void router_phase(Frame& F, const Args& a) {
    const float* x = a.in[0]; bf16_t* AO = (bf16_t*)(F.ws + WS_AO); const float* g2 = a.in[9]; const float* wr_ = a.in[10]; const float* br = a.in[11];
    unsigned char* H2N = (unsigned char*)(F.ws + WS_H2N); float* gwl = (float*)(F.ws + WS_GWL); int* list = (int*)(F.ws + WS_LIST); int* inv = (int*)(F.ws + WS_INV);
    unsigned* counts = (unsigned*)(F.ws + WS_CTL) + CW_CNT;
    LAS float* wL = (LAS float*)F.lds;
    LAS float* lgs = (LAS float*)(F.lds + RING_BYTES) + F.wave * 512;
    LAS int* sel = (LAS int*)(F.lds + SEL_OFF); LAS float* selg = (LAS float*)(F.lds + SELG_OFF);
    {
        f32x4 wv[16]; float gk[16];
#pragma unroll
        for (int j = 0; j < 16; ++j) { const int i4 = F.tid + NTHREADS * j; wv[j] = *((const f32x4*)wr_ + i4); gk[j] = g2[i4 >> 3]; }
#pragma unroll
        for (int j = 0; j < 16; ++j) { const int i = 4 * (F.tid + NTHREADS * j), k = i >> 5, e = i & 31;
#pragma unroll
            for (int c = 0; c < 4; ++c) wL[k * 32 + 2 * ((e + c) & 15) + ((e + c) >> 4)] = wv[j][c] * gk[j]; }
    }
    __syncthreads();
    const int lane = F.lane, ti = lane & 15, q = lane >> 4;
    for (int ch = blockIdx.x; ch < T / 128; ch += F.G) {
        const int t0 = ch * 128 + F.wave * 16;
        const float* xrow = x + (size_t)(t0 + ti) * D + 4 * q; bf16_t* arow = AO + (size_t)(t0 + ti) * D + 4 * q;
        f32x4 acc0 = {0.f, 0.f, 0.f, 0.f}, acc1 = {0.f, 0.f, 0.f, 0.f}; float ss = 0.f;
#pragma unroll 4
        for (int s = 0; s < 64; ++s) {
            f32x4 v = *(const f32x4*)(xrow + 16 * s); const u32x2 w = *(const u32x2*)(arow + 16 * s);
            v.x += bflo(w.x); v.y += bfhi(w.x); v.z += bflo(w.y); v.w += bfhi(w.y);
            { u32x2 xb; xb.x = pk2(v.x, v.y); xb.y = pk2(v.z, v.w); *(u32x2*)(arow + 16 * s) = xb; }
            ss += (v.x * v.x + v.y * v.y) + (v.z * v.z + v.w * v.w);
            const LAS float* wp = wL + (16 * s + 4 * q) * 32 + 2 * ti;
#pragma unroll
            for (int u = 0; u < 4; ++u) {
                const f32x2 b = *(const LAS f32x2*)(wp + 32 * u);
                acc0 = __builtin_amdgcn_mfma_f32_16x16x4f32(v[u], b.x, acc0, 0, 0, 0);
                acc1 = __builtin_amdgcn_mfma_f32_16x16x4f32(v[u], b.y, acc1, 0, 0, 0);
            }
        }
        ss += __shfl_xor(ss, 16); ss += __shfl_xor(ss, 32);
        const float rstd = 1.0f / sqrtf(ss * (1.f / D) + RMS_EPS);
#pragma unroll
        for (int r = 0; r < 4; ++r) { lgs[(4 * q + r) * 32 + ti] = acc0[r]; lgs[(4 * q + r) * 32 + 16 + ti] = acc1[r]; }
        asm volatile("s_waitcnt lgkmcnt(0)" ::: "memory");
        if (lane < 16) {
            float lg[32];
#pragma unroll
            for (int e4 = 0; e4 < 8; ++e4) { const f32x4 v4 = *(const LAS f32x4*)(lgs + lane * 32 + 4 * e4); const f32x4 b4 = *(const f32x4*)(br + 4 * e4);
                lg[4 * e4] = v4.x * rstd + b4.x; lg[4 * e4 + 1] = v4.y * rstd + b4.y; lg[4 * e4 + 2] = v4.z * rstd + b4.z; lg[4 * e4 + 3] = v4.w * rstd + b4.w; }
            float tv[4]; int tix[4];
#pragma unroll
            for (int k = 0; k < 4; ++k) {
                float best = -INFINITY; int bi = 0;
#pragma unroll
                for (int e = 0; e < 32; ++e) if (lg[e] > best) { best = lg[e]; bi = e; }
#pragma unroll
                for (int e = 0; e < 32; ++e) lg[e] = (e == bi) ? -INFINITY : lg[e];
                tv[k] = best; tix[k] = bi;
            }
            const float e1 = __expf(tv[1] - tv[0]), e2 = __expf(tv[2] - tv[0]), e3 = __expf(tv[3] - tv[0]);
            const float inv = 1.0f / (1.0f + e1 + e2 + e3);
            const int rloc = F.wave * 16 + lane;
            sel[rloc * 4 + 0] = tix[0]; sel[rloc * 4 + 1] = tix[1]; sel[rloc * 4 + 2] = tix[2]; sel[rloc * 4 + 3] = tix[3];
            selg[rloc * 4 + 0] = inv; selg[rloc * 4 + 1] = e1 * inv; selg[rloc * 4 + 2] = e2 * inv; selg[rloc * 4 + 3] = e3 * inv;
        }
#pragma unroll 4
        for (int r = 0; r < 16; ++r) {
            const float rq = __shfl(rstd, r) * F8_ACT; const int t = t0 + r;
            const u32x4* ar = (const u32x4*)(AO + (size_t)t * D) + 2 * lane;
            const u32x4 wa = ar[0], wb = ar[1];
            u32x4 o; o.x = pk4_fp8(bflo(wa.x) * rq, bfhi(wa.x) * rq, bflo(wa.y) * rq, bfhi(wa.y) * rq); o.y = pk4_fp8(bflo(wa.z) * rq, bfhi(wa.z) * rq, bflo(wa.w) * rq, bfhi(wa.w) * rq);
            o.z = pk4_fp8(bflo(wb.x) * rq, bfhi(wb.x) * rq, bflo(wb.y) * rq, bfhi(wb.y) * rq); o.w = pk4_fp8(bflo(wb.z) * rq, bfhi(wb.z) * rq, bflo(wb.w) * rq, bfhi(wb.w) * rq);
            *((u32x4*)(H2N + (size_t)t * D) + lane) = o;
        }
        LAS int* lcnt = (LAS int*)(F.lds + TS_OFF) + 96; LAS int* lbase = lcnt + 32;
        if (F.tid < 32) lcnt[F.tid] = 0;
        __syncthreads();
        const int myj = F.tid, mye = sel[myj];
        const int mypos = __hip_atomic_fetch_add(lcnt + mye, 1, __ATOMIC_RELAXED, __HIP_MEMORY_SCOPE_WORKGROUP);
        __syncthreads();
        if (F.tid < 32) { const int c = lcnt[F.tid]; lbase[F.tid] = c > 0 ? (int)__hip_atomic_fetch_add(counts + F.tid, (unsigned)c, RLX_AGENT) : 0; }
        __syncthreads();
        { const int idx = lbase[mye] + mypos, slot = mye * LISTCAP + idx, tk = (ch * 128 + (myj >> 2)) * 4 + (myj & 3); list[slot] = tk; gwl[slot] = selg[myj]; inv[tk] = (mye << 16) | idx; }
        __syncthreads();
    }
}

__device__ __forceinline__ void moe_tables(Frame& F) {
    LAS int* ts = (LAS int*)(F.lds + TS_OFF); LAS int* cn = ts + 40;
    unsigned* counts = (unsigned*)(F.ws + WS_CTL) + CW_CNT;
    if (F.tid < 32) cn[F.tid] = (int)__hip_atomic_load(counts + F.tid, RLX_AGENT);
    __syncthreads();
    if (F.tid == 0) { int s = 0; for (int e = 0; e < 32; ++e) { ts[e] = s; s += (cn[e] + 255) >> 8; } ts[32] = s; ts[33] = 0x7fffffff; }
    __syncthreads();
    { LAS unsigned char* t2e = F.lds + T2E_OFF; const int total = ts[32];
      for (int m = F.tid; m < total; m += NTHREADS) { int e = 0; while (ts[e + 1] <= m) ++e; t2e[m] = (unsigned char)e; } }
    __syncthreads();
}

__device__ __forceinline__ void combine_phase(Frame& F, const Args& a) {
    moe_tables(F);
    const LAS int* ts = (const LAS int*)(F.lds + TS_OFF);
    float* out = a.out; const float* x = a.in[0]; const float* fg = a.in[16]; const unsigned char* Y = (const unsigned char*)(F.ws + WS_YTK); const bf16_t* AO = (const bf16_t*)(F.ws + WS_AO);
    const int* inv = (const int*)(F.ws + WS_INV);
    const int gw = F.vcu * NWAVES + F.wave, NGW = F.G * NWAVES;
    f32x4 gv[4];
#pragma unroll
    for (int j = 0; j < 4; ++j) gv[j] = *((const f32x4*)fg + F.lane + 64 * j);
    const int ntok = (T - gw + NGW - 1) / NGW;
    for (int i0 = 0; i0 < ntok; i0 += 16) {
        const int ti_ = i0 + (F.lane >> 2); int invv = 0;
        if (ti_ < ntok) invv = __hip_atomic_load(inv + 4 * (size_t)(gw + ti_ * NGW) + (F.lane & 3), RLX_AGENT);
        const int rowv = ts[(invv >> 16) & 31] * 256 + (invv & 0xffff);
        const int nloc = min(16, ntok - i0);
#define CB_LOAD(AV, YV, i_) do { const int t_ = gw + (i0 + (i_)) * NGW; int row_[4]; \
            _Pragma("unroll") for (int k = 0; k < 4; ++k) row_[k] = __builtin_amdgcn_readlane(rowv, 4 * (i_) + k); \
            _Pragma("unroll") for (int j = 0; j < 4; ++j) { AV[j] = *((const u32x2*)(AO + (size_t)t_ * D) + F.lane + 64 * j); \
                _Pragma("unroll") for (int k = 0; k < 4; ++k) YV[k][j] = *((const unsigned*)(Y + (size_t)row_[k] * D) + F.lane + 64 * j); } } while (0)
#define CB_PROC(AV, YV, i_) do { const int t_ = gw + (i0 + (i_)) * NGW; f32x4 v[4]; float ss = 0.f; \
            _Pragma("unroll") for (int j = 0; j < 4; ++j) { f32x4 ysum = {0.f, 0.f, 0.f, 0.f}; \
                _Pragma("unroll") for (int k = 0; k < 4; ++k) { const f32x2 lo2 = __builtin_amdgcn_cvt_pk_f32_fp8((int)YV[k][j], false), hi2 = __builtin_amdgcn_cvt_pk_f32_fp8((int)YV[k][j], true); \
                    ysum.x += lo2.x; ysum.y += lo2.y; ysum.z += hi2.x; ysum.w += hi2.y; } \
                v[j] = ysum * F8_YINV; v[j].x += bflo(AV[j].x); v[j].y += bfhi(AV[j].x); v[j].z += bflo(AV[j].y); v[j].w += bfhi(AV[j].y); \
                ss += (v[j].x * v[j].x + v[j].y * v[j].y) + (v[j].z * v[j].z + v[j].w * v[j].w); } \
            const float rstd = 1.0f / sqrtf(wave_sum(ss) * (1.f / D) + RMS_EPS); f32x4* orow = (f32x4*)(out + (size_t)t_ * D) + F.lane; \
            _Pragma("unroll") for (int j = 0; j < 4; ++j) orow[64 * j] = v[j] * rstd * gv[j]; } while (0)
        u32x2 avA[4], avB[4]; unsigned yvA[4][4], yvB[4][4];
        CB_LOAD(avA, yvA, 0);
#pragma unroll 1
        for (int i = 0; i < nloc; i += 2) {
            if (i + 1 < nloc) CB_LOAD(avB, yvB, i + 1);
            CB_PROC(avA, yvA, i);
            if (i + 2 < nloc) CB_LOAD(avA, yvA, i + 2);
            if (i + 1 < nloc) CB_PROC(avB, yvB, i + 1);
        }
#undef CB_LOAD
#undef CB_PROC
    }
}

constexpr int N_PHASES = 9;
#ifndef PROBE_PHASE
#define PROBE_PHASE -1
#endif
#ifndef PROBE_REPS
#define PROBE_REPS 2
#endif
template <int k> __device__ __forceinline__ void run_phase(Frame& F0, const Args& args) {
    Frame F = F0; { int t_ = threadIdx.x; asm volatile("" : "+v"(t_)); F.tid = t_; F.lane = t_ & 63; F.wave = __builtin_amdgcn_readfirstlane(t_ >> 6); }
    if constexpr (k == 0) { p0_prologue(F, args); }
    else if constexpr (k == 1) {
        { DenseSched S; S.so.init(T, C_GA, F.G, (int)blockIdx.x); S.A = (const char*)(F.ws + WS_H1); S.lda = D * 2; S.Bt = (const char*)(F.ws + WS_WIN); S.K = 2 * D;
          EpiInProj E{F.ws, args.in[3], (const float*)(F.ws + WS_ROPE)};
          pg8::gemm_phase<true, true, false>(F.lds, 2 * D, S, E); }
        { DenseSched S; S.so.init(T, 2048, F.G, (int)blockIdx.x); if (F.G == 256) S.so.tail_lo = 128; S.A = (const char*)(F.ws + WS_H1Q); S.lda = D; S.Bt = (const char*)(F.ws + WS_WING8); S.K = D;
          EpiGate E{(unsigned char*)(F.ws + WS_SG), args.in[3]};
          pg8::gemm_phase<true, true, true>(F.lds, D, S, E); }
    } else if constexpr (k == 2) {
#if ATTN_NAIVE
        attn_naive(F, args);
#else
        na_phase(F, args); swa_phase(F, args);
#if PROBE_ATTN == 1
        na_phase(F, args); na_phase(F, args);
#elif PROBE_ATTN == 2
        swa_phase(F, args); swa_phase(F, args);
#endif
#endif
    } else if constexpr (k == 3) {
        UpSched S; S.so.init(T, D, F.G, (int)blockIdx.x); S.OA = (const char*)(F.ws + WS_OA); S.OB = (const char*)(F.ws + WS_OB); S.Wa = (const char*)(F.ws + WS_WA); S.Wb = (const char*)(F.ws + WS_WB);
        EpiUp E{(const unsigned char*)(F.ws + WS_SG), (bf16_t*)(F.ws + WS_MERGED)};
        pg8::gemm_phase<true, true, false>(F.lds, 2 * 512, S, E);
    } else if constexpr (k == 4) {
        DenseSched S; S.so.init(T, D, F.G, (int)blockIdx.x); S.A = (const char*)(F.ws + WS_MERGED); S.lda = D * 2; S.Bt = (const char*)(F.ws + WS_WOUT); S.K = 2 * D;
        EpiAo E{(bf16_t*)(F.ws + WS_AO)};
        pg8::gemm_phase<true, true, false>(F.lds, 2 * D, S, E);
    } else if constexpr (k == 5) { router_phase(F, args); }
    else if constexpr (k == 6) {
        moe_tables(F);
        const LAS int* ts = (const LAS int*)(F.lds + TS_OFF);
        MoeSched<true> S; S.tstart = ts; S.cnt = ts + 40; S.t2e = (const LAS unsigned char*)(F.lds + T2E_OFF); S.G = F.G; S.vcu = F.vcu; S.log_mt = 2; S.total = ts[32];
        S.A = (const char*)(F.ws + WS_H2N); S.list = (const int*)(F.ws + WS_LIST); S.Bt = (const char*)(F.ws + WS_W1); S.b_estride = (size_t)2 * FF * D; S.K = D;
        EpiMoe1 E{args.in[13], (unsigned char*)(F.ws + WS_HACT)};
        pg8::gemm_phase<true, true, true>(F.lds, D, S, E);
    } else if constexpr (k == 7) {
        moe_tables(F);
        const LAS int* ts = (const LAS int*)(F.lds + TS_OFF);
        MoeSched<false> S; S.tstart = ts; S.cnt = ts + 40; S.t2e = (const LAS unsigned char*)(F.lds + T2E_OFF); S.G = F.G; S.vcu = F.vcu; S.log_mt = 3; S.total = ts[32];
        S.A = (const char*)(F.ws + WS_HACT); S.list = (const int*)(F.ws + WS_LIST); S.Bt = (const char*)(F.ws + WS_W2); S.b_estride = (size_t)D * FF; S.K = FF;
        EpiMoe2 E{ts + 40, (const float*)(F.ws + WS_GWL), args.in[15], (unsigned char*)(F.ws + WS_YTK)};
        pg8::gemm_phase<true, true, true>(F.lds, FF, S, E);
    } else if constexpr (k == 8) { combine_phase(F, args); }
}
__global__ void __launch_bounds__(NTHREADS, 2) fwd_kernel(Args args) {
    extern __shared__ __attribute__((aligned(16))) unsigned char lds_raw[];
    Frame F;
    F.lds = (LAS unsigned char*)lds_raw;
    F.tid = threadIdx.x; F.lane = F.tid & 63; F.wave = __builtin_amdgcn_readfirstlane(F.tid >> 6);
    F.G = gridDim.x; { const int bx = blockIdx.x; F.vcu = (F.G % 8 == 0) ? (bx % 8) * (F.G / 8) + bx / 8 : bx; }
    F.ws = args.ws;
    volatile LAS unsigned* MISC = (volatile LAS unsigned*)(F.lds + MISC_OFF);
    for (int u = F.tid; u < 256; u += NTHREADS) MISC[u] = 0u;
    __syncthreads();
    unsigned* ctl = (unsigned*)(F.ws + WS_CTL);
    XcdBarrier bar; bar.bar = ctl + CW_BAR + args.li * XCD_BAR_WORDS; bar.x = 0; bar.st = nullptr;
    const int lo = args.ph_lo, hi = args.ph_hi;
    if (hi - lo > 1) bar = xcd_barrier_post(ctl + CW_BAR + args.li * XCD_BAR_WORDS, MISC + 8);
#define PHASE(k) do { if (lo <= (k) && (k) < hi) { run_phase<k>(F, args); if ((k) + 1 < hi) xcd_barrier(bar); } } while (0)
    PHASE(0); PHASE(1); PHASE(2); PHASE(3); PHASE(4); PHASE(5); PHASE(6); PHASE(7); PHASE(8);
#undef PHASE
}

extern "C" void kernel_launch(void* const* d_in, const int* in_sizes, int n_in, void* d_out, int out_size, void* d_ws, size_t ws_size, hipStream_t stream) {
    static int grid = 0;
    if (grid == 0) {
        if (n_in != 17 || in_sizes[0] != T * D || out_size != T * D || ws_size < WS_END) { fprintf(stderr, "kernel_launch: unexpected shapes (n_in %d, in0 %d, out %d, ws %zu); nothing launched\n", n_in, n_in > 0 ? in_sizes[0] : -1, out_size, ws_size); grid = -1; return; }
        int dev = 0, cus = 0, per_cu = 0;
        if (hipGetDevice(&dev) != hipSuccess || hipDeviceGetAttribute(&cus, hipDeviceAttributeMultiprocessorCount, dev) != hipSuccess) { grid = -1; return; }
        if (hipFuncSetAttribute((const void*)fwd_kernel, hipFuncAttributeMaxDynamicSharedMemorySize, LDS_BYTES) != hipSuccess) { fprintf(stderr, "kernel_launch: hipFuncSetAttribute failed\n"); grid = -1; return; }
        if (hipOccupancyMaxActiveBlocksPerMultiprocessor(&per_cu, (const void*)fwd_kernel, NTHREADS, LDS_BYTES) != hipSuccess || per_cu < 1) { fprintf(stderr, "kernel_launch: occupancy query reports %d blocks per CU\n", per_cu); per_cu = 1; }
        (void)hipGetLastError();
        grid = cus;
    }
    if (grid < 0) return;
    (void)hipMemsetAsync((char*)d_ws + WS_CTL, 0, CTL_ZERO_BYTES, stream);
    Args a{};
    for (int i = 0; i < 17; ++i) a.in[i] = (const float*)d_in[i];
    a.out = (float*)d_out; a.ws = (unsigned char*)d_ws;
    void* kargs[] = {&a};
#if MK_SPLIT
    for (int p = 0; p < N_PHASES; ++p) {
        a.ph_lo = p; a.ph_hi = p + 1; a.li = 0;
        hipLaunchKernelGGL(fwd_kernel, dim3(grid), dim3(NTHREADS), LDS_BYTES, stream, a);
    }
#elif PROBE_PHASE >= 0
    {
        int li = 0;
        a.ph_lo = 0; a.ph_hi = PROBE_PHASE + 1; a.li = li++;
        (void)hipLaunchCooperativeKernel((const void*)fwd_kernel, dim3(grid), dim3(NTHREADS), kargs, LDS_BYTES, stream);
        for (int r = 0; r < PROBE_REPS; ++r) { a.ph_lo = PROBE_PHASE; a.ph_hi = PROBE_PHASE + 1; a.li = li++;
            if (PROBE_PHASE == 5) (void)hipMemsetAsync((char*)d_ws + WS_CTL + CW_CNT * 4, 0, 128, stream);
            (void)hipLaunchCooperativeKernel((const void*)fwd_kernel, dim3(grid), dim3(NTHREADS), kargs, LDS_BYTES, stream); }
        if (PROBE_PHASE + 1 < N_PHASES) { a.ph_lo = PROBE_PHASE + 1; a.ph_hi = N_PHASES; a.li = li++;
            (void)hipLaunchCooperativeKernel((const void*)fwd_kernel, dim3(grid), dim3(NTHREADS), kargs, LDS_BYTES, stream); }
    }
#else
    a.ph_lo = 0; a.ph_hi = N_PHASES; a.li = 0;
    hipError_t e = hipLaunchCooperativeKernel((const void*)fwd_kernel, dim3(grid), dim3(NTHREADS), kargs, LDS_BYTES, stream);
    if (e != hipSuccess) fprintf(stderr, "kernel_launch: cooperative launch failed: %s (grid %d)\n", hipGetErrorString(e), grid);
#endif
}
```
